# Optimizing an MI355X kernel written in HIP

```python
import jax
import jax.numpy as jnp
from jax import lax
import numpy as np


D_MODEL = 1024
BATCH = 8
SEQ = 2048
DEPTH = 2

GRID_W = 64
CTX_LEN = 256
N_BRANCH = 4
BRANCH_W = 512

LRU_W = 512
LRU_BLOCKS = 8
LRU_BW = LRU_W // LRU_BLOCKS
LRU_CONV = 4
LRU_C = 8.0

GQA_HQ = 8
GQA_HKV = 2
GQA_DH = 64
WINDOW = 128
ATT_BLOCK = 128

MLA_H = 8
MLA_RQ = 384
MLA_RKV = 256
MLA_DN = 64
MLA_DR = 32
MLA_DV = 64

RET_H = 4
RET_DK = 128
RET_DV = 128
RET_CHUNK = 128

FF = 2816

ROPE_BASE = 10000.0
LN_EPS = 1e-5
MASK_VALUE = -1e30
DN_ALPHA = (2 * DEPTH) ** 0.25
DN_BETA = (8 * DEPTH) ** -0.25

IN_SIZES = (LRU_W, LRU_W, GQA_HQ * GQA_DH, GQA_HKV * GQA_DH, GQA_HKV * GQA_DH, MLA_RQ, MLA_RKV, MLA_DR, RET_H * RET_DK, RET_H * RET_DK, RET_H * RET_DV, RET_H * RET_DV, N_BRANCH * D_MODEL)
IN_COLS = sum(IN_SIZES)

kernel_name = 'hybrid_gated_parallel_diffusion_block'


def _split_cols(p):
    cuts = np.cumsum(np.array(IN_SIZES))[:-1].tolist()
    return jnp.split(p, cuts, axis=-1)


def _layer_norm(x, g, b):
    xf = x.astype(jnp.float32)
    mu = jnp.mean(xf, -1, keepdims=True)
    var = jnp.mean(jnp.square(xf - mu), -1, keepdims=True)
    y = (xf - mu) * lax.rsqrt(var + LN_EPS)
    return (y * g.astype(jnp.float32) + b.astype(jnp.float32)).astype(x.dtype)


def _rms_norm(x, g):
    xf = x.astype(jnp.float32)
    y = xf * lax.rsqrt(jnp.mean(jnp.square(xf), -1, keepdims=True) + LN_EPS)
    return (y * g.astype(jnp.float32)).astype(x.dtype)


def _axial_rope(x, rows, cols):
    dim = x.shape[-1]
    da = dim // 2
    nf = da // 2
    inv = ROPE_BASE ** (-jnp.arange(nf, dtype=jnp.float32) / nf)
    parts = []
    for pos, seg in ((rows, x[..., :da]), (cols, x[..., da:])):
        ang = pos.astype(jnp.float32)[:, None] * inv[None, :]
        cos = jnp.cos(ang)[:, None, :]
        sin = jnp.sin(ang)[:, None, :]
        sf = seg.astype(jnp.float32)
        s1, s2 = sf[..., :nf], sf[..., nf:]
        parts += [s1 * cos - s2 * sin, s2 * cos + s1 * sin]
    return jnp.concatenate(parts, -1).astype(x.dtype)


def _swiglu(h, w_in, w_out):
    a, b = jnp.split(h @ w_in, 2, axis=-1)
    return (jax.nn.silu(a) * b) @ w_out


def _half_ffn(h, shift, scale, gate, w1, w2, g, b):
    y = _swiglu(h * (1 + scale) + shift, w1, w2)
    return _layer_norm(DN_ALPHA * h + 0.5 * gate * y, g, b)


def _centred_dwconv(x, w, b):
    T = x.shape[1]
    left = LRU_CONV // 2
    xp = jnp.pad(x, ((0, 0), (left, LRU_CONV - 1 - left), (0, 0)))
    y = b
    for j in range(LRU_CONV):
        y = y + xp[:, j:j + T] * w[j]
    return y


def _rglru_coeffs(x, w_a, b_a, w_x, b_x, lam):
    B, T, _ = x.shape
    xb = x.reshape(B, T, LRU_BLOCKS, LRU_BW)
    r = jax.nn.sigmoid(jnp.einsum('btnd,nde->btne', xb, w_a).reshape(B, T, LRU_W) + b_a).astype(jnp.float32)
    i = jax.nn.sigmoid(jnp.einsum('btnd,nde->btne', xb, w_x).reshape(B, T, LRU_W) + b_x).astype(jnp.float32)
    log_a = -LRU_C * r * jax.nn.softplus(-lam.astype(jnp.float32))
    a = jnp.exp(log_a)
    bt = jnp.sqrt(1.0 - jnp.exp(2.0 * log_a)) * (i * x.astype(jnp.float32))
    return a, bt


def _linear_scan(a, b, h0):
    def comb(left, right):
        return (left[0] * right[0], right[0] * left[1] + right[1])
    acum, h = lax.associative_scan(comb, (a, b), axis=1)
    return h + acum * h0[:, None, :]


def _gqa_window(q, k, v, kc, vc, sink):
    B, S = q.shape[:2]
    G = GQA_HQ // GQA_HKV
    blk = ATT_BLOCK
    nb = S // blk
    Lc = kc.shape[1]
    scale = GQA_DH ** -0.5
    qb = q.reshape(B, nb, blk, GQA_HKV, G, GQA_DH)

    def windows(t):
        tp = jnp.pad(t, ((0, 0), (blk, blk), (0, 0), (0, 0))).reshape(B, nb + 2, blk, GQA_HKV, GQA_DH)
        return jnp.concatenate([tp[:, :nb], tp[:, 1:nb + 1], tp[:, 2:]], axis=2)

    kw, vw = windows(k), windows(v)
    s_win = jnp.einsum('bnqhgd,bnkhd->bnhgqk', qb, kw).astype(jnp.float32) * scale
    blocks = jnp.arange(nb)
    qpos = blocks[:, None] * blk + jnp.arange(blk)[None, :]
    kpos = (blocks[:, None] - 1) * blk + jnp.arange(3 * blk)[None, :]
    dist = qpos[:, :, None] - kpos[:, None, :]
    valid = (jnp.abs(dist) <= WINDOW) & (kpos[:, None, :] >= 0) & (kpos[:, None, :] < S)
    s_win = jnp.where(valid[None, :, None, None], s_win, MASK_VALUE)
    s_ctx = jnp.einsum('bnqhgd,bchd->bnhgqc', qb, kc).astype(jnp.float32) * scale
    s_sink = jnp.broadcast_to(sink.astype(jnp.float32).reshape(1, 1, GQA_HKV, G, 1, 1), s_ctx.shape[:-1] + (1,))
    p = jax.nn.softmax(jnp.concatenate([s_win, s_ctx, s_sink], -1), axis=-1).astype(v.dtype)
    nw = 3 * blk
    o = jnp.einsum('bnhgqk,bnkhd->bnqhgd', p[..., :nw], vw) + jnp.einsum('bnhgqc,bchd->bnqhgd', p[..., nw:nw + Lc], vc)
    return o.reshape(B, S, GQA_HQ * GQA_DH)


def _gqa_ctx(q, k, v, sink):
    B, L = q.shape[:2]
    G = GQA_HQ // GQA_HKV
    qg = q.reshape(B, L, GQA_HKV, G, GQA_DH)
    s = jnp.einsum('bqhgd,bkhd->bhgqk', qg, k).astype(jnp.float32) * (GQA_DH ** -0.5)
    s_sink = jnp.broadcast_to(sink.astype(jnp.float32).reshape(1, GQA_HKV, G, 1, 1), s.shape[:-1] + (1,))
    p = jax.nn.softmax(jnp.concatenate([s, s_sink], -1), axis=-1).astype(v.dtype)
    o = jnp.einsum('bhgqk,bkhd->bqhgd', p[..., :L], v)
    return o.reshape(B, L, GQA_HQ * GQA_DH)


def _mla_q(cq, g, w_uq, rows, cols):
    B, T, _ = cq.shape
    q = (_rms_norm(cq, g) @ w_uq).reshape(B, T, MLA_H, MLA_DN + MLA_DR)
    qn, qr = q[..., :MLA_DN], q[..., MLA_DN:]
    if rows is not None:
        qr = _axial_rope(qr, rows, cols)
    return jnp.concatenate([qn, qr], -1)


def _mla_kv(ckv, kr, g, w_ukv, rows, cols):
    B, T, _ = ckv.shape
    kv = (_rms_norm(ckv, g) @ w_ukv).reshape(B, T, MLA_H, MLA_DN + MLA_DV)
    kn, v = kv[..., :MLA_DN], kv[..., MLA_DN:]
    kr = kr[:, :, None, :]
    if rows is not None:
        kr = _axial_rope(kr, rows, cols)
    k = jnp.concatenate([kn, jnp.broadcast_to(kr, (B, T, MLA_H, MLA_DR))], -1)
    return k, v


def _dense_attend(q, k, v):
    s = jnp.einsum('bqhd,bkhd->bhqk', q, k).astype(jnp.float32) * ((MLA_DN + MLA_DR) ** -0.5)
    p = jax.nn.softmax(s, axis=-1).astype(v.dtype)
    return jnp.einsum('bhqk,bkhd->bqhd', p, v)


def _ret_heads(t, n_dim, rows, cols):
    B, T, _ = t.shape
    t = t.reshape(B, T, RET_H, n_dim)
    if rows is not None:
        t = _axial_rope(t, rows, cols)
    return t.astype(jnp.float32)


def _retention_chunkwise(q, k, v, gamma, state0, strict):
    B, T, H, DK = q.shape
    DV = v.shape[-1]
    C = RET_CHUNK
    nc = T // C
    qc = q.reshape(B, nc, C, H, DK)
    kc = k.reshape(B, nc, C, H, DK)
    vc = v.reshape(B, nc, C, H, DV)
    lg = jnp.log(gamma)
    pos = jnp.arange(C, dtype=jnp.float32)
    diff = pos[:, None] - pos[None, :]
    keep = (diff > 0) if strict else (diff >= 0)
    dmask = jnp.where(keep[None], jnp.exp(jnp.where(keep, diff, 0.0)[None] * lg[:, None, None]), 0.0)
    s = jnp.einsum('bnihd,bnjhd->bnhij', qc, kc) * dmask
    intra = jnp.einsum('bnhij,bnjhe->bnihe', s, vc)
    zeta = jnp.exp((C - 1 - pos)[:, None] * lg[None, :])
    kv = jnp.einsum('bnjhd,bnjhe->nbhde', kc * zeta[:, :, None], vc)
    decay = jnp.exp(C * lg)[None, :, None, None]

    def step(R, kv_n):
        return decay * R + kv_n, R

    final, before = lax.scan(step, state0, kv)
    xi = jnp.exp((pos + 1)[:, None] * lg[None, :])
    cross = jnp.einsum('bnihd,nbhde->bnihe', qc * xi[:, :, None], before)
    return (intra + cross).reshape(B, T, H, DV), final


def _retention_state(k, v, gamma):
    T = k.shape[1]
    w = jnp.exp((T - 1 - jnp.arange(T, dtype=jnp.float32))[:, None] * jnp.log(gamma)[None, :])
    return jnp.einsum('bthd,th,bthe->bhde', k, w, v)


def _head_group_norm(y, g):
    B, T, H, DV = y.shape
    mu = jnp.mean(y, -1, keepdims=True)
    var = jnp.mean(jnp.square(y - mu), -1, keepdims=True)
    yn = (y - mu) * lax.rsqrt(var + LN_EPS)
    return yn.reshape(B, T, H * DV) * g.astype(jnp.float32)


def _gated_merge(branches, gates, w_branch, w_out):
    B, T = gates.shape[:2]
    br = jnp.stack([b.astype(gates.dtype) for b in branches], axis=2)
    g = jax.nn.sigmoid(gates.reshape(B, T, N_BRANCH, D_MODEL))
    proj = jnp.einsum('btkw,kwd->btkd', br, w_branch)
    return jnp.einsum('btkd,btkd->btd', g, proj) @ w_out


def _mixer(hl, hc, rows, cols, need_ctx, w_in, conv_w, conv_b, lru_w_a, lru_b_a, lru_w_x, lru_b_x, lru_lambda, sink, q_norm, kv_norm, w_uq, w_ukv, ret_decay, gn_g, w_branch, w_out):
    B, S, _ = hl.shape
    Lc = hc.shape[1]
    dt = hl.dtype
    f32 = jnp.float32
    (ax_l, ay_l, bq_l, bk_l, bv_l, cq_l, ckv_l, ckr_l, dq_l, dk_l, dv_l, dg_l, gt_l) = _split_cols(hl @ w_in)
    (ax_c, ay_c, bq_c, bk_c, bv_c, cq_c, ckv_c, ckr_c, dq_c, dk_c, dv_c, dg_c, gt_c) = _split_cols(hc @ w_in)

    def flip(t):
        return t[:, ::-1]

    xa_l = _centred_dwconv(ax_l, conv_w, conv_b)
    xa_c = _centred_dwconv(ax_c, conv_w, conv_b)
    hs_l, hs_c = [], []
    for d in range(2):
        prm = (lru_w_a[d], lru_b_a[d], lru_w_x[d], lru_b_x[d], lru_lambda[d])
        src_c = flip(xa_c) if d == 1 else xa_c
        src_l = flip(xa_l) if d == 1 else xa_l
        st_c = _linear_scan(*_rglru_coeffs(src_c, *prm), jnp.zeros((B, LRU_W), f32))
        st_l = _linear_scan(*_rglru_coeffs(src_l, *prm), st_c[:, -1])
        hs_l.append(flip(st_l) if d == 1 else st_l)
        if need_ctx:
            hs_c.append(flip(st_c) if d == 1 else st_c)
    out_a_l = (hs_l[0] + hs_l[1]).astype(dt) * jax.nn.gelu(ay_l)

    qb_l = _axial_rope(bq_l.reshape(B, S, GQA_HQ, GQA_DH), rows, cols)
    kb_l = _axial_rope(bk_l.reshape(B, S, GQA_HKV, GQA_DH), rows, cols)
    vb_l = bv_l.reshape(B, S, GQA_HKV, GQA_DH)
    kb_c = bk_c.reshape(B, Lc, GQA_HKV, GQA_DH)
    vb_c = bv_c.reshape(B, Lc, GQA_HKV, GQA_DH)
    out_b_l = _gqa_window(qb_l, kb_l, vb_l, kb_c, vb_c, sink)

    k_c, v_c = _mla_kv(ckv_c, ckr_c, kv_norm, w_ukv, None, None)
    k_l, v_l = _mla_kv(ckv_l, ckr_l, kv_norm, w_ukv, rows, cols)
    q_l = _mla_q(cq_l, q_norm, w_uq, rows, cols)
    k_all = jnp.concatenate([k_c, k_l], axis=1)
    v_all = jnp.concatenate([v_c, v_l], axis=1)
    nb = S // ATT_BLOCK
    qblk = q_l.reshape(B, nb, ATT_BLOCK, MLA_H, MLA_DN + MLA_DR).transpose(1, 0, 2, 3, 4)
    o = lax.map(lambda qi: _dense_attend(qi, k_all, v_all), qblk)
    out_c_l = o.transpose(1, 0, 2, 3, 4).reshape(B, S, MLA_H * MLA_DV)

    gam = jax.nn.sigmoid(ret_decay.astype(f32))
    kd_c = _ret_heads(dk_c, RET_DK, None, None) * (RET_DK ** -0.5)
    vd_c = _ret_heads(dv_c, RET_DV, None, None)
    zero = jnp.zeros((B, RET_H, RET_DK, RET_DV), f32)
    if need_ctx:
        qd_c = _ret_heads(dq_c, RET_DK, None, None)
        oc_f, st_f = _retention_chunkwise(qd_c, kd_c, vd_c, gam[0], zero, False)
        oc_b, st_b = _retention_chunkwise(flip(qd_c), flip(kd_c), flip(vd_c), gam[1], zero, True)
    else:
        st_f = _retention_state(kd_c, vd_c, gam[0])
        st_b = _retention_state(flip(kd_c), flip(vd_c), gam[1])
    qd_l = _ret_heads(dq_l, RET_DK, rows, cols)
    kd_l = _ret_heads(dk_l, RET_DK, rows, cols) * (RET_DK ** -0.5)
    vd_l = _ret_heads(dv_l, RET_DV, None, None)
    ol_f, _ = _retention_chunkwise(qd_l, kd_l, vd_l, gam[0], st_f, False)
    ol_b, _ = _retention_chunkwise(flip(qd_l), flip(kd_l), flip(vd_l), gam[1], st_b, True)
    out_d_l = jax.nn.silu(dg_l) * _head_group_norm(ol_f + flip(ol_b), gn_g).astype(dt)

    y_l = _gated_merge([out_a_l, out_b_l, out_c_l, out_d_l], gt_l, w_branch, w_out)
    if not need_ctx:
        return y_l, None

    out_a_c = (hs_c[0] + hs_c[1]).astype(dt) * jax.nn.gelu(ay_c)
    out_b_c = _gqa_ctx(bq_c.reshape(B, Lc, GQA_HQ, GQA_DH), kb_c, vb_c, sink)
    q_c = _mla_q(cq_c, q_norm, w_uq, None, None)
    out_c_c = _dense_attend(q_c, k_c, v_c).reshape(B, Lc, MLA_H * MLA_DV)
    out_d_c = jax.nn.silu(dg_c) * _head_group_norm(oc_f + flip(oc_b), gn_g).astype(dt)
    y_c = _gated_merge([out_a_c, out_b_c, out_c_c, out_d_c], gt_c, w_branch, w_out)
    return y_l, y_c


def setup_inputs(seed: int = 0) -> dict:
    key = jax.random.key(seed)
    ks = jax.random.split(key, 32)
    f32 = jnp.float32

    def nrm(k, shape, scale):
        return jax.random.normal(k, shape, f32) * scale

    x = nrm(ks[0], (BATCH, SEQ, D_MODEL), 1.0)
    c = nrm(ks[1], (BATCH, D_MODEL), 1.0)
    ctx = nrm(ks[2], (BATCH, CTX_LEN, D_MODEL), 1.0)
    c_ctx = nrm(ks[3], (D_MODEL,), 1.0)
    w_mod = nrm(ks[4], (DEPTH, D_MODEL, 9 * D_MODEL), 0.5 * D_MODEL ** -0.5)
    b_mod = nrm(ks[5], (DEPTH, 9 * D_MODEL), 0.02)
    ln_g = 1.0 + nrm(ks[6], (DEPTH, 3, D_MODEL), 0.02)
    ln_b = nrm(ks[7], (DEPTH, 3, D_MODEL), 0.02)
    ffn_w_in = nrm(ks[8], (DEPTH, 2, D_MODEL, 2 * FF), D_MODEL ** -0.5)
    ffn_w_out = nrm(ks[9], (DEPTH, 2, FF, D_MODEL), DN_BETA * FF ** -0.5)
    w_in = nrm(ks[10], (DEPTH, D_MODEL, IN_COLS), D_MODEL ** -0.5)
    lru_conv_w = nrm(ks[11], (DEPTH, LRU_CONV, LRU_W), LRU_CONV ** -0.5)
    lru_conv_b = nrm(ks[12], (DEPTH, LRU_W), 0.02)
    lru_w_a = nrm(ks[13], (DEPTH, 2, LRU_BLOCKS, LRU_BW, LRU_BW), LRU_BW ** -0.5)
    lru_b_a = nrm(ks[14], (DEPTH, 2, LRU_W), 0.02)
    lru_w_x = nrm(ks[15], (DEPTH, 2, LRU_BLOCKS, LRU_BW, LRU_BW), LRU_BW ** -0.5)
    lru_b_x = nrm(ks[16], (DEPTH, 2, LRU_W), 0.02)
    u = jax.random.uniform(ks[17], (DEPTH, 2, LRU_W), f32, 0.9, 0.999)
    s = u ** (1.0 / LRU_C)
    lru_lambda = jnp.log(s) - jnp.log1p(-s)
    gqa_sink = nrm(ks[18], (DEPTH, GQA_HQ), 0.5)
    mla_q_norm = 1.0 + nrm(ks[19], (DEPTH, MLA_RQ), 0.02)
    mla_kv_norm = 1.0 + nrm(ks[20], (DEPTH, MLA_RKV), 0.02)
    mla_w_uq = nrm(ks[21], (DEPTH, MLA_RQ, MLA_H * (MLA_DN + MLA_DR)), MLA_RQ ** -0.5)
    mla_w_ukv = nrm(ks[22], (DEPTH, MLA_RKV, MLA_H * (MLA_DN + MLA_DV)), MLA_RKV ** -0.5)
    g0 = 1.0 - 2.0 ** (-5.0 - jnp.arange(RET_H, dtype=f32))
    ret_decay = (jnp.log(g0) - jnp.log1p(-g0))[None, None, :] + nrm(ks[23], (DEPTH, 2, RET_H), 0.1)
    ret_gn_g = 1.0 + nrm(ks[24], (DEPTH, RET_H * RET_DV), 0.02)
    w_branch = nrm(ks[25], (DEPTH, N_BRANCH, BRANCH_W, D_MODEL), BRANCH_W ** -0.5)
    w_out = nrm(ks[26], (DEPTH, D_MODEL, D_MODEL), DN_BETA * D_MODEL ** -0.5)
    return {'x': x, 'c': c, 'ctx': ctx, 'c_ctx': c_ctx, 'w_mod': w_mod, 'b_mod': b_mod, 'ln_g': ln_g, 'ln_b': ln_b, 'ffn_w_in': ffn_w_in, 'ffn_w_out': ffn_w_out, 'w_in': w_in, 'lru_conv_w': lru_conv_w, 'lru_conv_b': lru_conv_b, 'lru_w_a': lru_w_a, 'lru_b_a': lru_b_a, 'lru_w_x': lru_w_x, 'lru_b_x': lru_b_x, 'lru_lambda': lru_lambda, 'gqa_sink': gqa_sink, 'mla_q_norm': mla_q_norm, 'mla_kv_norm': mla_kv_norm, 'mla_w_uq': mla_w_uq, 'mla_w_ukv': mla_w_ukv, 'ret_decay': ret_decay, 'ret_gn_g': ret_gn_g, 'w_branch': w_branch, 'w_out': w_out}


def reference(x, c, ctx, c_ctx, w_mod, b_mod, ln_g, ln_b, ffn_w_in, ffn_w_out, w_in, lru_conv_w, lru_conv_b, lru_w_a, lru_b_a, lru_w_x, lru_b_x, lru_lambda, gqa_sink, mla_q_norm, mla_kv_norm, mla_w_uq, mla_w_ukv, ret_decay, ret_gn_g, w_branch, w_out):
    B, S, D = x.shape
    n_rows = S // GRID_W
    rows = jnp.repeat(jnp.arange(n_rows), GRID_W)
    cols = jnp.tile(jnp.arange(GRID_W), n_rows)
    s_lat = jax.nn.silu(c)
    s_ctx = jax.nn.silu(c_ctx)
    xl, xc = x, ctx
    for l in range(DEPTH):
        last = l == DEPTH - 1
        mod_l = (s_lat @ w_mod[l] + b_mod[l]).reshape(B, 9, 1, D)
        mod_c = (s_ctx @ w_mod[l] + b_mod[l]).reshape(9, 1, 1, D)
        ml = [mod_l[:, k] for k in range(9)]
        mc = [mod_c[k] for k in range(9)]
        xl = _half_ffn(xl, ml[0], ml[1], ml[2], ffn_w_in[l, 0], ffn_w_out[l, 0], ln_g[l, 0], ln_b[l, 0])
        xc = _half_ffn(xc, mc[0], mc[1], mc[2], ffn_w_in[l, 0], ffn_w_out[l, 0], ln_g[l, 0], ln_b[l, 0])
        hl = xl * (1 + ml[4]) + ml[3]
        hc = xc * (1 + mc[4]) + mc[3]
        yl, yc = _mixer(hl, hc, rows, cols, not last, w_in[l], lru_conv_w[l], lru_conv_b[l], lru_w_a[l], lru_b_a[l], lru_w_x[l], lru_b_x[l], lru_lambda[l], gqa_sink[l], mla_q_norm[l], mla_kv_norm[l], mla_w_uq[l], mla_w_ukv[l], ret_decay[l], ret_gn_g[l], w_branch[l], w_out[l])
        xl = _layer_norm(DN_ALPHA * xl + ml[5] * yl, ln_g[l, 1], ln_b[l, 1])
        xl = _half_ffn(xl, ml[6], ml[7], ml[8], ffn_w_in[l, 1], ffn_w_out[l, 1], ln_g[l, 2], ln_b[l, 2])
        if not last:
            xc = _layer_norm(DN_ALPHA * xc + mc[5] * yc, ln_g[l, 1], ln_b[l, 1])
            xc = _half_ffn(xc, mc[6], mc[7], mc[8], ffn_w_in[l, 1], ffn_w_out[l, 1], ln_g[l, 2], ln_b[l, 2])
    return xl
```

```cpp
#include <hip/hip_runtime.h>
#include <hip/hip_cooperative_groups.h>
#include <cstdio>
#include <cstdint>
namespace cg = cooperative_groups;
#ifndef DBG
#define DBG 0xFFF
#endif
#ifndef RDBG
#define RDBG 7
#endif

#define LAS __attribute__((address_space(3)))
#define GAS __attribute__((address_space(1)))
typedef unsigned short bf16_t;
typedef short bf16x8 __attribute__((ext_vector_type(8)));
typedef float f32x4 __attribute__((ext_vector_type(4)));
typedef float f32x2 __attribute__((ext_vector_type(2)));
typedef unsigned u32x4 __attribute__((ext_vector_type(4)));
typedef unsigned u32x2 __attribute__((ext_vector_type(2)));

constexpr int D = 1024, NB = 8, SEQ = 2048, CTX = 256, DEPTH = 2, FF = 2816;
constexpr int NLAT = NB * SEQ;
constexpr int NCTX = NB * CTX;
constexpr int NT = NLAT + NCTX;
constexpr int SALL = CTX + SEQ;
constexpr int IN_COLS = 8608, NINP = 4608;
constexpr float LN_EPS = 1e-5f;
constexpr float DN_ALPHA = 1.41421356237309515f;
constexpr float LOG2E = 1.44269504088896341f;

constexpr size_t MiB = 1u << 20;
constexpr size_t WS_CTL = 0, CTL_BYTES = 1 * MiB;
constexpr size_t WS_MISC = 1 * MiB;
constexpr size_t WS_MODTAB = WS_MISC;
constexpr size_t WS_CS8 = WS_MISC + 1 * MiB;
constexpr size_t WS_CS16 = WS_CS8 + 64 * 8 * 2 * 4;
constexpr size_t WS_CS32 = WS_CS16 + 64 * 16 * 2 * 4;
constexpr size_t WS_LRUSUM = WS_MISC + 1 * MiB + 512 * 1024;
constexpr size_t WS_WM = 5 * MiB;
constexpr size_t WM_INP = WS_WM, WM_G = WS_WM + 9 * MiB, WM_BR = WS_WM + 17 * MiB, WM_OUT = WS_WM + 21 * MiB, WM_UQ = WS_WM + 23 * MiB, WM_UKV = WM_UQ + 768 * 384 * 2, WM_LRU = WS_WM + 24 * MiB + 256 * 1024;
constexpr size_t WS_XC = 30 * MiB;
constexpr size_t WS_H = 38 * MiB;
constexpr size_t WS_QF = 74 * MiB;
constexpr size_t WS_KF = 101 * MiB;
constexpr size_t WS_VTM = 128 * MiB;
constexpr size_t WS_MG = WS_KF;
constexpr size_t WS_RET = 146 * MiB;
constexpr size_t WS_BIG = 182 * MiB;
constexpr size_t P_AX = WS_BIG, P_DQ = WS_BIG + 18 * MiB, P_DK = WS_BIG + 36 * MiB, VT_RET = WS_BIG + 54 * MiB, KT_RET = WS_BIG + 72 * MiB, VT_GQA = WS_BIG + 90 * MiB;
constexpr size_t P_BK = WS_BIG + 94 * MiB + 512 * 1024;
constexpr size_t P_AB = WS_BIG + 99 * MiB;
constexpr size_t P_CD = WS_BIG + 135 * MiB;
constexpr size_t P_CKV = WS_BIG + 171 * MiB, P_CKR = P_CKV + (size_t)NT * 256 * 2, WS_END = P_CKR + (size_t)NT * 32 * 2;
constexpr size_t WS_U = WS_BIG;
constexpr size_t WS_WF = WS_BIG + 99 * MiB;
constexpr size_t WF_SLOT = (size_t)(5632 * 1024 + 1024 * 2816) * 2;
constexpr size_t WS_SCR_SIG = WS_BIG, WS_SCR_M = WS_BIG + 32 * MiB;
static_assert(WS_WF + 2 * WF_SLOT <= WS_END && WS_U + (size_t)NT * FF * 2 <= WS_WF, "FFN overlay");
static_assert(WS_SCR_M + 64 * MiB <= P_AB, "merge scratch overlay");

typedef __bf16 bf16x2_t __attribute__((ext_vector_type(2)));
__device__ __forceinline__ unsigned cvt_pk_bf16(float lo, float hi) { bf16x2_t v; v.x = (__bf16)lo; v.y = (__bf16)hi; return __builtin_bit_cast(unsigned, v); }
__device__ __forceinline__ float bf_lo(unsigned w) { return __uint_as_float(w << 16); }
__device__ __forceinline__ float bf_hi(unsigned w) { return __uint_as_float(w & 0xffff0000u); }
__device__ __forceinline__ float bf2f(bf16_t b) { return __uint_as_float(((unsigned)b) << 16); }
__device__ __forceinline__ bf16_t f2bf(float f) { return (bf16_t)(cvt_pk_bf16(f, 0.f) & 0xffffu); }
__device__ __forceinline__ float fast_exp2(float x) { return __builtin_amdgcn_exp2f(x); }
__device__ __forceinline__ float fast_rcp(float x) { return __builtin_amdgcn_rcpf(x); }
__device__ __forceinline__ float sigmoidf_(float x) { return fast_rcp(1.0f + fast_exp2(-LOG2E * x)); }
__device__ __forceinline__ float siluf_(float x) { return x * sigmoidf_(x); }
__device__ __forceinline__ float geluf_(float v) { return v * sigmoidf_(1.5957691216057308f * (v + 0.044715f * v * v * v)); }
__device__ __forceinline__ float wave_sum(float v) {
#pragma unroll
    for (int o = 1; o < 64; o <<= 1) v += __shfl_xor(v, o);
    return v;
}
__device__ __forceinline__ int row_mod(int row) { return row < NLAT ? (row >> 11) : 8; }
__device__ __forceinline__ int posperm(int key) { return 8 * ((key >> 2) & 3) + 4 * ((key >> 4) & 1) + (key & 3); }
#define XB_TMO      128
#define XB_XCNT(j)  (256  + 64 * (j))
#define XB_XSUB(j)  (1280 + 64 * (j))
#define XB_XGEN(j)  (2304 + 64 * (j))
#define XB_TOP      3328
#define XB_TOPGEN   3392
#define XCD_BAR_WORDS 3456
#define XB_SPIN_CAP (1u << 20)
__device__ __forceinline__ unsigned xb_ld(unsigned* p)              { return __hip_atomic_load(p, __ATOMIC_RELAXED, __HIP_MEMORY_SCOPE_AGENT); }
__device__ __forceinline__ unsigned xb_add(unsigned* p, unsigned v) { return __hip_atomic_fetch_add(p, v, __ATOMIC_RELAXED, __HIP_MEMORY_SCOPE_AGENT); }
__device__ __forceinline__ unsigned xb_xcc_id() { return (unsigned)__builtin_amdgcn_s_getreg((3 << 11) | 20) & 0xFu; }
#define XB_SPIN(cond, bar) do { unsigned _sp = 0; while (cond) { __builtin_amdgcn_s_sleep(1); \
    if ((++_sp & 255u) == 0u) { if (xb_ld(&(bar)[XB_TMO])) break; if (_sp > XB_SPIN_CAP) { atomicAdd(&(bar)[XB_TMO], 1u); break; } } } } while (0)
struct XcdBarrier { unsigned* bar; unsigned x; volatile LAS unsigned* st; };
__device__ __forceinline__ XcdBarrier xcd_barrier_post(unsigned* bar, volatile LAS unsigned* st) {
    XcdBarrier b; b.bar = bar; b.x = xb_xcc_id(); b.st = st;
    if (threadIdx.x == 0) (void)xb_add(&bar[XB_XCNT(b.x)], 1u);
    return b;
}
__device__ __forceinline__ void xcd_barrier_complete(unsigned* bar, unsigned x, unsigned& nloc, unsigned& nx) {
    const unsigned G = gridDim.x * gridDim.y * gridDim.z;
    unsigned sum, cnt, mine, sp = 0u;
    for (;;) {
        sum = 0u; cnt = 0u; mine = 0u;
#pragma unroll
        for (unsigned j = 0; j < 16; ++j) { const unsigned c = xb_ld(&bar[XB_XCNT(j)]); sum += c; cnt += (c > 0u) ? 1u : 0u; mine = (j == x) ? c : mine; }
        if (sum == G) break;
        __builtin_amdgcn_s_sleep(1);
        if ((++sp & 255u) == 0u) { if (xb_ld(&bar[XB_TMO])) break; if (sp > XB_SPIN_CAP) { atomicAdd(&bar[XB_TMO], 1u); break; } }
    }
    nloc = mine > 0u ? mine : 1u; nx = cnt > 0u ? cnt : 1u;
}
__device__ __forceinline__ void xcd_barrier(const XcdBarrier& b) {
    asm volatile("s_waitcnt vmcnt(0)" ::: "memory");
    __syncthreads();
    if (threadIdx.x == 0) {
        unsigned* bar = b.bar;
        __builtin_amdgcn_s_waitcnt(0);
        unsigned nloc = b.st[0], nx = b.st[1];
        if (nloc == 0u) { xcd_barrier_complete(bar, b.x, nloc, nx); b.st[0] = nloc; b.st[1] = nx; }
        const unsigned old = xb_add(&bar[XB_XSUB(b.x)], 1u);
        const unsigned gen = old / nloc;
        if (old + 1u == (gen + 1u) * nloc) {
            __builtin_amdgcn_fence(__ATOMIC_RELEASE, "agent");
            asm volatile("s_waitcnt vmcnt(0)" ::: "memory");
            const unsigned og = xb_add(&bar[XB_TOP], 1u);
            const unsigned tg = og / nx;
            if (og + 1u == (tg + 1u) * nx) xb_add(&bar[XB_TOPGEN], 1u);
            else XB_SPIN(xb_ld(&bar[XB_TOPGEN]) == tg, bar);
            __builtin_amdgcn_fence(__ATOMIC_ACQUIRE, "agent");
            xb_add(&bar[XB_XGEN(b.x)], 1u);
            asm volatile("s_waitcnt vmcnt(0)" ::: "memory");
        } else {
            XB_SPIN(xb_ld(&bar[XB_XGEN(b.x)]) == gen, bar);
            __builtin_amdgcn_fence(__ATOMIC_ACQUIRE, "agent");
            asm volatile("s_waitcnt vmcnt(0)" ::: "memory");
        }
    }
    __syncthreads();
}

namespace pg8 {
constexpr int BM = 256, BK = 64, HALF = 128, HTB = HALF * BK * 2, STAGE_BYTES = 8 * HTB, NXCD = 8, WGM = 8;
__host__ __device__ __forceinline__ int lds_byte(int r, int c) { const int st = (r >> 4) * 2 + (c >> 5), rr = r & 15, cc = c & 31, ob = rr * 64 + cc * 2; return st * 1024 + (ob ^ (((ob >> 9) & 1) << 5)); }
__host__ __device__ __forceinline__ void stage_rc(int b, int& R, int& C) { const int st = b / 1024, sb = b % 1024, swz = sb ^ (((sb >> 9) & 1) << 5); R = (st >> 1) * 16 + swz / 64; C = (st & 1) * 32 + (swz % 64) / 2; }
__host__ __device__ __forceinline__ int perm32(int rho) { const int n = rho >> 4, i = rho & 15; return 8 * (i >> 2) + 4 * n + (i & 3); }

struct Unit { const char* A; const char* B; int nt, kind, pm, pn, k; };

struct TileOrder {
    int nM, nN, nwg, G, c;
    __device__ void init(int nM_, int nN_, int G_, int c_) { nM = nM_; nN = nN_; nwg = nM * nN; G = G_; c = c_; }
    __device__ bool tile(int i, int& pm, int& pn) const {
        const long L = (long)i * G + c; if (L >= nwg) return false;
        int wgid = (int)L; { const int q = nwg / NXCD, r = nwg % NXCD, xcd = wgid % NXCD, off = wgid / NXCD; wgid = (xcd < r ? xcd * (q + 1) : r * (q + 1) + (xcd - r) * q) + off; }
        const int nig = WGM * nN, gid = wgid / nig, fm = gid * WGM, gsz = (nM - fm) < WGM ? (nM - fm) : WGM;
        pm = fm + ((wgid % nig) % gsz); pn = (wgid % nig) / gsz; return true;
    }
};

template <class Epi, class Sched>
__device__ __forceinline__ void gemm_stream(LAS unsigned char* lds, const int tid, const Sched& S, const Epi& E) {
    const int wid = __builtin_amdgcn_readfirstlane(tid >> 6), lane = tid & 63, wr = wid >> 2, wc = wid & 3, fr = lane & 15, fq = lane >> 4;
    unsigned voff[2];
#pragma unroll
    for (int i = 0; i < 2; ++i) { int R, C; stage_rc(tid * 16 + i * 8192, R, C); voff[i] = (unsigned)(R * S.ld + C) * 2u; }
    const size_t hstep = (size_t)HALF * S.ld * 2;
    const size_t kstep = (size_t)(BK * 2);
    const unsigned ldsw = (unsigned)wid * 1024u;
    const int aoff = lds_byte(wr * 64 + fr, fq * 8), boff = lds_byte(wc * 32 + fr, fq * 8);
#define PG8_SA(b, h) (((b) * 2 + (h)) * HTB)
#define PG8_SB(b, h) ((4 + (b) * 2 + (h)) * HTB)
#define PG8_STAGE(bufoff, gbase, voff) do { _Pragma("unroll") for (int _i = 0; _i < 2; ++_i) \
        __builtin_amdgcn_global_load_lds((const unsigned*)((const char*)(gbase) + (voff)[_i]), (LAS unsigned*)(lds + (bufoff) + ldsw + _i * 8192), 16, 0, 0); } while (0)
#define PG8_LDA(dst, b, h) do { _Pragma("unroll") for (int m = 0; m < 4; ++m) _Pragma("unroll") for (int k = 0; k < 2; ++k) dst[m][k] = *(const LAS bf16x8*)(lds + PG8_SA(b, h) + aoff + m * 2048 + k * 1024); } while (0)
#define PG8_LDB(dst, b, h) do { _Pragma("unroll") for (int n = 0; n < 2; ++n) _Pragma("unroll") for (int k = 0; k < 2; ++k) dst[n][k] = *(const LAS bf16x8*)(lds + PG8_SB(b, h) + boff + n * 2048 + k * 1024); } while (0)
#define PG8_MMA(ai, bj, At, Bt) do { __builtin_amdgcn_s_setprio(1); _Pragma("unroll") for (int m = 0; m < 4; ++m) _Pragma("unroll") for (int n = 0; n < 2; ++n) _Pragma("unroll") for (int k = 0; k < 2; ++k) \
        acc[ai][bj][m][n] = __builtin_amdgcn_mfma_f32_16x16x32_bf16(Bt[n][k], At[m][k], acc[ai][bj][m][n], 0, 0, 0); __builtin_amdgcn_s_setprio(0); } while (0)
#define PG8_WAIT_V(n) asm volatile("s_waitcnt vmcnt(" #n ")" ::: "memory")
#define PG8_WAIT_L(n) asm volatile("s_waitcnt lgkmcnt(" #n ")" ::: "memory")
#define PG8_BAR __builtin_amdgcn_s_barrier()
#define PG8_SCHED __builtin_amdgcn_sched_barrier(0)
    Unit cur, nxt; int ui = 0;
    if (!S.next(0, cur)) return;
    f32x4 acc[2][2][4][2];
#pragma unroll
    for (int a = 0; a < 2; ++a)
#pragma unroll
        for (int b = 0; b < 2; ++b)
#pragma unroll
            for (int m = 0; m < 4; ++m)
#pragma unroll
                for (int n = 0; n < 2; ++n) acc[a][b][m][n] = (f32x4){0.f, 0.f, 0.f, 0.f};
    bf16x8 At[4][2], B0[2][2], B1[2][2];
    const char* cA = cur.A; const char* cB = cur.B;
    PG8_STAGE(PG8_SB(0, 0), cB, voff); PG8_STAGE(PG8_SA(0, 0), cA, voff); PG8_STAGE(PG8_SB(0, 1), cB + hstep, voff); PG8_STAGE(PG8_SA(0, 1), cA + hstep, voff);
    if (wr == 1) PG8_BAR;
    PG8_WAIT_V(4); PG8_BAR;
    PG8_STAGE(PG8_SB(1, 0), cB + kstep, voff); PG8_STAGE(PG8_SA(1, 0), cA + kstep, voff); PG8_STAGE(PG8_SB(1, 1), cB + hstep + kstep, voff);
    PG8_WAIT_V(6); PG8_BAR;
    for (;;) {
        const bool has_next = S.next(ui + 1, nxt);
        const char* nA; const char* nB;
        if (has_next) { nA = nxt.A; nB = nxt.B; } else { nA = cA; nB = cB; }
        const int nt = cur.nt;
        for (int t = 0; t < nt; t += 2) {
            const bool last = (t == nt - 2);
            const char* a1 = cA + (size_t)(t + 1) * kstep;
            const char* a2 = last ? nA : cA + (size_t)(t + 2) * kstep; const char* b2 = last ? nB : cB + (size_t)(t + 2) * kstep;
            const char* a3 = a2 + kstep; const char* b3 = b2 + kstep;
            PG8_LDB(B0, 0, 0); PG8_SCHED; PG8_LDA(At, 0, 0); PG8_STAGE(PG8_SA(1, 1), a1 + hstep, voff);
            PG8_WAIT_L(8); PG8_BAR; PG8_WAIT_L(0); PG8_MMA(0, 0, At, B0); PG8_BAR; PG8_SCHED;
            PG8_LDB(B1, 0, 1); PG8_STAGE(PG8_SB(0, 0), b2, voff);
            PG8_BAR; PG8_WAIT_L(0); PG8_MMA(0, 1, At, B1); PG8_BAR;
            PG8_LDA(At, 0, 1); PG8_STAGE(PG8_SA(0, 0), a2, voff);
            PG8_BAR; PG8_WAIT_L(0); PG8_MMA(1, 0, At, B0); PG8_BAR; PG8_SCHED;
            PG8_STAGE(PG8_SB(0, 1), b2 + hstep, voff);
            PG8_WAIT_V(6); PG8_BAR; PG8_MMA(1, 1, At, B1); PG8_BAR;
            PG8_LDB(B0, 1, 0); PG8_SCHED; PG8_LDA(At, 1, 0); PG8_STAGE(PG8_SA(0, 1), a2 + hstep, voff);
            PG8_WAIT_L(8); PG8_BAR; PG8_WAIT_L(0); PG8_MMA(0, 0, At, B0); PG8_BAR; PG8_SCHED;
            PG8_LDB(B1, 1, 1); PG8_STAGE(PG8_SB(1, 0), b3, voff);
            PG8_BAR; PG8_WAIT_L(0); PG8_MMA(0, 1, At, B1); PG8_BAR;
            PG8_LDA(At, 1, 1); PG8_STAGE(PG8_SA(1, 0), a3, voff);
            PG8_BAR; PG8_WAIT_L(0); PG8_MMA(1, 0, At, B0); PG8_BAR; PG8_SCHED;
            PG8_STAGE(PG8_SB(1, 1), b3 + hstep, voff);
            PG8_WAIT_V(6); PG8_BAR; PG8_MMA(1, 1, At, B1); PG8_BAR;
        }
        E(acc, cur, wr, wc, fr, fq);
        if (!has_next) break;
#pragma unroll
        for (int a = 0; a < 2; ++a)
#pragma unroll
            for (int b = 0; b < 2; ++b)
#pragma unroll
                for (int m = 0; m < 4; ++m)
#pragma unroll
                    for (int n = 0; n < 2; ++n) acc[a][b][m][n] = (f32x4){0.f, 0.f, 0.f, 0.f};
        cur = nxt; cA = nA; cB = nB; ++ui;
    }
    PG8_WAIT_V(0);
    if (wr == 0) PG8_BAR;
    PG8_BAR;
#undef PG8_SA
#undef PG8_SB
#undef PG8_STAGE
#undef PG8_LDA
#undef PG8_LDB
#undef PG8_MMA
#undef PG8_WAIT_V
#undef PG8_WAIT_L
#undef PG8_BAR
#undef PG8_SCHED
}
}
struct Ctx {
    const float* in[27]; float* out; unsigned char* ws;
    LAS unsigned char* lds; int tid, lane, wave, G, bid;
};
enum { I_X = 0, I_C, I_CTX, I_CCTX, I_WMOD, I_BMOD, I_LNG, I_LNB, I_FFNIN, I_FFNOUT, I_WIN, I_CONVW, I_CONVB, I_LWA, I_LBA, I_LWX, I_LBX, I_LLAM, I_SINK, I_QNORM, I_KVNORM, I_WUQ, I_WUKV, I_RDECAY, I_GNG, I_WBR, I_WOUT };
template <class T> __device__ __forceinline__ T* wsp(const Ctx& c, size_t off) { return (T*)(c.ws + off); }
__device__ __forceinline__ float* xrow_ptr(const Ctx& c, int row) { return row < NLAT ? c.out + (size_t)row * D : wsp<float>(c, WS_XC) + (size_t)(row - NLAT) * D; }
__device__ __forceinline__ const float* modp(const Ctx& c, int l, int r, int k) { return wsp<float>(c, WS_MODTAB) + ((size_t)(l * 9 + r) * 9 + k) * D; }

enum { MAP_NAT = 0, MAP_PERM32, MAP_SWIGLU, MAP_INP, MAP_GATE, MAP_UQ };
constexpr int IO_AX = 0, IO_AY = 512, IO_BQ = 1024, IO_BK = 1536, IO_BV = 1664, IO_CQ = 1792, IO_CKV = 2176, IO_CKR = 2432, IO_DQ = 2464, IO_DK = 2976, IO_DV = 3488, IO_DG = 4000, IO_GT = 4512;
enum { EK_PLAIN = 0, EK_GELU, EK_SILU, EK_ROPE16, EK_ROPE32, EK_ROPE32K, EK_VT, EK_CKR };
struct HalfTile { int kind, src, dstoff; };
__device__ __forceinline__ HalfTile inp_half(int pn, int bj) {
    const int h = pn * 2 + bj;
    switch (pn) {
        case 0: case 1:   return HalfTile{EK_PLAIN, IO_AX + 128 * h, 128 * h};
        case 2: case 3:   return HalfTile{EK_GELU, IO_AY + 128 * (h - 4), 128 * (h - 4)};
        case 4: case 5:   return HalfTile{EK_ROPE16, IO_BQ + 128 * (h - 8), 128 * (h - 8)};
        case 6:           return bj == 0 ? HalfTile{EK_ROPE16, IO_BK, 0} : HalfTile{EK_VT, IO_BV, 0};
        case 7:           return HalfTile{EK_PLAIN, IO_CQ + 128 * (h - 14), 128 * (h - 14)};
        case 8:           return bj == 0 ? HalfTile{EK_PLAIN, IO_CQ + 256, 256} : HalfTile{EK_CKR, IO_CKR, 0};
        case 9:           return HalfTile{EK_PLAIN, IO_CKV + 128 * (h - 18), 128 * (h - 18)};
        case 10: case 11: return HalfTile{EK_ROPE32, IO_DQ + 128 * (h - 20), 128 * (h - 20)};
        case 12: case 13: return HalfTile{EK_ROPE32K, IO_DK + 128 * (h - 24), 128 * (h - 24)};
        case 14: case 15: return HalfTile{EK_VT, IO_DV + 128 * (h - 28), 128 * (h - 28)};
        default:          return HalfTile{EK_SILU, IO_DG + 128 * (h - 32), 128 * (h - 32)};
    }
}
struct RowMap {
    int mode; const float* kscale; float cscale;
    __device__ __forceinline__ int col(int R, float& sc) const {
        sc = cscale;
        switch (mode) {
            case MAP_NAT: return R;
            case MAP_PERM32: return (R & ~31) + pg8::perm32(R & 31);
            case MAP_SWIGLU: { const int pn = R >> 8, cs = R & 255, bj = cs >> 7, wc = (cs >> 5) & 3, n = (cs >> 4) & 1, i = cs & 15;
                return (n ? FF : 0) + 128 * pn + 32 * wc + 8 * (i >> 2) + 4 * bj + (i & 3); }
            case MAP_GATE: return IO_GT + (R & ~31) + pg8::perm32(R & 31);
            case MAP_UQ: { const int h = R / 96, d = R % 96; if (d < 64) return 96 * h + d; const int u = (d - 64) & 15, hi = (d - 64) >> 4; return 96 * h + 64 + 16 * (u >> 3) + 8 * hi + (u & 7); }
            default: {
                const int pn = R >> 8, cs = R & 255, bj = cs >> 7, c7 = cs & 127, wc = (cs >> 5) & 3, n = (cs >> 4) & 1, i = cs & 15;
                const HalfTile ht = inp_half(pn, bj);
                switch (ht.kind) {
                    case EK_PLAIN: case EK_GELU: case EK_SILU: return ht.src + 32 * wc + pg8::perm32(cs & 31);
                    case EK_ROPE16: if (ht.src != IO_BK) sc = 0.125f * LOG2E; return ht.src + c7;
                    case EK_VT: return ht.src + c7;
                    case EK_ROPE32: return ht.src + 64 * (wc >> 1) + 32 * n + 16 * (wc & 1) + i;
                    case EK_ROPE32K: sc = 0.08838834764831845f; return ht.src + 64 * (wc >> 1) + 32 * n + 16 * (wc & 1) + i;
                    default: return c7 < 32 ? ht.src + c7 : -1;
                }
            }
        }
    }
};
__device__ __forceinline__ void conv_block(const float* W, int ldw, bf16_t* WT, int ldk, LAS float* scr, int k0, int n0, const RowMap& mp, int lane) {
    float cs; const int sc = mp.col(n0 + (lane & 31), cs);
#pragma unroll 8
    for (int i = 0; i < 32; ++i) { const int kk = 2 * i + (lane >> 5);
        float v = 0.f; if (sc >= 0) { v = W[(size_t)(k0 + kk) * ldw + sc] * cs; if (mp.kscale) v *= mp.kscale[k0 + kk]; }
        scr[kk * 33 + (lane & 31)] = v; }
    asm volatile("s_waitcnt lgkmcnt(0)" ::: "memory");
    const int c = lane & 7;
#pragma unroll
    for (int j = 0; j < 4; ++j) { const int n = (lane >> 3) + 8 * j; const LAS float* s = scr + (8 * c) * 33 + n;
        u32x4 o; o.x = cvt_pk_bf16(s[0 * 33], s[1 * 33]); o.y = cvt_pk_bf16(s[2 * 33], s[3 * 33]); o.z = cvt_pk_bf16(s[4 * 33], s[5 * 33]); o.w = cvt_pk_bf16(s[6 * 33], s[7 * 33]);
        *(u32x4*)(WT + (size_t)(n0 + n) * ldk + k0 + 8 * c) = o; }
    asm volatile("s_waitcnt lgkmcnt(0)" ::: "memory");
}
struct ConvJob { const float* W; int ldw, K, N; bf16_t* WT; int ldk; RowMap mp; };
__device__ __forceinline__ void conv_job_run(const Ctx& c, const ConvJob& j, int& base, int gw, int NGW, LAS float* scr) {
    const int nkb = j.K / 64, nnb = j.N / 32, nblk = nkb * nnb;
    int first = gw - (base % NGW); if (first < 0) first += NGW;
    for (int b = first; b < nblk; b += NGW) conv_block(j.W, j.ldw, j.WT, j.ldk, scr, 64 * (b / nnb), 32 * (b % nnb), j.mp, c.lane);
    base += nblk;
}
__device__ __forceinline__ void conv_ffn(const Ctx& c, int l, int f, int slot, int& base, int gw, int NGW, LAS float* scr) {
    bf16_t* w1t = wsp<bf16_t>(c, WS_WF + slot * WF_SLOT); bf16_t* w2t = w1t + (size_t)5632 * 1024;
    ConvJob j1{c.in[I_FFNIN] + (size_t)(l * 2 + f) * 1024 * 5632, 5632, 1024, 5632, w1t, 1024, RowMap{MAP_SWIGLU, nullptr, 1.f}};
    conv_job_run(c, j1, base, gw, NGW, scr);
    ConvJob j2{c.in[I_FFNOUT] + (size_t)(l * 2 + f) * FF * 1024, 1024, FF, 1024, w2t, FF, RowMap{MAP_NAT, nullptr, 1.f}};
    conv_job_run(c, j2, base, gw, NGW, scr);
}
__device__ __forceinline__ void conv_mixer(const Ctx& c, int l, int& base, int gw, int NGW, LAS float* scr) {
    const float* win = c.in[I_WIN] + (size_t)l * 1024 * IN_COLS;
    { ConvJob j{win, IN_COLS, 1024, NINP, wsp<bf16_t>(c, WM_INP), 1024, RowMap{MAP_INP, nullptr, 1.f}}; conv_job_run(c, j, base, gw, NGW, scr); }
    { ConvJob j{win, IN_COLS, 1024, 4096, wsp<bf16_t>(c, WM_G), 1024, RowMap{MAP_GATE, nullptr, 1.f}}; conv_job_run(c, j, base, gw, NGW, scr); }
    for (int k = 0; k < 4; ++k) {
        ConvJob j{c.in[I_WBR] + (size_t)(l * 4 + k) * 512 * 1024, 1024, 512, 1024, wsp<bf16_t>(c, WM_BR) + (size_t)(k >> 1) * 1024 * 1024 + 512 * (k & 1), 1024, RowMap{MAP_PERM32, nullptr, 1.f}}; conv_job_run(c, j, base, gw, NGW, scr); }
    { ConvJob j{c.in[I_WOUT] + (size_t)l * 1024 * 1024, 1024, 1024, 1024, wsp<bf16_t>(c, WM_OUT), 1024, RowMap{MAP_NAT, nullptr, 1.f}}; conv_job_run(c, j, base, gw, NGW, scr); }
    { ConvJob j{c.in[I_WUQ] + (size_t)l * 384 * 768, 768, 384, 768, wsp<bf16_t>(c, WM_UQ), 384, RowMap{MAP_UQ, c.in[I_QNORM] + l * 384, 0.10206207261596577f * LOG2E}}; conv_job_run(c, j, base, gw, NGW, scr); }
    { ConvJob j{c.in[I_WUKV] + (size_t)l * 256 * 1024, 1024, 256, 1024, wsp<bf16_t>(c, WM_UKV), 256, RowMap{MAP_NAT, c.in[I_KVNORM] + l * 256, 1.f}}; conv_job_run(c, j, base, gw, NGW, scr); }
    for (int m = 0; m < 32; ++m) {
        const int dir = m >> 4, gate = (m >> 3) & 1, n = m & 7;
        const float* W = (gate ? c.in[I_LWX] : c.in[I_LWA]) + (size_t)(((l * 2 + dir) * 8 + n) * 64) * 64;
        ConvJob j{W, 64, 64, 64, wsp<bf16_t>(c, WM_LRU) + (size_t)m * 4096, 64, RowMap{MAP_NAT, nullptr, 1.f}}; conv_job_run(c, j, base, gw, NGW, scr);
    }
}

__device__ __forceinline__ void p0_modtab(const Ctx& c) {
    LAS float* S = (LAS float*)c.lds;
    LAS float* R = (LAS float*)(c.lds + 9 * 1024 * 4);
    for (int i = c.tid; i < 9 * 1024; i += 512) { const int r = i >> 10, k = i & 1023; const float v = r < 8 ? c.in[I_C][r * 1024 + k] : c.in[I_CCTX][k]; S[i] = v / (1.0f + expf(-v)); }
    __syncthreads();
    for (int it = c.bid; it < 2 * 144; it += c.G) {
        const int l = it / 144, cg_ = it % 144, col = 64 * cg_ + c.lane;
        const float* W = c.in[I_WMOD] + (size_t)l * 1024 * 9216 + col;
        float acc[9];
#pragma unroll
        for (int r = 0; r < 9; ++r) acc[r] = 0.f;
        const int k0 = c.wave * 128;
#pragma unroll 2
        for (int k = k0; k < k0 + 128; k += 4) {
            const float w0 = W[(size_t)k * 9216], w1 = W[(size_t)(k + 1) * 9216], w2 = W[(size_t)(k + 2) * 9216], w3 = W[(size_t)(k + 3) * 9216];
#pragma unroll
            for (int r = 0; r < 9; ++r) { const f32x4 s = *(const LAS f32x4*)(S + r * 1024 + k); acc[r] += s.x * w0 + s.y * w1 + s.z * w2 + s.w * w3; }
        }
#pragma unroll
        for (int r = 0; r < 9; ++r) R[(c.wave * 9 + r) * 64 + c.lane] = acc[r];
        __syncthreads();
        for (int i = c.tid; i < 9 * 64; i += 512) { const int r = i >> 6, ln = i & 63; float s = 0.f;
#pragma unroll
            for (int w = 0; w < 8; ++w) s += R[(w * 9 + r) * 64 + ln];
            wsp<float>(c, WS_MODTAB)[(size_t)(l * 9 + r) * 9216 + 64 * cg_ + ln] = s + c.in[I_BMOD][l * 9216 + 64 * cg_ + ln]; }
        __syncthreads();
    }
}
__device__ __forceinline__ void p0_rope_tables(const Ctx& c) {
    if (c.bid != c.G - 1) return;
    for (int i = c.tid; i < 64 * 56; i += 512) {
        const int pos = i / 56, r = i % 56; int nf, f; float* tab;
        if (r < 8) { nf = 8; f = r; tab = wsp<float>(c, WS_CS8); } else if (r < 24) { nf = 16; f = r - 8; tab = wsp<float>(c, WS_CS16); } else { nf = 32; f = r - 24; tab = wsp<float>(c, WS_CS32); }
        const float inv = powf(10000.0f, -(float)f / (float)nf), ang = (float)pos * inv;
        tab[(pos * 2 + 0) * nf + f] = cosf(ang); tab[(pos * 2 + 1) * nf + f] = sinf(ang);
    }
}
__device__ __forceinline__ void p0_rows(const Ctx& c) {
    const int gw = c.bid * 8 + c.wave, NGW = c.G * 8;
    for (int row = gw; row < NT; row += NGW) {
        const float* src = row < NLAT ? c.in[I_X] + (size_t)row * D : c.in[I_CTX] + (size_t)(row - NLAT) * D;
        float* xr = xrow_ptr(c, row); bf16_t* hr = wsp<bf16_t>(c, WS_H) + (size_t)row * D;
        const int r = row_mod(row); const float* sh = modp(c, 0, r, 0); const float* sc = modp(c, 0, r, 1);
#pragma unroll
        for (int j = 0; j < 4; ++j) { const int col = 256 * j + 4 * c.lane;
            const f32x4 v = *(const f32x4*)(src + col), s1 = *(const f32x4*)(sc + col), s0 = *(const f32x4*)(sh + col);
            *(f32x4*)(xr + col) = v;
            const f32x4 h = v * (s1 + 1.0f) + s0; u32x2 o; o.x = cvt_pk_bf16(h.x, h.y); o.y = cvt_pk_bf16(h.z, h.w); *(u32x2*)(hr + col) = o; }
    }
}
__device__ __forceinline__ void phase_normalize(const Ctx& c, int nrows, const float* g, const float* b, int ln, int ksh, int ksc) {
    const int gw = c.bid * 8 + c.wave, NGW = c.G * 8;
    for (int row = gw; row < nrows; row += NGW) {
        float* xr = xrow_ptr(c, row);
        f32x4 v[4]; float s = 0.f;
#pragma unroll
        for (int j = 0; j < 4; ++j) { v[j] = *(const f32x4*)(xr + 256 * j + 4 * c.lane); s += (v[j].x + v[j].y) + (v[j].z + v[j].w); }
        const float mean = wave_sum(s) * (1.f / D); float s2 = 0.f;
#pragma unroll
        for (int j = 0; j < 4; ++j) { v[j] = v[j] - mean; s2 += (v[j].x * v[j].x + v[j].y * v[j].y) + (v[j].z * v[j].z + v[j].w * v[j].w); }
        const float rstd = 1.f / sqrtf(wave_sum(s2) * (1.f / D) + LN_EPS);
        const int r = row_mod(row);
#pragma unroll
        for (int j = 0; j < 4; ++j) { const int col = 256 * j + 4 * c.lane;
            const f32x4 y = v[j] * rstd * *(const f32x4*)(g + col) + *(const f32x4*)(b + col);
            *(f32x4*)(xr + col) = y;
            if (ln >= 0) { const f32x4 h = y * (*(const f32x4*)(modp(c, ln, r, ksc) + col) + 1.0f) + *(const f32x4*)(modp(c, ln, r, ksh) + col);
                u32x2 o; o.x = cvt_pk_bf16(h.x, h.y); o.y = cvt_pk_bf16(h.z, h.w); *(u32x2*)(wsp<bf16_t>(c, WS_H) + (size_t)row * D + col) = o; } }
    }
}
typedef f32x4 Acc[2][2][4][2];
struct SchedTiles {
    pg8::TileOrder ord; const char* A; const char* B; int ld, nt;
    __device__ __forceinline__ bool next(int i, pg8::Unit& u) const {
        int pm, pn; if (!ord.tile(i, pm, pn)) return false;
        u.A = A + (size_t)pm * 256 * ld * 2; u.B = B + (size_t)pn * 256 * ld * 2; u.nt = nt; u.kind = 0; u.pm = pm; u.pn = pn; u.k = 0; return true;
    }
};
struct EpiSwiglu {
    bf16_t* U;
    __device__ __forceinline__ void operator()(const Acc& acc, const pg8::Unit& u, int wr, int wc, int fr, int fq) const {
#pragma unroll
        for (int ai = 0; ai < 2; ++ai)
#pragma unroll
            for (int m = 0; m < 4; ++m) {
                const int row = u.pm * 256 + ai * 128 + wr * 64 + m * 16 + fr;
                float o[8];
#pragma unroll
                for (int bj = 0; bj < 2; ++bj)
#pragma unroll
                    for (int j = 0; j < 4; ++j) o[4 * bj + j] = siluf_(acc[ai][bj][m][0][j]) * acc[ai][bj][m][1][j];
                u32x4 w; w.x = cvt_pk_bf16(o[0], o[1]); w.y = cvt_pk_bf16(o[2], o[3]); w.z = cvt_pk_bf16(o[4], o[5]); w.w = cvt_pk_bf16(o[6], o[7]);
                *(u32x4*)(U + (size_t)row * FF + 128 * u.pn + 32 * wc + 8 * fq) = w;
            }
    }
};
struct EpiResid {
    Ctx c; int l, kg; float coef;
    __device__ __forceinline__ void operator()(const Acc& acc, const pg8::Unit& u, int wr, int wc, int fr, int fq) const {
        const float* gate = modp(c, l, row_mod(u.pm * 256), kg);
        const int col0 = u.pn * 256 + wc * 32 + 4 * fq;
        f32x4 gv[2][2];
#pragma unroll
        for (int bj = 0; bj < 2; ++bj)
#pragma unroll
            for (int n = 0; n < 2; ++n) gv[bj][n] = *(const f32x4*)(gate + col0 + bj * 128 + n * 16) * coef;
#pragma unroll
        for (int ai = 0; ai < 2; ++ai)
#pragma unroll
            for (int m = 0; m < 4; ++m) {
                float* xr = xrow_ptr(c, u.pm * 256 + ai * 128 + wr * 64 + m * 16 + fr) + col0;
#pragma unroll
                for (int bj = 0; bj < 2; ++bj)
#pragma unroll
                    for (int n = 0; n < 2; ++n) { float* p = xr + bj * 128 + n * 16; const f32x4 x = *(const f32x4*)p; *(f32x4*)p = x * DN_ALPHA + gv[bj][n] * acc[ai][bj][m][n]; }
                if (m & 1) asm volatile("" ::: "memory");
            }
    }
};
struct RowInfo { int row, b, s, prow, pcol; bool lat; };
__device__ __forceinline__ RowInfo row_info(int row) {
    RowInfo r; r.row = row; r.lat = row < NLAT;
    if (r.lat) { const int t = row & 2047; r.b = row >> 11; r.s = CTX + t; r.prow = t >> 6; r.pcol = t & 63; }
    else { const int q = row - NLAT; r.b = q >> 8; r.s = q & 255; r.prow = 0; r.pcol = 0; }
    return r;
}
struct EpiInp {
    Ctx c;
    __device__ __forceinline__ void dst_of(int src, bf16_t*& dst, int& ld) const {
        if (src < IO_AY) { dst = wsp<bf16_t>(c, P_AX); ld = 512; }
        else if (src < IO_BQ) { dst = wsp<bf16_t>(c, P_AB); ld = 1024; }
        else if (src < IO_BK) { dst = wsp<bf16_t>(c, P_AB) + 512; ld = 1024; }
        else if (src < IO_BV) { dst = wsp<bf16_t>(c, P_BK); ld = 128; }
        else if (src < IO_CKV) { dst = wsp<bf16_t>(c, P_CD) + 512; ld = 1024; }
        else if (src < IO_CKR) { dst = wsp<bf16_t>(c, P_CKV); ld = 256; }
        else if (src < IO_DQ) { dst = wsp<bf16_t>(c, P_CKR); ld = 32; }
        else if (src < IO_DK) { dst = wsp<bf16_t>(c, P_DQ); ld = 512; }
        else if (src < IO_DV) { dst = wsp<bf16_t>(c, P_DK); ld = 512; }
        else { dst = wsp<bf16_t>(c, P_CD); ld = 1024; }
    }
    __device__ __forceinline__ void operator()(const Acc& acc, const pg8::Unit& u, int wr, int wc, int fr, int fq) const {
#pragma unroll
        for (int bj = 0; bj < 2; ++bj) {
            const HalfTile ht = inp_half(u.pn, bj);
            bf16_t* dst; int ld; dst_of(ht.src, dst, ld);
            const int dcol = ht.dstoff + 32 * wc + 8 * fq;
            if (ht.kind == EK_PLAIN || ht.kind == EK_GELU || ht.kind == EK_SILU) {
#pragma unroll
                for (int ai = 0; ai < 2; ++ai)
#pragma unroll
                    for (int m = 0; m < 4; ++m) {
                        const int row = u.pm * 256 + ai * 128 + wr * 64 + m * 16 + fr;
                        float o[8];
#pragma unroll
                        for (int j = 0; j < 4; ++j) { o[j] = acc[ai][bj][m][0][j]; o[4 + j] = acc[ai][bj][m][1][j]; }
                        if (ht.kind == EK_GELU) {
#pragma unroll
                            for (int j = 0; j < 8; ++j) o[j] = geluf_(o[j]); }
                        if (ht.kind == EK_SILU) {
#pragma unroll
                            for (int j = 0; j < 8; ++j) o[j] = siluf_(o[j]); }
                        u32x4 w; w.x = cvt_pk_bf16(o[0], o[1]); w.y = cvt_pk_bf16(o[2], o[3]); w.z = cvt_pk_bf16(o[4], o[5]); w.w = cvt_pk_bf16(o[6], o[7]);
                        *(u32x4*)(dst + (size_t)row * ld + dcol) = w;
                    }
            } else if (ht.kind == EK_ROPE16 || ht.kind == EK_ROPE32 || ht.kind == EK_ROPE32K) {
                const bool r16 = ht.kind == EK_ROPE16;
                const int seg = r16 ? (wc & 1) : (wc >> 1), nf = r16 ? 16 : 32, f0 = r16 ? 4 * fq : 16 * (wc & 1) + 4 * fq;
                const float* tab = wsp<float>(c, r16 ? WS_CS16 : WS_CS32);
                const int head = (ht.dstoff >> 7);
#pragma unroll
                for (int ai = 0; ai < 2; ++ai)
#pragma unroll
                    for (int m = 0; m < 4; ++m) {
                        const RowInfo ri = row_info(u.pm * 256 + ai * 128 + wr * 64 + m * 16 + fr);
                        f32x4 x1 = acc[ai][bj][m][0], x2 = acc[ai][bj][m][1], o1 = x1, o2 = x2;
                        if (ri.lat) { const int pos = seg ? ri.pcol : ri.prow;
                            const f32x4 cs = *(const f32x4*)(tab + (pos * 2 + 0) * nf + f0), sn = *(const f32x4*)(tab + (pos * 2 + 1) * nf + f0);
                            o1 = x1 * cs - x2 * sn; o2 = x2 * cs + x1 * sn; }
                        u32x4 w; w.x = cvt_pk_bf16(o1.x, o1.y); w.y = cvt_pk_bf16(o1.z, o1.w); w.z = cvt_pk_bf16(o2.x, o2.y); w.w = cvt_pk_bf16(o2.z, o2.w);
                        *(u32x4*)(dst + (size_t)ri.row * ld + dcol) = w;
                        if (ht.kind == EK_ROPE32K) {
                            bf16_t* kt = wsp<bf16_t>(c, KT_RET) + ((size_t)(ri.b * 4 + head) * 128 + 32 * wc + 8 * fq) * SALL + (ri.s & ~31) + posperm(ri.s & 31);
                            kt[0 * SALL] = (bf16_t)(w.x & 0xffff); kt[1 * SALL] = (bf16_t)(w.x >> 16); kt[2 * SALL] = (bf16_t)(w.y & 0xffff); kt[3 * SALL] = (bf16_t)(w.y >> 16);
                            kt[4 * SALL] = (bf16_t)(w.z & 0xffff); kt[5 * SALL] = (bf16_t)(w.z >> 16); kt[6 * SALL] = (bf16_t)(w.w & 0xffff); kt[7 * SALL] = (bf16_t)(w.w >> 16);
                        }
                    }
            } else if (ht.kind == EK_VT) {
                const bool gq = ht.src == IO_BV;
#pragma unroll
                for (int ai = 0; ai < 2; ++ai)
#pragma unroll
                    for (int m = 0; m < 4; ++m) {
                        const RowInfo ri = row_info(u.pm * 256 + ai * 128 + wr * 64 + m * 16 + fr);
                        const int sp = (ri.s & ~31) + posperm(ri.s & 31);
#pragma unroll
                        for (int n = 0; n < 2; ++n) {
                            const int c7 = 32 * wc + 16 * n + 4 * fq;
                            bf16_t* vt = gq ? wsp<bf16_t>(c, VT_GQA) + ((size_t)(ri.b * 2 + (c7 >> 6)) * 64 + (c7 & 63)) * SALL + sp
                                            : wsp<bf16_t>(c, VT_RET) + ((size_t)(ri.b * 4 + (ht.dstoff >> 7)) * 128 + c7) * SALL + sp;
                            const unsigned w0 = cvt_pk_bf16(acc[ai][bj][m][n][0], acc[ai][bj][m][n][1]), w1 = cvt_pk_bf16(acc[ai][bj][m][n][2], acc[ai][bj][m][n][3]);
                            vt[0 * SALL] = (bf16_t)(w0 & 0xffff); vt[1 * SALL] = (bf16_t)(w0 >> 16); vt[2 * SALL] = (bf16_t)(w1 & 0xffff); vt[3 * SALL] = (bf16_t)(w1 >> 16);
                        }
                    }
            } else {
                if (wc == 0) {
#pragma unroll
                    for (int ai = 0; ai < 2; ++ai)
#pragma unroll
                        for (int m = 0; m < 4; ++m) {
                            const int row = u.pm * 256 + ai * 128 + wr * 64 + m * 16 + fr;
#pragma unroll
                            for (int n = 0; n < 2; ++n) { u32x2 w; w.x = cvt_pk_bf16(acc[ai][bj][m][n][0], acc[ai][bj][m][n][1]); w.y = cvt_pk_bf16(acc[ai][bj][m][n][2], acc[ai][bj][m][n][3]);
                                *(u32x2*)(dst + (size_t)row * 32 + 16 * n + 4 * fq) = w; }
                        }
                }
            }
        }
    }
};
struct SchedMerge {
    pg8::TileOrder ord; const char* H; const char* Wg; const char* Wb; const char* AB; const char* CD; int ld;
    __device__ __forceinline__ bool next(int i, pg8::Unit& u) const {
        int pm, pn; if (!ord.tile(i >> 3, pm, pn)) return false;
        const int k = (i >> 1) & 3, isP = i & 1;
        u.pm = pm; u.pn = pn; u.k = k; u.kind = isP;
        if (!isP) { u.A = H + (size_t)pm * 256 * 1024 * 2; u.B = Wg + (size_t)(k * 1024 + pn * 256) * 1024 * 2; u.nt = 16; }
        else { const char* bp = k == 0 ? AB : k == 1 ? AB + 1024 : k == 2 ? CD + 1024 : CD;
            u.A = bp + (size_t)pm * 256 * 1024 * 2; u.B = Wb + ((size_t)((k >> 1) * 1024 + pn * 256) * 1024 + 512 * (k & 1)) * 2; u.nt = 8; }
        return true;
    }
};
struct EpiMerge {
    GAS unsigned char* sig; GAS unsigned char* msum; GAS bf16_t* MG;
    __device__ __forceinline__ void operator()(const Acc& acc, const pg8::Unit& u, int wr, int wc, int fr, int fq) const {
        const unsigned toff = (unsigned)((wr * 4 + wc) * 64 + fq * 16 + fr) * 16u;
        if (u.kind == 0) {
#pragma unroll
            for (int ai = 0; ai < 2; ++ai)
#pragma unroll
                for (int bj = 0; bj < 2; ++bj)
#pragma unroll
                    for (int m = 0; m < 4; ++m) {
                        const int q = (ai * 2 + bj) * 4 + m; const f32x4 a = acc[ai][bj][m][0], b = acc[ai][bj][m][1];
                        unsigned t2 = toff; asm volatile("" : "+v"(t2));
                        u32x4 w; w.x = cvt_pk_bf16(sigmoidf_(a.x), sigmoidf_(a.y)); w.y = cvt_pk_bf16(sigmoidf_(a.z), sigmoidf_(a.w)); w.z = cvt_pk_bf16(sigmoidf_(b.x), sigmoidf_(b.y)); w.w = cvt_pk_bf16(sigmoidf_(b.z), sigmoidf_(b.w));
                        *(GAS u32x4*)(sig + q * 8192 + t2) = w;
                    }
        } else {
#pragma unroll
            for (int ai = 0; ai < 2; ++ai)
#pragma unroll
                for (int bj = 0; bj < 2; ++bj)
#pragma unroll
                    for (int m = 0; m < 4; ++m) {
                        const int q = (ai * 2 + bj) * 4 + m;
                        unsigned t2 = toff; asm volatile("" : "+v"(t2));
                        const u32x4 w = *(const GAS u32x4*)(sig + q * 8192 + t2);
                        f32x4 a = acc[ai][bj][m][0], b = acc[ai][bj][m][1];
                        if (!((DBG >> (8 + u.k)) & 1)) { a = (f32x4){0.f, 0.f, 0.f, 0.f}; b = a; }
                        a.x *= bf_lo(w.x); a.y *= bf_hi(w.x); a.z *= bf_lo(w.y); a.w *= bf_hi(w.y); b.x *= bf_lo(w.z); b.y *= bf_hi(w.z); b.z *= bf_lo(w.w); b.w *= bf_hi(w.w);
                        GAS f32x4* pm0 = (GAS f32x4*)(msum + (q * 2 + 0) * 8192 + t2); GAS f32x4* pm1 = (GAS f32x4*)(msum + (q * 2 + 1) * 8192 + t2);
                        if (u.k > 0) { a += *pm0; b += *pm1; }
                        if (u.k < 3) { *pm0 = a; *pm1 = b; }
                        else { const int row = u.pm * 256 + ai * 128 + wr * 64 + m * 16 + fr;
                            u32x4 o; o.x = cvt_pk_bf16(a.x, a.y); o.y = cvt_pk_bf16(a.z, a.w); o.z = cvt_pk_bf16(b.x, b.y); o.w = cvt_pk_bf16(b.z, b.w);
                            *(GAS u32x4*)(MG + (size_t)row * D + u.pn * 256 + bj * 128 + wc * 32 + 8 * fq) = o; }
                        asm volatile("" ::: "memory");
                    }
        }
    }
};
__device__ __forceinline__ f32x4 mfma16(bf16x8 a, bf16x8 b, f32x4 c) { return __builtin_amdgcn_mfma_f32_16x16x32_bf16(a, b, c, 0, 0, 0); }
__device__ __forceinline__ bf16x8 ldfrag(const bf16_t* p) { return *(const bf16x8*)p; }
__device__ __forceinline__ bf16x8 ldfrag_dev(const bf16_t* p) {
    const unsigned long long a = __hip_atomic_load((const unsigned long long*)p, __ATOMIC_RELAXED, __HIP_MEMORY_SCOPE_AGENT), b = __hip_atomic_load((const unsigned long long*)p + 1, __ATOMIC_RELAXED, __HIP_MEMORY_SCOPE_AGENT);
    u32x4 w; w.x = (unsigned)a; w.y = (unsigned)(a >> 32); w.z = (unsigned)b; w.w = (unsigned)(b >> 32); return __builtin_bit_cast(bf16x8, w);
}
__device__ __forceinline__ bf16x8 pack8(const f32x4 a, const f32x4 b) {
    u32x4 w; w.x = cvt_pk_bf16(a.x, a.y); w.y = cvt_pk_bf16(a.z, a.w); w.z = cvt_pk_bf16(b.x, b.y); w.w = cvt_pk_bf16(b.z, b.w); return __builtin_bit_cast(bf16x8, w);
}
__device__ __forceinline__ float sumsq8(bf16x8 v) { const u32x4 w = __builtin_bit_cast(u32x4, v); float s = 0.f;
    s += bf_lo(w.x) * bf_lo(w.x) + bf_hi(w.x) * bf_hi(w.x); s += bf_lo(w.y) * bf_lo(w.y) + bf_hi(w.y) * bf_hi(w.y);
    s += bf_lo(w.z) * bf_lo(w.z) + bf_hi(w.z) * bf_hi(w.z); s += bf_lo(w.w) * bf_lo(w.w) + bf_hi(w.w) * bf_hi(w.w); return s; }
__device__ __forceinline__ void st4bf(bf16_t* p, const f32x4 v) { u32x2 w; w.x = cvt_pk_bf16(v.x, v.y); w.y = cvt_pk_bf16(v.z, v.w); *(u32x2*)p = w; }

__device__ __forceinline__ void mla_q_item(const Ctx& c, int it) {
    const int fr = c.lane & 15, fq = c.lane >> 4, row0 = 16 * it;
    const bf16_t* A = wsp<bf16_t>(c, P_CD) + 512 + (size_t)(row0 + fr) * 1024 + 8 * fq;
    bf16x8 a[12]; float ss = 0.f;
#pragma unroll
    for (int ks = 0; ks < 12; ++ks) { a[ks] = ldfrag(A + 32 * ks); ss += sumsq8(a[ks]); }
    ss += __shfl_xor(ss, 16); ss += __shfl_xor(ss, 32);
    const float rstd = 1.0f / sqrtf(ss * (1.0f / 384.0f) + LN_EPS);
    const RowInfo ri = row_info(row0 + fr);
    const bf16_t* W = wsp<bf16_t>(c, WM_UQ) + (size_t)fr * 384 + 8 * fq;
    const int seg = fq >> 1, e0 = 4 * (fq & 1), pos = seg ? ri.pcol : ri.prow;
    const f32x4 cs = *(const f32x4*)(wsp<float>(c, WS_CS8) + (pos * 2 + 0) * 8 + e0), sn = *(const f32x4*)(wsp<float>(c, WS_CS8) + (pos * 2 + 1) * 8 + e0);
    bf16_t* Q = wsp<bf16_t>(c, WS_QF) + (size_t)(row0 + fr) * 768 + 4 * fq;
    for (int h = 0; h < 8; ++h) {
        f32x4 acc[6];
#pragma unroll
        for (int t = 0; t < 6; ++t) { acc[t] = (f32x4){0.f, 0.f, 0.f, 0.f};
#pragma unroll
            for (int ks = 0; ks < 12; ++ks) acc[t] = mfma16(ldfrag(W + (size_t)(96 * h + 16 * t) * 384 + 32 * ks), a[ks], acc[t]); }
#pragma unroll
        for (int t = 0; t < 6; ++t) acc[t] = acc[t] * rstd;
        if (ri.lat) { const f32x4 x1 = acc[4], x2 = acc[5]; acc[4] = x1 * cs - x2 * sn; acc[5] = x2 * cs + x1 * sn; }
#pragma unroll
        for (int t = 0; t < 6; ++t) st4bf(Q + 96 * h + 16 * t, acc[t]);
    }
}
__device__ __forceinline__ void mla_kv_item(const Ctx& c, int it) {
    const int fr = c.lane & 15, fq = c.lane >> 4, row0 = 16 * it;
    const bf16_t* A = wsp<bf16_t>(c, P_CKV) + (size_t)(row0 + fr) * 256 + 8 * fq;
    bf16x8 a[8]; float ss = 0.f;
#pragma unroll
    for (int ks = 0; ks < 8; ++ks) { a[ks] = ldfrag(A + 32 * ks); ss += sumsq8(a[ks]); }
    ss += __shfl_xor(ss, 16); ss += __shfl_xor(ss, 32);
    const float rstd = 1.0f / sqrtf(ss * (1.0f / 256.0f) + LN_EPS);
    f32x4 rstd4; rstd4.x = __shfl(rstd, 4 * fq + 0); rstd4.y = __shfl(rstd, 4 * fq + 1); rstd4.z = __shfl(rstd, 4 * fq + 2); rstd4.w = __shfl(rstd, 4 * fq + 3);
    const RowInfo ri = row_info(row0 + fr), r0 = row_info(row0);
    const bf16_t* W = wsp<bf16_t>(c, WM_UKV) + (size_t)fr * 256 + 8 * fq;
    u32x4 krw;
    { const int seg = fq & 1, half = fq >> 1, pos = seg ? ri.pcol : ri.prow;
      const bf16_t* kr = wsp<bf16_t>(c, P_CKR) + (size_t)(row0 + fr) * 32 + 16 * seg;
      const u32x4 w1 = *(const u32x4*)kr, w2 = *(const u32x4*)(kr + 8);
      float x1[8] = {bf_lo(w1.x), bf_hi(w1.x), bf_lo(w1.y), bf_hi(w1.y), bf_lo(w1.z), bf_hi(w1.z), bf_lo(w1.w), bf_hi(w1.w)};
      float x2[8] = {bf_lo(w2.x), bf_hi(w2.x), bf_lo(w2.y), bf_hi(w2.y), bf_lo(w2.z), bf_hi(w2.z), bf_lo(w2.w), bf_hi(w2.w)};
      float o[8];
      const float* cp = wsp<float>(c, WS_CS8) + (pos * 2 + 0) * 8; const float* sp = cp + 8;
#pragma unroll
      for (int e = 0; e < 8; ++e) { const float cc = ri.lat ? cp[e] : 1.0f, sv = ri.lat ? sp[e] : 0.0f; o[e] = half == 0 ? x1[e] * cc - x2[e] * sv : x2[e] * cc + x1[e] * sv; }
      krw.x = cvt_pk_bf16(o[0], o[1]); krw.y = cvt_pk_bf16(o[2], o[3]); krw.z = cvt_pk_bf16(o[4], o[5]); krw.w = cvt_pk_bf16(o[6], o[7]); }
    for (int h = 0; h < 8; ++h) {
        bf16_t* Kd = wsp<bf16_t>(c, WS_KF) + ((size_t)(ri.b * 8 + h) * SALL + ri.s) * 96;
        f32x4 acc[4];
#pragma unroll
        for (int t = 0; t < 4; ++t) { acc[t] = (f32x4){0.f, 0.f, 0.f, 0.f};
#pragma unroll
            for (int ks = 0; ks < 8; ++ks) acc[t] = mfma16(ldfrag(W + (size_t)(128 * h + 16 * t) * 256 + 32 * ks), a[ks], acc[t]); }
#pragma unroll
        for (int t = 0; t < 4; ++t) st4bf(Kd + 16 * t + 4 * fq, acc[t] * rstd);
        *(u32x4*)(Kd + 64 + 8 * fq) = krw;
#pragma unroll
        for (int t = 0; t < 4; ++t) { acc[t] = (f32x4){0.f, 0.f, 0.f, 0.f};
#pragma unroll
            for (int ks = 0; ks < 8; ++ks) acc[t] = mfma16(a[ks], ldfrag(W + (size_t)(128 * h + 64 + 16 * t) * 256 + 32 * ks), acc[t]); }
        bf16_t* Vd = wsp<bf16_t>(c, WS_VTM) + ((size_t)(r0.b * 8 + h) * 64 + fr) * SALL + (r0.s & ~31) + 8 * fq + 4 * ((r0.s >> 4) & 1);
#pragma unroll
        for (int t = 0; t < 4; ++t) st4bf(Vd + (size_t)16 * t * SALL, acc[t] * rstd4);
    }
}

template <int DQK, int NQT> struct AttnSt { f32x4 o[4][NQT]; float m[NQT], l[NQT]; bf16x8 q[NQT][DQK / 32]; };
template <int DQK, int NQT>
__device__ __forceinline__ void attn_init(AttnSt<DQK, NQT>& st, const bf16_t* Q, int ldq, float m0, float l0, int fr, int fq) {
#pragma unroll
    for (int qt = 0; qt < NQT; ++qt) { st.m[qt] = m0; st.l[qt] = l0;
#pragma unroll
        for (int ks = 0; ks < DQK / 32; ++ks) st.q[qt][ks] = ldfrag(Q + (size_t)(16 * qt + fr) * ldq + 32 * ks + 8 * fq);
#pragma unroll
        for (int d = 0; d < 4; ++d) st.o[d][qt] = (f32x4){0.f, 0.f, 0.f, 0.f}; }
}
template <int DQK, int NQT, bool MASK>
__device__ __forceinline__ void attn_steps(AttnSt<DQK, NQT>& st, const bf16_t* Kp, int ldk, const bf16_t* VTp, int nsteps, int qpos0, int kpos0, int fr, int fq) {
    for (int stp = 0; stp < nsteps; ++stp) {
        f32x4 s[2][NQT];
#pragma unroll
        for (int kt = 0; kt < 2; ++kt) {
            bf16x8 kf[DQK / 32];
#pragma unroll
            for (int ks = 0; ks < DQK / 32; ++ks) kf[ks] = ldfrag(Kp + (size_t)(32 * stp + 16 * kt + fr) * ldk + 32 * ks + 8 * fq);
#pragma unroll
            for (int qt = 0; qt < NQT; ++qt) { s[kt][qt] = (f32x4){0.f, 0.f, 0.f, 0.f};
#pragma unroll
                for (int ks = 0; ks < DQK / 32; ++ks) s[kt][qt] = mfma16(kf[ks], st.q[qt][ks], s[kt][qt]); }
        }
        bf16x8 vf[4];
#pragma unroll
        for (int d = 0; d < 4; ++d) vf[d] = ldfrag(VTp + (size_t)(16 * d + fr) * SALL + 32 * stp + 8 * fq);
#pragma unroll
        for (int qt = 0; qt < NQT; ++qt) {
            if (MASK) { const int qp = qpos0 + 16 * qt + fr;
#pragma unroll
                for (int kt = 0; kt < 2; ++kt)
#pragma unroll
                    for (int r = 0; r < 4; ++r) { const int dd = qp - (kpos0 + 32 * stp + 16 * kt + 4 * fq + r); if (dd > 128 || dd < -128) s[kt][qt][r] = -1e30f; } }
            float mx = fmaxf(fmaxf(fmaxf(s[0][qt].x, s[0][qt].y), fmaxf(s[0][qt].z, s[0][qt].w)), fmaxf(fmaxf(s[1][qt].x, s[1][qt].y), fmaxf(s[1][qt].z, s[1][qt].w)));
            mx = fmaxf(mx, __shfl_xor(mx, 16)); mx = fmaxf(mx, __shfl_xor(mx, 32));
            const float mn = fmaxf(st.m[qt], mx), alpha = fast_exp2(st.m[qt] - mn); st.m[qt] = mn;
            float ps = 0.f;
#pragma unroll
            for (int kt = 0; kt < 2; ++kt)
#pragma unroll
                for (int r = 0; r < 4; ++r) { float p = fast_exp2(s[kt][qt][r] - mn); if (MASK) p = s[kt][qt][r] < -1e29f ? 0.f : p; s[kt][qt][r] = p; ps += p; }
            st.l[qt] = st.l[qt] * alpha + ps;
            const bf16x8 pk = pack8(s[0][qt], s[1][qt]);
#pragma unroll
            for (int d = 0; d < 4; ++d) st.o[d][qt] = mfma16(vf[d], pk, st.o[d][qt] * alpha);
        }
    }
}
template <int DQK, int NQT>
__device__ __forceinline__ void attn_store(AttnSt<DQK, NQT>& st, bf16_t* O, int ldo, int fr, int fq) {
#pragma unroll
    for (int qt = 0; qt < NQT; ++qt) { float l = st.l[qt]; l += __shfl_xor(l, 16); l += __shfl_xor(l, 32); const float inv = 1.0f / l;
#pragma unroll
        for (int d = 0; d < 4; ++d) st4bf(O + (size_t)(16 * qt + fr) * ldo + 16 * d + 4 * fq, st.o[d][qt] * inv); }
}
__device__ __forceinline__ void gqa_item(const Ctx& c, int l, int it) {
    const int fr = c.lane & 15, fq = c.lane >> 4;
    const bool lat = it < 2048; int b, hq, tg;
    if (lat) { b = it >> 8; hq = (it >> 5) & 7; tg = it & 31; } else { const int j = it - 2048; b = j >> 5; hq = (j >> 2) & 7; tg = j & 3; }
    const int kvh = hq >> 2, row0 = lat ? b * SEQ + 64 * tg : NLAT + b * CTX + 64 * tg;
    bf16_t* Q = wsp<bf16_t>(c, P_AB) + 512 + (size_t)row0 * 1024 + hq * 64;
    const bf16_t* Kall = wsp<bf16_t>(c, P_BK) + kvh * 64;
    const bf16_t* VT = wsp<bf16_t>(c, VT_GQA) + (size_t)((b * 2 + kvh) * 64) * SALL;
    AttnSt<64, 4> st;
    attn_init<64, 4>(st, Q, 1024, c.in[I_SINK][l * 8 + hq] * LOG2E, fq == 0 ? 1.0f : 0.0f, fr, fq);
    if (lat) { const int tlo = 64 * tg - 128 < 0 ? 0 : 64 * tg - 128, thi = 64 * tg + 192 > SEQ ? SEQ : 64 * tg + 192;
        attn_steps<64, 4, true>(st, Kall + (size_t)(b * SEQ + tlo) * 128, 128, VT + CTX + tlo, (thi - tlo) >> 5, 64 * tg, tlo, fr, fq); }
    attn_steps<64, 4, false>(st, Kall + (size_t)(NLAT + b * CTX) * 128, 128, VT, 8, 0, 0, fr, fq);
    attn_store<64, 4>(st, Q, 1024, fr, fq);
}
__device__ __forceinline__ void mla_item(const Ctx& c, int it) {
    const int fr = c.lane & 15, fq = c.lane >> 4;
    const bool lat = it < 2048; int b, h, tg;
    if (lat) { b = it >> 8; h = (it >> 5) & 7; tg = it & 31; } else { const int j = it - 2048; b = j >> 5; h = (j >> 2) & 7; tg = j & 3; }
    const int row0 = lat ? b * SEQ + 64 * tg : NLAT + b * CTX + 64 * tg;
    AttnSt<96, 4> st;
    attn_init<96, 4>(st, wsp<bf16_t>(c, WS_QF) + (size_t)row0 * 768 + h * 96, 768, -1e30f, 0.0f, fr, fq);
    attn_steps<96, 4, false>(st, wsp<bf16_t>(c, WS_KF) + (size_t)((b * 8 + h) * SALL) * 96, 96, wsp<bf16_t>(c, WS_VTM) + (size_t)((b * 8 + h) * 64) * SALL, lat ? SALL / 32 : CTX / 32, 0, 0, fr, fq);
    attn_store<96, 4>(st, wsp<bf16_t>(c, P_CD) + 512 + (size_t)row0 * 1024 + h * 64, 1024, fr, fq);
}

__device__ __forceinline__ int ret_row0(int b, int p) { return p < 2 ? NLAT + b * CTX + 128 * p : b * SEQ + 128 * (p - 2); }
__device__ __forceinline__ int ret_s0(int p) { return p < 2 ? 128 * p : CTX + 128 * (p - 2); }
__device__ __forceinline__ int ret_posb(int p) { return p < 2 ? 1 - p : 2 + (17 - p); }
__device__ __forceinline__ float ret_lg2(const Ctx& c, int l, int dir, int h) { const float x = c.in[I_RDECAY][(l * 2 + dir) * 4 + h]; return -log2f(1.0f + expf(-x)); }
__device__ __forceinline__ bf16_t* ret_state(const Ctx& c, int b, int h, int dir, int pos) { return wsp<bf16_t>(c, WS_RET) + ((size_t)(((b * 4 + h) * 2 + dir) * 18 + pos)) * 16384; }
__device__ __forceinline__ void ret_kv_item(const Ctx& c, int l, int it) {
    const int fr = c.lane & 15, fq = c.lane >> 4;
    const int w = it & 7, p = (it >> 3) % 18, bh = (it >> 3) / 18, b = bh >> 2, h = bh & 3, s0 = ret_s0(p);
    const float lgf = ret_lg2(c, l, 0, h), lgb = ret_lg2(c, l, 1, h);
    const bf16_t* KT = wsp<bf16_t>(c, KT_RET) + ((size_t)(b * 4 + h) * 128 + 16 * w + fr) * SALL + s0 + 8 * fq;
    const bf16_t* VT = wsp<bf16_t>(c, VT_RET) + ((size_t)(b * 4 + h) * 128 + fr) * SALL + s0 + 8 * fq;
    bf16x8 kf[4], kb[4];
#pragma unroll
    for (int u = 0; u < 4; ++u) { const u32x4 kw = *(const u32x4*)(KT + 32 * u); float v[8] = {bf_lo(kw.x), bf_hi(kw.x), bf_lo(kw.y), bf_hi(kw.y), bf_lo(kw.z), bf_hi(kw.z), bf_lo(kw.w), bf_hi(kw.w)};
        float vf[8], vb[8];
#pragma unroll
        for (int jj = 0; jj < 8; ++jj) { const int jl = 32 * u + 16 * (jj >> 2) + 4 * fq + (jj & 3);
            if (RDBG & 64) v[jj] = bf2f(wsp<bf16_t>(c, P_DK)[(size_t)(ret_row0(b, p) + jl) * 512 + h * 128 + 16 * w + fr]); vf[jj] = v[jj] * exp2f((float)(127 - jl) * lgf); vb[jj] = v[jj] * exp2f((float)jl * lgb); }
        u32x4 o; o.x = cvt_pk_bf16(vf[0], vf[1]); o.y = cvt_pk_bf16(vf[2], vf[3]); o.z = cvt_pk_bf16(vf[4], vf[5]); o.w = cvt_pk_bf16(vf[6], vf[7]); kf[u] = __builtin_bit_cast(bf16x8, o);
        o.x = cvt_pk_bf16(vb[0], vb[1]); o.y = cvt_pk_bf16(vb[2], vb[3]); o.z = cvt_pk_bf16(vb[4], vb[5]); o.w = cvt_pk_bf16(vb[6], vb[7]); kb[u] = __builtin_bit_cast(bf16x8, o);
        if (RDBG & 32) { const u32x4 cw = {0x3c233c23u, 0x3c233c23u, 0x3c233c23u, 0x3c233c23u}; kf[u] = __builtin_bit_cast(bf16x8, cw); kb[u] = kf[u]; } }
    bf16_t* Sf = ret_state(c, b, h, 0, p) + (size_t)fr * 128 + 16 * w + 4 * fq;
    bf16_t* Sb = ret_state(c, b, h, 1, ret_posb(p)) + (size_t)fr * 128 + 16 * w + 4 * fq;
#pragma unroll 2
    for (int d = 0; d < 8; ++d) {
        f32x4 af = (f32x4){0.f, 0.f, 0.f, 0.f}, ab = af;
#pragma unroll
        for (int u = 0; u < 4; ++u) { const bf16x8 vf = ldfrag(VT + (size_t)(16 * d) * SALL + 32 * u); af = mfma16(kf[u], vf, af); ab = mfma16(kb[u], vf, ab); }
        st4bf(Sf + (size_t)(16 * d) * 128, af); st4bf(Sb + (size_t)(16 * d) * 128, ab);
    }
}
__device__ __forceinline__ void ret_prefix(const Ctx& c, int l, int e) {
    const int chain = e >> 11, off = (e & 2047) * 8, dir = chain & 1, h = (chain >> 1) & 3;
    const float dec = exp2f(128.0f * ret_lg2(c, l, dir, h));
    bf16_t* S = wsp<bf16_t>(c, WS_RET) + (size_t)chain * 18 * 16384 + off;
    u32x4 kv[18];
#pragma unroll
    for (int p = 0; p < 18; ++p) kv[p] = *(const u32x4*)(S + (size_t)p * 16384);
    float R[8];
#pragma unroll
    for (int j = 0; j < 8; ++j) R[j] = 0.f;
#pragma unroll
    for (int p = 0; p < 18; ++p) {
        u32x4 o; o.x = cvt_pk_bf16(R[0], R[1]); o.y = cvt_pk_bf16(R[2], R[3]); o.z = cvt_pk_bf16(R[4], R[5]); o.w = cvt_pk_bf16(R[6], R[7]);
        *(u32x4*)(S + (size_t)p * 16384) = o;
        R[0] = R[0] * dec + bf_lo(kv[p].x); R[1] = R[1] * dec + bf_hi(kv[p].x); R[2] = R[2] * dec + bf_lo(kv[p].y); R[3] = R[3] * dec + bf_hi(kv[p].y);
        R[4] = R[4] * dec + bf_lo(kv[p].z); R[5] = R[5] * dec + bf_hi(kv[p].z); R[6] = R[6] * dec + bf_lo(kv[p].w); R[7] = R[7] * dec + bf_hi(kv[p].w);
    }
}
__device__ __forceinline__ void ret_out_item(const Ctx& c, int l, int it) {
    const int fr = c.lane & 15, fq = c.lane >> 4;
    const int w = it & 7, p = (it >> 3) % 18, bh = (it >> 3) / 18, b = bh >> 2, h = bh & 3, s0 = ret_s0(p), row0 = ret_row0(b, p);
    const float lgf = ret_lg2(c, l, 0, h), lgb = ret_lg2(c, l, 1, h);
    const int il = 16 * w + fr;
    bf16x8 qf[4];
#pragma unroll
    for (int ks = 0; ks < 4; ++ks) qf[ks] = ldfrag(wsp<bf16_t>(c, P_DQ) + (size_t)(row0 + il) * 512 + h * 128 + 32 * ks + 8 * fq);
    f32x4 y[8];
    {
        f32x4 st[8];
        const bf16_t* K = wsp<bf16_t>(c, P_DK) + (size_t)(row0 + fr) * 512 + h * 128 + 8 * fq;
#pragma unroll
        for (int jt = 0; jt < 8; ++jt) { st[jt] = (f32x4){0.f, 0.f, 0.f, 0.f};
#pragma unroll
            for (int ks = 0; ks < 4; ++ks) st[jt] = mfma16(ldfrag(K + (size_t)(16 * jt) * 512 + 32 * ks), qf[ks], st[jt]);
#pragma unroll
            for (int r = 0; r < 4; ++r) { const int d = il - (16 * jt + 4 * fq + r); st[jt][r] *= d >= 0 ? exp2f((float)d * lgf) : exp2f((float)(-d) * lgb); } }
        const bf16_t* VT = wsp<bf16_t>(c, VT_RET) + ((size_t)(b * 4 + h) * 128 + fr) * SALL + s0 + 8 * fq;
        bf16x8 pk[4];
#pragma unroll
        for (int u = 0; u < 4; ++u) pk[u] = pack8(st[2 * u], st[2 * u + 1]);
#pragma unroll
        for (int d = 0; d < 8; ++d) { y[d] = (f32x4){0.f, 0.f, 0.f, 0.f};
#pragma unroll
            for (int u = 0; u < 4; ++u) y[d] = mfma16(ldfrag(VT + (size_t)(16 * d) * SALL + 32 * u), pk[u], y[d]);
            if (!(RDBG & 1)) y[d] = (f32x4){0.f, 0.f, 0.f, 0.f}; }
    }
    {
        const float xif = exp2f((float)(il + 1) * lgf), xib = exp2f((float)(128 - il) * lgb);
        const bf16_t* Rf = ret_state(c, b, h, 0, p) + (size_t)fr * 128 + 8 * fq;
        const bf16_t* Rb = ret_state(c, b, h, 1, ret_posb(p)) + (size_t)fr * 128 + 8 * fq;
#pragma unroll 2
        for (int d = 0; d < 8; ++d) { f32x4 cf = (f32x4){0.f, 0.f, 0.f, 0.f}, cb = cf;
#pragma unroll
            for (int ks = 0; ks < 4; ++ks) { bf16x8 rf_ = ldfrag(Rf + (size_t)(16 * d) * 128 + 32 * ks), rb_ = ldfrag(Rb + (size_t)(16 * d) * 128 + 32 * ks);
                if (RDBG & 16) { const u32x4 cw = {0x3c233c23u, 0x3c233c23u, 0x3c233c23u, 0x3c233c23u}; rf_ = __builtin_bit_cast(bf16x8, cw); rb_ = rf_; }
                cf = mfma16(rf_, qf[ks], cf); cb = mfma16(rb_, qf[ks], cb); }
            if (RDBG & 2) y[d] += cf * xif; if (RDBG & 4) y[d] += cb * xib; }
    }
    float s = 0.f;
#pragma unroll
    for (int d = 0; d < 8; ++d) s += (y[d].x + y[d].y) + (y[d].z + y[d].w);
    s += __shfl_xor(s, 16); s += __shfl_xor(s, 32);
    const float mu = s * (1.0f / 128.0f); float q = 0.f;
#pragma unroll
    for (int d = 0; d < 8; ++d) { y[d] = y[d] - mu; q += (y[d].x * y[d].x + y[d].y * y[d].y) + (y[d].z * y[d].z + y[d].w * y[d].w); }
    q += __shfl_xor(q, 16); q += __shfl_xor(q, 32);
    const float rstd = 1.0f / sqrtf(q * (1.0f / 128.0f) + LN_EPS);
    bf16_t* G = wsp<bf16_t>(c, P_CD) + (size_t)(row0 + il) * 1024 + h * 128 + 4 * fq;
    const float* gn = c.in[I_GNG] + l * 512 + h * 128 + 4 * fq;
#pragma unroll
    for (int d = 0; d < 8; ++d) { const u32x2 gw = *(const u32x2*)(G + 16 * d); const f32x4 gg = *(const f32x4*)(gn + 16 * d);
        f32x4 o = y[d] * rstd * gg; o.x *= bf_lo(gw.x); o.y *= bf_hi(gw.x); o.z *= bf_lo(gw.y); o.w *= bf_hi(gw.y); st4bf(G + 16 * d, o); }
}

__device__ __forceinline__ void lru_item(const Ctx& c, int l, int it, bool final) {
    const int n = it & 7, ch = (it >> 3) % 36, b = (it >> 3) / 36;
    const bool isctx = ch < 4; const int T = isctx ? CTX : SEQ, t0 = isctx ? 64 * ch : 64 * (ch - 4), rowbase = isctx ? NLAT + b * CTX : b * SEQ;
    LAS float* xa = (LAS float*)c.lds;
    LAS bf16_t* xab = (LAS bf16_t*)(c.lds + 16384);
    LAS float* ga = (LAS float*)(c.lds + 16384 + 9216);
    LAS float* gb = ga + 2 * 4096;
    const bf16_t* AX = wsp<bf16_t>(c, P_AX);
    const float* cw = c.in[I_CONVW] + l * 4 * 512; const float* cb = c.in[I_CONVB] + l * 512;
    for (int idx = c.tid; idx < 4096; idx += 512) { const int t = idx >> 6, e = idx & 63, cc = n * 64 + e; float v = cb[cc];
#pragma unroll
        for (int j = 0; j < 4; ++j) { const int tt = t0 + t + j - 2; if (tt >= 0 && tt < T) v += cw[j * 512 + cc] * bf2f(AX[(size_t)(rowbase + tt) * 512 + cc]); }
        xa[idx] = v; xab[t * 72 + e] = f2bf(v); }
    __syncthreads();
    {
        const int fr = c.lane & 15, fq = c.lane >> 4, dir = c.wave >> 2, et = c.wave & 3, e = 16 * et + fr, cc = n * 64 + e;
        f32x4 ar[4], ai[4];
#pragma unroll
        for (int tt = 0; tt < 4; ++tt) { ar[tt] = (f32x4){0.f, 0.f, 0.f, 0.f}; ai[tt] = ar[tt]; }
        const bf16_t* Wa = wsp<bf16_t>(c, WM_LRU) + (size_t)((dir * 2 + 0) * 8 + n) * 4096 + e * 64 + 8 * fq;
        const bf16_t* Wx = wsp<bf16_t>(c, WM_LRU) + (size_t)((dir * 2 + 1) * 8 + n) * 4096 + e * 64 + 8 * fq;
#pragma unroll
        for (int ks = 0; ks < 2; ++ks) { const bf16x8 wa = ldfrag(Wa + 32 * ks), wx = ldfrag(Wx + 32 * ks);
#pragma unroll
            for (int tt = 0; tt < 4; ++tt) { const bf16x8 xf = *(const LAS bf16x8*)(xab + (16 * tt + fr) * 72 + 32 * ks + 8 * fq); ar[tt] = mfma16(xf, wa, ar[tt]); ai[tt] = mfma16(xf, wx, ai[tt]); } }
        const float ba = c.in[I_LBA][(l * 2 + dir) * 512 + cc], bx = c.in[I_LBX][(l * 2 + dir) * 512 + cc], lam = c.in[I_LLAM][(l * 2 + dir) * 512 + cc];
        const float sp = log1pf(expf(-lam));
#pragma unroll
        for (int tt = 0; tt < 4; ++tt)
#pragma unroll
            for (int r = 0; r < 4; ++r) { const int t = 16 * tt + 4 * fq + r;
                const float rg = 1.0f / (1.0f + expf(-(ar[tt][r] + ba))), ig = 1.0f / (1.0f + expf(-(ai[tt][r] + bx)));
                const float la = -8.0f * rg * sp, a = expf(la), bt = sqrtf(1.0f - expf(2.0f * la)) * (ig * xa[t * 64 + e]);
                ga[(dir * 64 + t) * 64 + e] = a; gb[(dir * 64 + t) * 64 + e] = bt; }
    }
    __syncthreads();
    if (c.tid < 128) {
        const int dir = c.tid >> 6, e = c.tid & 63, cc = n * 64 + e;
        const int pos = dir == 0 ? ch : (isctx ? 3 - ch : 4 + (35 - ch));
        float* sum = wsp<float>(c, WS_LRUSUM) + ((size_t)(b * 2 + dir) * 36) * 1024 + cc * 2;
        float hst = 0.f, ap = 1.f;
        if (final) for (int q = 0; q < pos; ++q) { const f32x2 sq = *(const f32x2*)(sum + (size_t)q * 1024); hst = sq.x * hst + sq.y; }
        for (int i = 0; i < 64; ++i) { const int t = dir == 0 ? i : 63 - i; const float a = ga[(dir * 64 + t) * 64 + e]; hst = a * hst + gb[(dir * 64 + t) * 64 + e]; ap *= a; if (final) gb[(dir * 64 + t) * 64 + e] = hst; }
        if (!final) *(f32x2*)(sum + (size_t)pos * 1024) = (f32x2){ap, hst};
    }
    __syncthreads();
    if (final) {
        bf16_t* AY = wsp<bf16_t>(c, P_AB);
        for (int idx = c.tid; idx < 4096; idx += 512) { const int t = idx >> 6, e = idx & 63; bf16_t* p = AY + (size_t)(rowbase + t0 + t) * 1024 + n * 64 + e;
            *p = f2bf((gb[t * 64 + e] + gb[(64 + t) * 64 + e]) * bf2f(*p)); }
        __syncthreads();
    }
}
__device__ __forceinline__ void phase_m1(const Ctx& c, int l, bool last) {
    const int gw = c.bid * 8 + c.wave, NGW = c.G * 8;
    for (int it = c.bid; it < 8 * 36 * 8; it += c.G) lru_item(c, l, it, false);
    for (int it = gw; it < NT / 16; it += NGW) mla_kv_item(c, it);
    for (int it = gw; it < (last ? NLAT : NT) / 16; it += NGW) mla_q_item(c, it);
    for (int it = gw; it < 8 * 4 * 18 * 8; it += NGW) ret_kv_item(c, l, it);
}
__device__ __forceinline__ void phase_m2(const Ctx& c, int l, bool last) {
    const int gw = c.bid * 8 + c.wave, NGW = c.G * 8;
    for (int it = c.bid; it < 8 * 36 * 8; it += c.G) { if (last && ((it >> 3) % 36) < 4) continue; lru_item(c, l, it, true); }
    for (int it = gw; it < (last ? 2048 : 2304); it += NGW) mla_item(c, it);
    for (int it = gw; it < (last ? 2048 : 2304); it += NGW) gqa_item(c, l, it);
    for (int it = gw; it < 8 * 4 * 18 * 8; it += NGW) { if (last && ((it >> 3) % 18) < 2) continue; ret_out_item(c, l, it); }
}

#ifndef DBG
#define DBG 0xFFF
#endif
constexpr int LDS_BYTES = 147456, MISC_OFF = 131072 + 320;
constexpr int CW_BAR = 4096;
struct Args { const float* in[27]; float* out; unsigned char* ws; };
__device__ __forceinline__ void make_ctx(Ctx& c, const Args& args, unsigned char* lds_raw) {
    int t = threadIdx.x; asm volatile("" : "+v"(t));
#pragma unroll
    for (int i = 0; i < 27; ++i) c.in[i] = args.in[i];
    float* o = args.out; unsigned char* w = args.ws; asm volatile("" : "+s"(o), "+s"(w));
    c.out = (float*)(GAS float*)o; c.ws = (unsigned char*)(GAS unsigned char*)w; c.lds = (LAS unsigned char*)lds_raw;
    c.tid = t; c.lane = t & 63; c.wave = __builtin_amdgcn_readfirstlane(t >> 6); c.G = gridDim.x; c.bid = blockIdx.x;
}
#define CTX() Ctx c; make_ctx(c, args, lds_raw)
__global__ void __launch_bounds__(512, 2) fwd_kernel(Args args) {
    extern __shared__ __attribute__((aligned(16))) unsigned char lds_raw[];
    XcdBarrier bar;
    { CTX();
      for (int u = c.tid; u < (LDS_BYTES - 131072) / 4; u += 512) ((LAS unsigned*)(c.lds + 131072))[u] = 0u;
      __syncthreads();
      bar = xcd_barrier_post(wsp<unsigned>(c, WS_CTL) + CW_BAR, (volatile LAS unsigned*)(c.lds + MISC_OFF) + 8); }
#define GRID_BAR() xcd_barrier(bar)
#define SCR(c) ((LAS float*)((c).lds + 57344 + (c).wave * 8704))
    { CTX(); p0_modtab(c); }
    { CTX(); p0_rope_tables(c); }
    { CTX(); int base = 0; conv_ffn(c, 0, 0, 0, base, c.bid * 8 + c.wave, c.G * 8, SCR(c)); conv_mixer(c, 0, base, c.bid * 8 + c.wave, c.G * 8, SCR(c)); }
    cg::this_grid().sync();
    GRID_BAR();
    { CTX(); p0_rows(c); }
    GRID_BAR();
#pragma unroll 1
    for (int l = 0; l < DEPTH; ++l) {
        const bool last = l == DEPTH - 1;
        const int nM = last ? 64 : 72;
        const int dbg = (DBG >> (3 * l)) & 7;
        if (dbg & 1) {
        { CTX(); SchedTiles S; S.ord.init(72, 22, c.G, c.bid); S.A = (const char*)wsp<bf16_t>(c, WS_H); S.B = (const char*)wsp<bf16_t>(c, WS_WF); S.ld = 1024; S.nt = 16;
          EpiSwiglu E{wsp<bf16_t>(c, WS_U)}; pg8::gemm_stream(c.lds, c.tid, S, E); }
        GRID_BAR();
        { CTX(); SchedTiles S; S.ord.init(72, 4, c.G, c.bid); S.A = (const char*)wsp<bf16_t>(c, WS_U); S.B = (const char*)(wsp<bf16_t>(c, WS_WF) + (size_t)5632 * 1024); S.ld = FF; S.nt = 44;
          EpiResid E{c, l, 2, 0.5f}; pg8::gemm_stream(c.lds, c.tid, S, E); }
        GRID_BAR();
        }
        { CTX(); phase_normalize(c, NT, c.in[I_LNG] + l * 3 * D, c.in[I_LNB] + l * 3 * D, l, 3, 4); }
        GRID_BAR();
        if (dbg & 2) {
        { CTX(); SchedTiles S; S.ord.init(72, 18, c.G, c.bid); S.A = (const char*)wsp<bf16_t>(c, WS_H); S.B = (const char*)wsp<bf16_t>(c, WM_INP); S.ld = 1024; S.nt = 16;
          EpiInp E{c}; pg8::gemm_stream(c.lds, c.tid, S, E); }
        GRID_BAR();
        { CTX(); phase_m1(c, l, last); }
        GRID_BAR();
        if (!(RDBG & 8)) { CTX(); for (int e = c.bid * 512 + c.tid; e < 64 * 2048; e += c.G * 512) ret_prefix(c, l, e); }
        GRID_BAR();
        { CTX(); phase_m2(c, l, last); }
        GRID_BAR();
        { CTX(); SchedMerge S; S.ord.init(nM, 4, c.G, c.bid); S.H = (const char*)wsp<bf16_t>(c, WS_H); S.Wg = (const char*)wsp<bf16_t>(c, WM_G); S.Wb = (const char*)wsp<bf16_t>(c, WM_BR);
          S.AB = (const char*)wsp<bf16_t>(c, P_AB); S.CD = (const char*)wsp<bf16_t>(c, P_CD); S.ld = 1024;
          EpiMerge E{(GAS unsigned char*)(c.ws + WS_SCR_SIG + (size_t)c.bid * 131072), (GAS unsigned char*)(c.ws + WS_SCR_M + (size_t)c.bid * 262144), (GAS bf16_t*)wsp<bf16_t>(c, WS_MG)}; pg8::gemm_stream(c.lds, c.tid, S, E); }
        GRID_BAR();
        { CTX(); SchedTiles S; S.ord.init(nM, 4, c.G, c.bid); S.A = (const char*)wsp<bf16_t>(c, WS_MG); S.B = (const char*)wsp<bf16_t>(c, WM_OUT); S.ld = 1024; S.nt = 16;
          EpiResid E{c, l, 5, 1.0f}; pg8::gemm_stream(c.lds, c.tid, S, E); }
        GRID_BAR();
        }
        { CTX(); phase_normalize(c, nM * 256, c.in[I_LNG] + (l * 3 + 1) * D, c.in[I_LNB] + (l * 3 + 1) * D, l, 6, 7); }
        { CTX(); int base = 0; const int gw = c.bid * 8 + c.wave, NGW = c.G * 8; conv_ffn(c, l, 1, 1, base, gw, NGW, SCR(c)); if (!last) { conv_ffn(c, l + 1, 0, 0, base, gw, NGW, SCR(c)); conv_mixer(c, l + 1, base, gw, NGW, SCR(c)); } }
        GRID_BAR();
        if (dbg & 4) {
        { CTX(); SchedTiles S; S.ord.init(nM, 22, c.G, c.bid); S.A = (const char*)wsp<bf16_t>(c, WS_H); S.B = (const char*)wsp<bf16_t>(c, WS_WF + WF_SLOT); S.ld = 1024; S.nt = 16;
          EpiSwiglu E{wsp<bf16_t>(c, WS_U)}; pg8::gemm_stream(c.lds, c.tid, S, E); }
        GRID_BAR();
        { CTX(); SchedTiles S; S.ord.init(nM, 4, c.G, c.bid); S.A = (const char*)wsp<bf16_t>(c, WS_U); S.B = (const char*)(wsp<bf16_t>(c, WS_WF + WF_SLOT) + (size_t)5632 * 1024); S.ld = FF; S.nt = 44;
          EpiResid E{c, l, 8, 0.5f}; pg8::gemm_stream(c.lds, c.tid, S, E); }
        GRID_BAR();
        }
        { CTX(); phase_normalize(c, nM * 256, c.in[I_LNG] + (l * 3 + 2) * D, c.in[I_LNB] + (l * 3 + 2) * D, last ? -1 : l + 1, 0, 1); }
        if (!last) GRID_BAR();
    }
}

extern "C" void kernel_launch(void* const* d_in, const int* in_sizes, int n_in, void* d_out, int out_size, void* d_ws, size_t ws_size, hipStream_t stream) {
    static int grid = 0;
    if (grid == 0) {
        if (n_in != 27 || out_size != NLAT * D || ws_size < WS_END) { fprintf(stderr, "kernel_launch: unexpected problem (n_in %d, out %d, ws %zu < %zu)\n", n_in, out_size, ws_size, (size_t)WS_END); grid = -1; return; }
        int dev = 0, cus = 0, per_cu = 0;
        hipGetDevice(&dev); hipDeviceGetAttribute(&cus, hipDeviceAttributeMultiprocessorCount, dev);
        hipFuncSetAttribute((const void*)fwd_kernel, hipFuncAttributeMaxDynamicSharedMemorySize, LDS_BYTES);
        hipOccupancyMaxActiveBlocksPerMultiprocessor(&per_cu, (const void*)fwd_kernel, 512, LDS_BYTES);
        if (per_cu < 1) { fprintf(stderr, "kernel_launch: occupancy query says %d workgroups per CU\n", per_cu); per_cu = 1; }
        (void)hipGetLastError();
        grid = cus;
    }
    if (grid < 0) return;
    hipMemsetAsync((char*)d_ws + WS_CTL, 0, CTL_BYTES, stream);
    Args a{};
    for (int i = 0; i < 27; ++i) a.in[i] = (const float*)d_in[i];
    a.out = (float*)d_out; a.ws = (unsigned char*)d_ws;
    void* kargs[] = {&a};
    hipError_t e = hipLaunchCooperativeKernel((const void*)fwd_kernel, dim3(grid), dim3(512), kargs, LDS_BYTES, stream);
    if (e != hipSuccess) fprintf(stderr, "cooperative launch failed: %s (grid %d)\n", hipGetErrorString(e), grid);
}
```

```cpp
#include <hip/hip_runtime.h>
#include <hip/hip_cooperative_groups.h>
#include <cstdio>
#include <cstdint>
namespace cg = cooperative_groups;
#ifndef DBG
#define DBG 0xFFF
#endif
#ifndef RDBG
#define RDBG 7
#endif
#ifndef TW
#define TW 0
#endif

#define LAS __attribute__((address_space(3)))
#define GAS __attribute__((address_space(1)))
typedef unsigned short bf16_t;
typedef short bf16x8 __attribute__((ext_vector_type(8)));
typedef float f32x4 __attribute__((ext_vector_type(4)));
typedef float f32x2 __attribute__((ext_vector_type(2)));
typedef unsigned u32x4 __attribute__((ext_vector_type(4)));
typedef unsigned u32x2 __attribute__((ext_vector_type(2)));

constexpr int D = 1024, NB = 8, SEQ = 2048, CTX = 256, DEPTH = 2, FF = 2816;
constexpr int NLAT = NB * SEQ;
constexpr int NCTX = NB * CTX;
constexpr int NT = NLAT + NCTX;
constexpr int SALL = CTX + SEQ;
constexpr int IN_COLS = 8608, NINP = 4608;
constexpr float LN_EPS = 1e-5f;
constexpr float DN_ALPHA = 1.41421356237309515f;
constexpr float LOG2E = 1.44269504088896341f;

constexpr size_t MiB = 1u << 20;
constexpr size_t WS_CTL = 0, CTL_BYTES = 1 * MiB;
constexpr size_t WS_MISC = 1 * MiB;
constexpr size_t WS_MODTAB = WS_MISC;
constexpr size_t WS_CS8 = WS_MISC + 1 * MiB;
constexpr size_t WS_CS16 = WS_CS8 + 64 * 8 * 2 * 4;
constexpr size_t WS_CS32 = WS_CS16 + 64 * 16 * 2 * 4;
constexpr size_t WS_LRUSUM = WS_MISC + 1 * MiB + 512 * 1024;
constexpr size_t WS_WM = 5 * MiB;
constexpr size_t WM_INP = WS_WM, WM_G = WS_WM + 9 * MiB, WM_BR = WS_WM + 17 * MiB, WM_OUT = WS_WM + 21 * MiB, WM_UQ = WS_WM + 23 * MiB  , WM_UKV = WS_WM + 24 * MiB + 512 * 1024  , WM_LRU = WS_MISC + 1 * MiB + 64 * 1024;
constexpr size_t WS_XC = 30 * MiB;
constexpr size_t WS_H = 38 * MiB;
constexpr size_t WS_QF = 74 * MiB;
constexpr size_t WS_KF = 101 * MiB;
constexpr size_t WS_VTM = 128 * MiB;
constexpr size_t WS_MG = WS_KF;
constexpr size_t WS_RET = 146 * MiB;
constexpr size_t WS_BIG = 182 * MiB;
constexpr size_t P_AX = WS_BIG, P_DQ = WS_BIG + 18 * MiB, P_DK = WS_BIG + 36 * MiB, VT_RET = WS_BIG + 54 * MiB, KT_RET = WS_BIG + 72 * MiB, VT_GQA = WS_BIG + 90 * MiB;
constexpr size_t P_BK = WS_BIG + 94 * MiB + 512 * 1024;
constexpr size_t P_AB = WS_BIG + 99 * MiB;
constexpr size_t P_CD = WS_BIG + 135 * MiB;
constexpr size_t P_CKV = WS_BIG + 171 * MiB, P_CKR = P_CKV + (size_t)NT * 256 * 2;
constexpr size_t ST_CQ = P_CKR + (size_t)NT * 32 * 2  , ST_CKV = ST_CQ + (size_t)NT * 12 * 4  , WS_END = ST_CKV + (size_t)NT * 8 * 4;
constexpr size_t WS_U = WS_BIG;
constexpr size_t WS_WF = WS_BIG + 99 * MiB;
constexpr size_t WF_SLOT = (size_t)(5632 * 1024 + 1024 * 2816) * 2;
constexpr size_t WS_SCR_SIG = WS_BIG, WS_SCR_M = WS_BIG + 32 * MiB;
static_assert(WS_WF + 2 * WF_SLOT <= WS_END && WS_U + (size_t)NT * FF * 2 <= WS_WF, "FFN overlay");
static_assert(WS_SCR_M + 64 * MiB <= P_AB, "merge scratch overlay");

typedef __bf16 bf16x2_t __attribute__((ext_vector_type(2)));
__device__ __forceinline__ unsigned cvt_pk_bf16(float lo, float hi) { bf16x2_t v; v.x = (__bf16)lo; v.y = (__bf16)hi; return __builtin_bit_cast(unsigned, v); }
__device__ __forceinline__ float bf_lo(unsigned w) { return __uint_as_float(w << 16); }
__device__ __forceinline__ float bf_hi(unsigned w) { return __uint_as_float(w & 0xffff0000u); }
__device__ __forceinline__ float bf2f(bf16_t b) { return __uint_as_float(((unsigned)b) << 16); }
__device__ __forceinline__ bf16_t f2bf(float f) { return (bf16_t)(cvt_pk_bf16(f, 0.f) & 0xffffu); }
__device__ __forceinline__ float fast_exp2(float x) { return __builtin_amdgcn_exp2f(x); }
__device__ __forceinline__ float fast_rcp(float x) { return __builtin_amdgcn_rcpf(x); }
__device__ __forceinline__ float sigmoidf_(float x) { return fast_rcp(1.0f + fast_exp2(-LOG2E * x)); }
__device__ __forceinline__ float siluf_(float x) { return x * sigmoidf_(x); }
__device__ __forceinline__ float geluf_(float v) { return v * sigmoidf_(1.5957691216057308f * (v + 0.044715f * v * v * v)); }
__device__ __forceinline__ float wave_sum(float v) {
#pragma unroll
    for (int o = 1; o < 64; o <<= 1) v += __shfl_xor(v, o);
    return v;
}
__device__ __forceinline__ int row_mod(int row) { return row < NLAT ? (row >> 11) : 8; }
__device__ __forceinline__ int posperm(int key) { return 8 * ((key >> 2) & 3) + 4 * ((key >> 4) & 1) + (key & 3); }
#define XB_TMO      128
#define XB_XCNT(j)  (256  + 64 * (j))
#define XB_XSUB(j)  (1280 + 64 * (j))
#define XB_XGEN(j)  (2304 + 64 * (j))
#define XB_TOP      3328
#define XB_TOPGEN   3392
#define XCD_BAR_WORDS 3456
#define XB_SPIN_CAP (1u << 20)
__device__ __forceinline__ unsigned xb_ld(unsigned* p)              { return __hip_atomic_load(p, __ATOMIC_RELAXED, __HIP_MEMORY_SCOPE_AGENT); }
__device__ __forceinline__ unsigned xb_add(unsigned* p, unsigned v) { return __hip_atomic_fetch_add(p, v, __ATOMIC_RELAXED, __HIP_MEMORY_SCOPE_AGENT); }
__device__ __forceinline__ unsigned xb_xcc_id() { return (unsigned)__builtin_amdgcn_s_getreg((3 << 11) | 20) & 0xFu; }
#define XB_SPIN(cond, bar) do { unsigned _sp = 0; while (cond) { __builtin_amdgcn_s_sleep(1); \
    if ((++_sp & 255u) == 0u) { if (xb_ld(&(bar)[XB_TMO])) break; if (_sp > XB_SPIN_CAP) { atomicAdd(&(bar)[XB_TMO], 1u); break; } } } } while (0)
struct XcdBarrier { unsigned* bar; unsigned x; volatile LAS unsigned* st; };
__device__ __forceinline__ XcdBarrier xcd_barrier_post(unsigned* bar, volatile LAS unsigned* st) {
    XcdBarrier b; b.bar = bar; b.x = xb_xcc_id(); b.st = st;
    if (threadIdx.x == 0) (void)xb_add(&bar[XB_XCNT(b.x)], 1u);
    return b;
}
__device__ __forceinline__ void xcd_barrier_complete(unsigned* bar, unsigned x, unsigned& nloc, unsigned& nx) {
    const unsigned G = gridDim.x * gridDim.y * gridDim.z;
    unsigned sum, cnt, mine, sp = 0u;
    for (;;) {
        sum = 0u; cnt = 0u; mine = 0u;
#pragma unroll
        for (unsigned j = 0; j < 16; ++j) { const unsigned c = xb_ld(&bar[XB_XCNT(j)]); sum += c; cnt += (c > 0u) ? 1u : 0u; mine = (j == x) ? c : mine; }
        if (sum == G) break;
        __builtin_amdgcn_s_sleep(1);
        if ((++sp & 255u) == 0u) { if (xb_ld(&bar[XB_TMO])) break; if (sp > XB_SPIN_CAP) { atomicAdd(&bar[XB_TMO], 1u); break; } }
    }
    nloc = mine > 0u ? mine : 1u; nx = cnt > 0u ? cnt : 1u;
}
__device__ __forceinline__ void xcd_barrier(const XcdBarrier& b) {
    asm volatile("s_waitcnt vmcnt(0)" ::: "memory");
    __syncthreads();
    if (threadIdx.x == 0) {
        unsigned* bar = b.bar; asm volatile("" : "+s"(bar));
        bar = (unsigned*)(GAS unsigned*)bar;
        unsigned bx = b.x; asm volatile("" : "+s"(bx));
        __builtin_amdgcn_s_waitcnt(0);
        unsigned nloc = b.st[0], nx = b.st[1];
        if (nloc == 0u) { xcd_barrier_complete(bar, bx, nloc, nx); b.st[0] = nloc; b.st[1] = nx; }
        const unsigned old = xb_add(&bar[XB_XSUB(bx)], 1u);
        const unsigned gen = old / nloc;
        if (old + 1u == (gen + 1u) * nloc) {
            __builtin_amdgcn_fence(__ATOMIC_RELEASE, "agent");
            asm volatile("s_waitcnt vmcnt(0)" ::: "memory");
            const unsigned og = xb_add(&bar[XB_TOP], 1u);
            const unsigned tg = og / nx;
            if (og + 1u == (tg + 1u) * nx) xb_add(&bar[XB_TOPGEN], 1u);
            else XB_SPIN(xb_ld(&bar[XB_TOPGEN]) == tg, bar);
            __builtin_amdgcn_fence(__ATOMIC_ACQUIRE, "agent");
            xb_add(&bar[XB_XGEN(bx)], 1u);
            asm volatile("s_waitcnt vmcnt(0)" ::: "memory");
        } else {
            XB_SPIN(xb_ld(&bar[XB_XGEN(bx)]) == gen, bar);
            __builtin_amdgcn_fence(__ATOMIC_ACQUIRE, "agent");
            asm volatile("s_waitcnt vmcnt(0)" ::: "memory");
        }
    }
    __syncthreads();
}

namespace pg8 {
constexpr int BM = 256, BK = 64, HALF = 128, HTB = HALF * BK * 2, STAGE_BYTES = 8 * HTB, NXCD = 8, WGM = 8;
__host__ __device__ __forceinline__ int lds_byte(int r, int c) { const int st = (r >> 4) * 2 + (c >> 5), rr = r & 15, cc = c & 31, ob = rr * 64 + cc * 2; return st * 1024 + (ob ^ (((ob >> 9) & 1) << 5)); }
__host__ __device__ __forceinline__ void stage_rc(int b, int& R, int& C) { const int st = b / 1024, sb = b % 1024, swz = sb ^ (((sb >> 9) & 1) << 5); R = (st >> 1) * 16 + swz / 64; C = (st & 1) * 32 + (swz % 64) / 2; }
__host__ __device__ __forceinline__ int perm32(int rho) { const int n = rho >> 4, i = rho & 15; return 8 * (i >> 2) + 4 * n + (i & 3); }

struct Unit { const char* A; const char* B; int nt, kind, pm, pn, k; };

struct TileOrder {
    int nM, nN, nwg, G, c;
    __device__ void init(int nM_, int nN_, int G_, int c_) { nM = nM_; nN = nN_; nwg = nM * nN; G = G_; c = c_; }
    __device__ bool tile(int i, int& pm, int& pn) const {
        const long L = (long)i * G + c; if (L >= nwg) return false;
        int wgid = (int)L; { const int q = nwg / NXCD, r = nwg % NXCD, xcd = wgid % NXCD, off = wgid / NXCD; wgid = (xcd < r ? xcd * (q + 1) : r * (q + 1) + (xcd - r) * q) + off; }
        const int nig = WGM * nN, gid = wgid / nig, fm = gid * WGM, gsz = (nM - fm) < WGM ? (nM - fm) : WGM;
        pm = fm + ((wgid % nig) % gsz); pn = (wgid % nig) / gsz; return true;
    }
};

template <class Epi, class Sched>
__device__ __forceinline__ void gemm_stream(LAS unsigned char* lds, const int tid, const Sched& S, const Epi& E) {
    const int wid = __builtin_amdgcn_readfirstlane(tid >> 6), lane = tid & 63, wr = wid >> 2, wc = wid & 3, fr = lane & 15, fq = lane >> 4;
    unsigned voff[2];
#pragma unroll
    for (int i = 0; i < 2; ++i) { int R, C; stage_rc(tid * 16 + i * 8192, R, C); voff[i] = (unsigned)(R * S.ld + C) * 2u; }
    const size_t hstep = (size_t)HALF * S.ld * 2;
    const size_t kstep = (size_t)(BK * 2);
    const unsigned ldsw = (unsigned)wid * 1024u;
    const int aoff = lds_byte(wr * 64 + fr, fq * 8), boff = lds_byte(wc * 32 + fr, fq * 8);
#define PG8_SA(b, h) (((b) * 2 + (h)) * HTB)
#define PG8_SB(b, h) ((4 + (b) * 2 + (h)) * HTB)
#define PG8_STAGE(bufoff, gbase, voff) do { _Pragma("unroll") for (int _i = 0; _i < 2; ++_i) \
        __builtin_amdgcn_global_load_lds((const unsigned*)((const char*)(gbase) + (voff)[_i]), (LAS unsigned*)(lds + (bufoff) + ldsw + _i * 8192), 16, 0, 0); } while (0)
#define PG8_LDA(dst, b, h) do { _Pragma("unroll") for (int m = 0; m < 4; ++m) _Pragma("unroll") for (int k = 0; k < 2; ++k) dst[m][k] = *(const LAS bf16x8*)(lds + PG8_SA(b, h) + aoff + m * 2048 + k * 1024); } while (0)
#define PG8_LDB(dst, b, h) do { _Pragma("unroll") for (int n = 0; n < 2; ++n) _Pragma("unroll") for (int k = 0; k < 2; ++k) dst[n][k] = *(const LAS bf16x8*)(lds + PG8_SB(b, h) + boff + n * 2048 + k * 1024); } while (0)
#define PG8_MMA(ai, bj, At, Bt) do { __builtin_amdgcn_s_setprio(1); _Pragma("unroll") for (int m = 0; m < 4; ++m) _Pragma("unroll") for (int n = 0; n < 2; ++n) _Pragma("unroll") for (int k = 0; k < 2; ++k) \
        acc[ai][bj][m][n] = __builtin_amdgcn_mfma_f32_16x16x32_bf16(Bt[n][k], At[m][k], acc[ai][bj][m][n], 0, 0, 0); __builtin_amdgcn_s_setprio(0); } while (0)
#define PG8_WAIT_V(n) asm volatile("s_waitcnt vmcnt(" #n ")" ::: "memory")
#define PG8_WAIT_L(n) asm volatile("s_waitcnt lgkmcnt(" #n ")" ::: "memory")
#define PG8_BAR __builtin_amdgcn_s_barrier()
#define PG8_SCHED __builtin_amdgcn_sched_barrier(0)
    Unit cur, nxt; int ui = 0;
    if (!S.next(0, cur)) return;
    f32x4 acc[2][2][4][2];
#pragma unroll
    for (int a = 0; a < 2; ++a)
#pragma unroll
        for (int b = 0; b < 2; ++b)
#pragma unroll
            for (int m = 0; m < 4; ++m)
#pragma unroll
                for (int n = 0; n < 2; ++n) acc[a][b][m][n] = (f32x4){0.f, 0.f, 0.f, 0.f};
    bf16x8 At[4][2], B0[2][2], B1[2][2];
    const char* cA = cur.A; const char* cB = cur.B;
    PG8_STAGE(PG8_SB(0, 0), cB, voff); PG8_STAGE(PG8_SA(0, 0), cA, voff); PG8_STAGE(PG8_SB(0, 1), cB + hstep, voff); PG8_STAGE(PG8_SA(0, 1), cA + hstep, voff);
    if (wr == 1) PG8_BAR;
    PG8_WAIT_V(4); PG8_BAR;
    PG8_STAGE(PG8_SB(1, 0), cB + kstep, voff); PG8_STAGE(PG8_SA(1, 0), cA + kstep, voff); PG8_STAGE(PG8_SB(1, 1), cB + hstep + kstep, voff);
    PG8_WAIT_V(6); PG8_BAR;
    for (;;) {
        const bool has_next = S.next(ui + 1, nxt);
        const char* nA; const char* nB;
        if (has_next) { nA = nxt.A; nB = nxt.B; } else { nA = cA; nB = cB; }
        const int nt = cur.nt;
        for (int t = 0; t < nt; t += 2) {
            const bool last = (t == nt - 2);
            const char* a1 = cA + (size_t)(t + 1) * kstep;
            const char* a2 = last ? nA : cA + (size_t)(t + 2) * kstep; const char* b2 = last ? nB : cB + (size_t)(t + 2) * kstep;
            const char* a3 = a2 + kstep; const char* b3 = b2 + kstep;
            PG8_LDB(B0, 0, 0); PG8_SCHED; PG8_LDA(At, 0, 0); PG8_STAGE(PG8_SA(1, 1), a1 + hstep, voff);
            PG8_WAIT_L(8); PG8_BAR; PG8_WAIT_L(0); PG8_MMA(0, 0, At, B0); PG8_BAR; PG8_SCHED;
            PG8_LDB(B1, 0, 1); PG8_STAGE(PG8_SB(0, 0), b2, voff);
            PG8_BAR; PG8_WAIT_L(0); PG8_MMA(0, 1, At, B1); PG8_BAR;
            PG8_LDA(At, 0, 1); PG8_STAGE(PG8_SA(0, 0), a2, voff);
            PG8_BAR; PG8_WAIT_L(0); PG8_MMA(1, 0, At, B0); PG8_BAR; PG8_SCHED;
            PG8_STAGE(PG8_SB(0, 1), b2 + hstep, voff);
            PG8_WAIT_V(6); PG8_BAR; PG8_MMA(1, 1, At, B1); PG8_BAR;
            PG8_LDB(B0, 1, 0); PG8_SCHED; PG8_LDA(At, 1, 0); PG8_STAGE(PG8_SA(0, 1), a2 + hstep, voff);
            PG8_WAIT_L(8); PG8_BAR; PG8_WAIT_L(0); PG8_MMA(0, 0, At, B0); PG8_BAR; PG8_SCHED;
            PG8_LDB(B1, 1, 1); PG8_STAGE(PG8_SB(1, 0), b3, voff);
            PG8_BAR; PG8_WAIT_L(0); PG8_MMA(0, 1, At, B1); PG8_BAR;
            PG8_LDA(At, 1, 1); PG8_STAGE(PG8_SA(1, 0), a3, voff);
            PG8_BAR; PG8_WAIT_L(0); PG8_MMA(1, 0, At, B0); PG8_BAR; PG8_SCHED;
            PG8_STAGE(PG8_SB(1, 1), b3 + hstep, voff);
            PG8_WAIT_V(6); PG8_BAR; PG8_MMA(1, 1, At, B1); PG8_BAR;
        }
        E(acc, cur, wr, wc, fr, fq);
        if (!has_next) break;
#pragma unroll
        for (int a = 0; a < 2; ++a)
#pragma unroll
            for (int b = 0; b < 2; ++b)
#pragma unroll
                for (int m = 0; m < 4; ++m)
#pragma unroll
                    for (int n = 0; n < 2; ++n) acc[a][b][m][n] = (f32x4){0.f, 0.f, 0.f, 0.f};
        cur = nxt; cA = nA; cB = nB; ++ui;
    }
    PG8_WAIT_V(0);
    if (wr == 0) PG8_BAR;
    PG8_BAR;
#undef PG8_SA
#undef PG8_SB
#undef PG8_STAGE
#undef PG8_LDA
#undef PG8_LDB
#undef PG8_MMA
#undef PG8_WAIT_V
#undef PG8_WAIT_L
#undef PG8_BAR
#undef PG8_SCHED
}
}
struct Ctx {
    const float* in[27]; float* out; unsigned char* ws;
    LAS unsigned char* lds; int tid, lane, wave, G, bid;
};
enum { I_X = 0, I_C, I_CTX, I_CCTX, I_WMOD, I_BMOD, I_LNG, I_LNB, I_FFNIN, I_FFNOUT, I_WIN, I_CONVW, I_CONVB, I_LWA, I_LBA, I_LWX, I_LBX, I_LLAM, I_SINK, I_QNORM, I_KVNORM, I_WUQ, I_WUKV, I_RDECAY, I_GNG, I_WBR, I_WOUT };
template <class T> __device__ __forceinline__ T* wsp(const Ctx& c, size_t off) { return (T*)(c.ws + off); }
__device__ __forceinline__ float* xrow_ptr(const Ctx& c, int row) { return row < NLAT ? c.out + (size_t)row * D : wsp<float>(c, WS_XC) + (size_t)(row - NLAT) * D; }
__device__ __forceinline__ const float* modp(const Ctx& c, int l, int r, int k) { return wsp<float>(c, WS_MODTAB) + ((size_t)(l * 9 + r) * 9 + k) * D; }

enum { MAP_NAT = 0, MAP_PERM32, MAP_SWIGLU, MAP_INP, MAP_GATE, MAP_UQ, MAP_UKV };
constexpr int IO_AX = 0, IO_AY = 512, IO_BQ = 1024, IO_BK = 1536, IO_BV = 1664, IO_CQ = 1792, IO_CKV = 2176, IO_CKR = 2432, IO_DQ = 2464, IO_DK = 2976, IO_DV = 3488, IO_DG = 4000, IO_GT = 4512;
enum { EK_PLAIN = 0, EK_GELU, EK_SILU, EK_ROPE16, EK_ROPE32, EK_ROPE32K, EK_VT, EK_CKR };
struct HalfTile { int kind, src, dstoff; };
__device__ __forceinline__ HalfTile inp_half(int pn, int bj) {
    const int h = pn * 2 + bj;
    switch (pn) {
        case 0: case 1:   return HalfTile{EK_PLAIN, IO_AX + 128 * h, 128 * h};
        case 2: case 3:   return HalfTile{EK_GELU, IO_AY + 128 * (h - 4), 128 * (h - 4)};
        case 4: case 5:   return HalfTile{EK_ROPE16, IO_BQ + 128 * (h - 8), 128 * (h - 8)};
        case 6:           return bj == 0 ? HalfTile{EK_ROPE16, IO_BK, 0} : HalfTile{EK_VT, IO_BV, 0};
        case 7:           return HalfTile{EK_PLAIN, IO_CQ + 128 * (h - 14), 128 * (h - 14)};
        case 8:           return bj == 0 ? HalfTile{EK_PLAIN, IO_CQ + 256, 256} : HalfTile{EK_CKR, IO_CKR, 0};
        case 9:           return HalfTile{EK_PLAIN, IO_CKV + 128 * (h - 18), 128 * (h - 18)};
        case 10: case 11: return HalfTile{EK_ROPE32, IO_DQ + 128 * (h - 20), 128 * (h - 20)};
        case 12: case 13: return HalfTile{EK_ROPE32K, IO_DK + 128 * (h - 24), 128 * (h - 24)};
        case 14: case 15: return HalfTile{EK_VT, IO_DV + 128 * (h - 28), 128 * (h - 28)};
        default:          return HalfTile{EK_SILU, IO_DG + 128 * (h - 32), 128 * (h - 32)};
    }
}
struct RowMap {
    int mode; const float* kscale; float cscale;
    __device__ __forceinline__ int col(int R, float& sc) const {
        sc = cscale;
        switch (mode) {
            case MAP_NAT: return R;
            case MAP_PERM32: return (R & ~31) + pg8::perm32(R & 31);
            case MAP_SWIGLU: { const int pn = R >> 8, cs = R & 255, bj = cs >> 7, wc = (cs >> 5) & 3, n = (cs >> 4) & 1, i = cs & 15;
                return (n ? FF : 0) + 128 * pn + 32 * wc + 8 * (i >> 2) + 4 * bj + (i & 3); }
            case MAP_GATE: return IO_GT + (R & ~31) + pg8::perm32(R & 31);
            case MAP_UQ: {
                const int g = R >> 5, h = g / 3, gi = g % 3, rho = R & 31, n = rho >> 4, i = rho & 15;
                if (gi < 2) return 96 * h + 32 * gi + pg8::perm32(rho);
                return 96 * h + 64 + 16 * (i >> 3) + 8 * n + (i & 7); }
            case MAP_UKV: {
                const int g = R >> 5, h = g >> 2, gi = g & 3, rho = R & 31;
                if (gi < 2) return 128 * h + 32 * gi + pg8::perm32(rho);
                return 128 * h + 32 * gi + rho; }
            default: {
                const int pn = R >> 8, cs = R & 255, bj = cs >> 7, c7 = cs & 127, wc = (cs >> 5) & 3, n = (cs >> 4) & 1, i = cs & 15;
                const HalfTile ht = inp_half(pn, bj);
                switch (ht.kind) {
                    case EK_PLAIN: case EK_GELU: case EK_SILU: return ht.src + 32 * wc + pg8::perm32(cs & 31);
                    case EK_ROPE16: if (ht.src != IO_BK) sc = 0.125f * LOG2E; return ht.src + c7;
                    case EK_VT: return ht.src + c7;
                    case EK_ROPE32: return ht.src + 64 * (wc >> 1) + 32 * n + 16 * (wc & 1) + i;
                    case EK_ROPE32K: sc = 0.08838834764831845f; return ht.src + 64 * (wc >> 1) + 32 * n + 16 * (wc & 1) + i;
                    default: return c7 < 32 ? ht.src + c7 : -1;
                }
            }
        }
    }
};
__device__ __forceinline__ void conv_block(const float* W, int ldw, bf16_t* WT, int ldk, LAS float* scr, int k0, int n0, const RowMap& mp, int lane) {
    float cs; const int sc = mp.col(n0 + (lane & 31), cs);
    float vv[32];
    const float* Wp = W + (size_t)(k0 + (lane >> 5)) * ldw + (sc >= 0 ? sc : 0);
#pragma unroll
    for (int i = 0; i < 32; ++i) vv[i] = Wp[(size_t)(2 * i) * ldw];
#pragma unroll
    for (int i = 0; i < 32; ++i) { const int kk = 2 * i + (lane >> 5);
        float v = sc >= 0 ? vv[i] * cs : 0.f; if (mp.kscale) v *= mp.kscale[k0 + kk];
        scr[kk * 33 + (lane & 31)] = v; }
    asm volatile("s_waitcnt lgkmcnt(0)" ::: "memory");
    const int c = lane & 7;
#pragma unroll
    for (int j = 0; j < 4; ++j) { const int n = (lane >> 3) + 8 * j; const LAS float* s = scr + (8 * c) * 33 + n;
        u32x4 o; o.x = cvt_pk_bf16(s[0 * 33], s[1 * 33]); o.y = cvt_pk_bf16(s[2 * 33], s[3 * 33]); o.z = cvt_pk_bf16(s[4 * 33], s[5 * 33]); o.w = cvt_pk_bf16(s[6 * 33], s[7 * 33]);
        *(u32x4*)(WT + (size_t)(n0 + n) * ldk + k0 + 8 * c) = o; }
    asm volatile("s_waitcnt lgkmcnt(0)" ::: "memory");
}
struct ConvJob { const float* W; int ldw, K, N; bf16_t* WT; int ldk; RowMap mp; };
__device__ __forceinline__ void conv_job_run(const Ctx& c, const ConvJob& j, int& base, int gw, int NGW, LAS float* scr) {
    const int nkb = j.K / 64, nnb = j.N / 32, nblk = nkb * nnb;
    int first = gw - (base % NGW); if (first < 0) first += NGW;
    for (int b = first; b < nblk; b += NGW) conv_block(j.W, j.ldw, j.WT, j.ldk, scr, 64 * (b / nnb), 32 * (b % nnb), j.mp, c.lane);
    base += nblk;
}
__device__ __forceinline__ void conv_ffn(const Ctx& c, int l, int f, int slot, int& base, int gw, int NGW, LAS float* scr) {
    bf16_t* w1t = wsp<bf16_t>(c, WS_WF + slot * WF_SLOT); bf16_t* w2t = w1t + (size_t)5632 * 1024;
    ConvJob j1{c.in[I_FFNIN] + (size_t)(l * 2 + f) * 1024 * 5632, 5632, 1024, 5632, w1t, 1024, RowMap{MAP_SWIGLU, nullptr, 1.f}};
    conv_job_run(c, j1, base, gw, NGW, scr);
    ConvJob j2{c.in[I_FFNOUT] + (size_t)(l * 2 + f) * FF * 1024, 1024, FF, 1024, w2t, FF, RowMap{MAP_NAT, nullptr, 1.f}};
    conv_job_run(c, j2, base, gw, NGW, scr);
}
__device__ __forceinline__ void conv_mixer(const Ctx& c, int l, int& base, int gw, int NGW, LAS float* scr) {
    const float* win = c.in[I_WIN] + (size_t)l * 1024 * IN_COLS;
    { ConvJob j{win, IN_COLS, 1024, NINP, wsp<bf16_t>(c, WM_INP), 1024, RowMap{MAP_INP, nullptr, 1.f}}; conv_job_run(c, j, base, gw, NGW, scr); }
    { ConvJob j{win, IN_COLS, 1024, 4096, wsp<bf16_t>(c, WM_G), 1024, RowMap{MAP_GATE, nullptr, 1.f}}; conv_job_run(c, j, base, gw, NGW, scr); }
    for (int k = 0; k < 4; ++k) {
        ConvJob j{c.in[I_WBR] + (size_t)(l * 4 + k) * 512 * 1024, 1024, 512, 1024, wsp<bf16_t>(c, WM_BR) + (size_t)(k >> 1) * 1024 * 1024 + 512 * (k & 1), 1024, RowMap{MAP_PERM32, nullptr, 1.f}}; conv_job_run(c, j, base, gw, NGW, scr); }
    { ConvJob j{c.in[I_WOUT] + (size_t)l * 1024 * 1024, 1024, 1024, 1024, wsp<bf16_t>(c, WM_OUT), 1024, RowMap{MAP_NAT, nullptr, 1.f}}; conv_job_run(c, j, base, gw, NGW, scr); }
    { ConvJob j{c.in[I_WUQ] + (size_t)l * 384 * 768, 768, 384, 768, wsp<bf16_t>(c, WM_UQ), 1024, RowMap{MAP_UQ, c.in[I_QNORM] + l * 384, 0.10206207261596577f * LOG2E}}; conv_job_run(c, j, base, gw, NGW, scr); }
    { ConvJob j{c.in[I_WUKV] + (size_t)l * 256 * 1024, 1024, 256, 1024, wsp<bf16_t>(c, WM_UKV), 256, RowMap{MAP_UKV, c.in[I_KVNORM] + l * 256, 1.f}}; conv_job_run(c, j, base, gw, NGW, scr); }
    for (int m = 0; m < 32; ++m) {
        const int dir = m >> 4, gate = (m >> 3) & 1, n = m & 7;
        const float* W = (gate ? c.in[I_LWX] : c.in[I_LWA]) + (size_t)(((l * 2 + dir) * 8 + n) * 64) * 64;
        ConvJob j{W, 64, 64, 64, wsp<bf16_t>(c, WM_LRU) + (size_t)m * 4096, 64, RowMap{MAP_NAT, nullptr, 1.f}}; conv_job_run(c, j, base, gw, NGW, scr);
    }
}

__device__ __forceinline__ void p0_modtab(const Ctx& c) {
    LAS float* S = (LAS float*)c.lds;
    LAS float* R = (LAS float*)(c.lds + 9 * 1024 * 4);
    for (int i = c.tid; i < 9 * 1024; i += 512) { const int r = i >> 10, k = i & 1023; const float v = r < 8 ? c.in[I_C][r * 1024 + k] : c.in[I_CCTX][k]; S[i] = v / (1.0f + expf(-v)); }
    __syncthreads();
    for (int it = c.bid; it < 2 * 144; it += c.G) {
        const int l = it / 144, cg_ = it % 144, col = 64 * cg_ + c.lane;
        const float* W = c.in[I_WMOD] + (size_t)l * 1024 * 9216 + col;
        float acc[9];
#pragma unroll
        for (int r = 0; r < 9; ++r) acc[r] = 0.f;
        const int k0 = c.wave * 128;
#pragma unroll 2
        for (int k = k0; k < k0 + 128; k += 4) {
            const float w0 = W[(size_t)k * 9216], w1 = W[(size_t)(k + 1) * 9216], w2 = W[(size_t)(k + 2) * 9216], w3 = W[(size_t)(k + 3) * 9216];
#pragma unroll
            for (int r = 0; r < 9; ++r) { const f32x4 s = *(const LAS f32x4*)(S + r * 1024 + k); acc[r] += s.x * w0 + s.y * w1 + s.z * w2 + s.w * w3; }
        }
#pragma unroll
        for (int r = 0; r < 9; ++r) R[(c.wave * 9 + r) * 64 + c.lane] = acc[r];
        __syncthreads();
        for (int i = c.tid; i < 9 * 64; i += 512) { const int r = i >> 6, ln = i & 63; float s = 0.f;
#pragma unroll
            for (int w = 0; w < 8; ++w) s += R[(w * 9 + r) * 64 + ln];
            wsp<float>(c, WS_MODTAB)[(size_t)(l * 9 + r) * 9216 + 64 * cg_ + ln] = s + c.in[I_BMOD][l * 9216 + 64 * cg_ + ln]; }
        __syncthreads();
    }
}
__device__ __forceinline__ void p0_rope_tables(const Ctx& c) {
    if (c.bid != c.G - 1) return;
    for (int i = c.tid; i < 64 * 56; i += 512) {
        const int pos = i / 56, r = i % 56; int nf, f; float* tab;
        if (r < 8) { nf = 8; f = r; tab = wsp<float>(c, WS_CS8); } else if (r < 24) { nf = 16; f = r - 8; tab = wsp<float>(c, WS_CS16); } else { nf = 32; f = r - 24; tab = wsp<float>(c, WS_CS32); }
        const float inv = powf(10000.0f, -(float)f / (float)nf), ang = (float)pos * inv;
        tab[(pos * 2 + 0) * nf + f] = cosf(ang); tab[(pos * 2 + 1) * nf + f] = sinf(ang);
    }
}
__device__ __forceinline__ void p0_rows(const Ctx& c) {
    const int gw = c.bid * 8 + c.wave, NGW = c.G * 8;
    for (int row = gw; row < NT; row += NGW) {
        const float* src = row < NLAT ? c.in[I_X] + (size_t)row * D : c.in[I_CTX] + (size_t)(row - NLAT) * D;
        float* xr = xrow_ptr(c, row); bf16_t* hr = wsp<bf16_t>(c, WS_H) + (size_t)row * D;
        const int r = row_mod(row); const float* sh = modp(c, 0, r, 0); const float* sc = modp(c, 0, r, 1);
#pragma unroll
        for (int j = 0; j < 4; ++j) { const int col = 256 * j + 4 * c.lane;
            const f32x4 v = *(const f32x4*)(src + col), s1 = *(const f32x4*)(sc + col), s0 = *(const f32x4*)(sh + col);
            *(f32x4*)(xr + col) = v;
            const f32x4 h = v * (s1 + 1.0f) + s0; u32x2 o; o.x = cvt_pk_bf16(h.x, h.y); o.y = cvt_pk_bf16(h.z, h.w); *(u32x2*)(hr + col) = o; }
    }
}
__device__ __forceinline__ void phase_normalize(const Ctx& c, int nrows, const float* g, const float* b, int ln, int ksh, int ksc) {
    const int gw = c.bid * 8 + c.wave, NGW = c.G * 8;
    for (int row = gw; row < nrows; row += NGW) {
        float* xr = xrow_ptr(c, row);
        f32x4 v[4]; float s = 0.f;
#pragma unroll
        for (int j = 0; j < 4; ++j) { v[j] = *(const f32x4*)(xr + 256 * j + 4 * c.lane); s += (v[j].x + v[j].y) + (v[j].z + v[j].w); }
        const float mean = wave_sum(s) * (1.f / D); float s2 = 0.f;
#pragma unroll
        for (int j = 0; j < 4; ++j) { v[j] = v[j] - mean; s2 += (v[j].x * v[j].x + v[j].y * v[j].y) + (v[j].z * v[j].z + v[j].w * v[j].w); }
        const float rstd = 1.f / sqrtf(wave_sum(s2) * (1.f / D) + LN_EPS);
        const int r = row_mod(row);
#pragma unroll
        for (int j = 0; j < 4; ++j) { const int col = 256 * j + 4 * c.lane;
            const f32x4 y = v[j] * rstd * *(const f32x4*)(g + col) + *(const f32x4*)(b + col);
            *(f32x4*)(xr + col) = y;
            if (ln >= 0) { const f32x4 h = y * (*(const f32x4*)(modp(c, ln, r, ksc) + col) + 1.0f) + *(const f32x4*)(modp(c, ln, r, ksh) + col);
                u32x2 o; o.x = cvt_pk_bf16(h.x, h.y); o.y = cvt_pk_bf16(h.z, h.w); *(u32x2*)(wsp<bf16_t>(c, WS_H) + (size_t)row * D + col) = o; } }
    }
}
typedef f32x4 Acc[2][2][4][2];
struct SchedTiles {
    pg8::TileOrder ord; const char* A; const char* B; int ld, nt;
    __device__ __forceinline__ bool next(int i, pg8::Unit& u) const {
        int pm, pn; if (!ord.tile(i, pm, pn)) return false;
        u.A = A + (size_t)pm * 256 * ld * 2; u.B = B + (size_t)pn * 256 * ld * 2; u.nt = nt; u.kind = 0; u.pm = pm; u.pn = pn; u.k = 0; return true;
    }
};
struct EpiSwiglu {
    bf16_t* U;
    __device__ __forceinline__ void operator()(const Acc& acc, const pg8::Unit& u, int wr, int wc, int fr, int fq) const {
#pragma unroll
        for (int ai = 0; ai < 2; ++ai)
#pragma unroll
            for (int m = 0; m < 4; ++m) {
                const int row = u.pm * 256 + ai * 128 + wr * 64 + m * 16 + fr;
                float o[8];
#pragma unroll
                for (int bj = 0; bj < 2; ++bj)
#pragma unroll
                    for (int j = 0; j < 4; ++j) o[4 * bj + j] = siluf_(acc[ai][bj][m][0][j]) * acc[ai][bj][m][1][j];
                u32x4 w; w.x = cvt_pk_bf16(o[0], o[1]); w.y = cvt_pk_bf16(o[2], o[3]); w.z = cvt_pk_bf16(o[4], o[5]); w.w = cvt_pk_bf16(o[6], o[7]);
                *(u32x4*)(U + (size_t)row * FF + 128 * u.pn + 32 * wc + 8 * fq) = w;
            }
    }
};
struct EpiResid {
    Ctx c; int l, kg; float coef;
    __device__ __forceinline__ void operator()(const Acc& acc, const pg8::Unit& u, int wr, int wc, int fr, int fq) const {
        const float* gate = modp(c, l, row_mod(u.pm * 256), kg);
        const int col0 = u.pn * 256 + wc * 32 + 4 * fq;
        f32x4 gv[2][2];
#pragma unroll
        for (int bj = 0; bj < 2; ++bj)
#pragma unroll
            for (int n = 0; n < 2; ++n) gv[bj][n] = *(const f32x4*)(gate + col0 + bj * 128 + n * 16) * coef;
#pragma unroll
        for (int ai = 0; ai < 2; ++ai)
#pragma unroll
            for (int m = 0; m < 4; ++m) {
                float* xr = xrow_ptr(c, u.pm * 256 + ai * 128 + wr * 64 + m * 16 + fr) + col0;
#pragma unroll
                for (int bj = 0; bj < 2; ++bj)
#pragma unroll
                    for (int n = 0; n < 2; ++n) { float* p = xr + bj * 128 + n * 16; const f32x4 x = *(const f32x4*)p; *(f32x4*)p = x * DN_ALPHA + gv[bj][n] * acc[ai][bj][m][n]; }
                if (m & 1) asm volatile("" ::: "memory");
            }
    }
};
struct RowInfo { int row, b, s, prow, pcol; bool lat; };
__device__ __forceinline__ RowInfo row_info(int row) {
    RowInfo r; r.row = row; r.lat = row < NLAT;
    if (r.lat) { const int t = row & 2047; r.b = row >> 11; r.s = CTX + t; r.prow = t >> 6; r.pcol = t & 63; }
    else { const int q = row - NLAT; r.b = q >> 8; r.s = q & 255; r.prow = 0; r.pcol = 0; }
    return r;
}
struct EpiInp {
    Ctx c;
    __device__ __forceinline__ void dst_of(int src, bf16_t*& dst, int& ld) const {
        if (src < IO_AY) { dst = wsp<bf16_t>(c, P_AX); ld = 512; }
        else if (src < IO_BQ) { dst = wsp<bf16_t>(c, P_AB); ld = 1024; }
        else if (src < IO_BK) { dst = wsp<bf16_t>(c, P_AB) + 512; ld = 1024; }
        else if (src < IO_BV) { dst = wsp<bf16_t>(c, P_BK); ld = 128; }
        else if (src < IO_CKV) { dst = wsp<bf16_t>(c, P_CD) + 512; ld = 1024; }
        else if (src < IO_CKR) { dst = wsp<bf16_t>(c, P_CKV); ld = 256; }
        else if (src < IO_DQ) { dst = wsp<bf16_t>(c, P_CKR); ld = 32; }
        else if (src < IO_DK) { dst = wsp<bf16_t>(c, P_DQ); ld = 512; }
        else if (src < IO_DV) { dst = wsp<bf16_t>(c, P_DK); ld = 512; }
        else { dst = wsp<bf16_t>(c, P_CD); ld = 1024; }
    }
    __device__ __forceinline__ void operator()(const Acc& acc, const pg8::Unit& u, int wr, int wc, int fr, int fq) const {
#pragma unroll
        for (int bj = 0; bj < 2; ++bj) {
            const HalfTile ht = inp_half(u.pn, bj);
            bf16_t* dst; int ld; dst_of(ht.src, dst, ld);
            const int dcol = ht.dstoff + 32 * wc + 8 * fq;
            if (ht.kind == EK_PLAIN || ht.kind == EK_GELU || ht.kind == EK_SILU) {
#pragma unroll
                for (int ai = 0; ai < 2; ++ai)
#pragma unroll
                    for (int m = 0; m < 4; ++m) {
                        const int row = u.pm * 256 + ai * 128 + wr * 64 + m * 16 + fr;
                        float o[8];
#pragma unroll
                        for (int j = 0; j < 4; ++j) { o[j] = acc[ai][bj][m][0][j]; o[4 + j] = acc[ai][bj][m][1][j]; }
                        if (ht.kind == EK_GELU) {
#pragma unroll
                            for (int j = 0; j < 8; ++j) o[j] = geluf_(o[j]); }
                        if (ht.kind == EK_SILU) {
#pragma unroll
                            for (int j = 0; j < 8; ++j) o[j] = siluf_(o[j]); }
                        u32x4 w; w.x = cvt_pk_bf16(o[0], o[1]); w.y = cvt_pk_bf16(o[2], o[3]); w.z = cvt_pk_bf16(o[4], o[5]); w.w = cvt_pk_bf16(o[6], o[7]);
                        *(u32x4*)(dst + (size_t)row * ld + dcol) = w;
                        if (ht.src >= IO_CQ && ht.src < IO_CKR) {
                            float ss = (bf_lo(w.x) * bf_lo(w.x) + bf_hi(w.x) * bf_hi(w.x)) + (bf_lo(w.y) * bf_lo(w.y) + bf_hi(w.y) * bf_hi(w.y)) + (bf_lo(w.z) * bf_lo(w.z) + bf_hi(w.z) * bf_hi(w.z)) + (bf_lo(w.w) * bf_lo(w.w) + bf_hi(w.w) * bf_hi(w.w));
                            ss += __shfl_xor(ss, 16); ss += __shfl_xor(ss, 32);
                            if (fq == 0) { if (ht.src < IO_CKV) wsp<float>(c, ST_CQ)[(size_t)row * 12 + ((ht.dstoff + 32 * wc) >> 5)] = ss; else wsp<float>(c, ST_CKV)[(size_t)row * 8 + ((ht.dstoff + 32 * wc) >> 5)] = ss; }
                        }
                    }
            } else if (ht.kind == EK_ROPE16 || ht.kind == EK_ROPE32 || ht.kind == EK_ROPE32K) {
                const bool r16 = ht.kind == EK_ROPE16;
                const int seg = r16 ? (wc & 1) : (wc >> 1), nf = r16 ? 16 : 32, f0 = r16 ? 4 * fq : 16 * (wc & 1) + 4 * fq;
                const float* tab = wsp<float>(c, r16 ? WS_CS16 : WS_CS32);
                const int head = (ht.dstoff >> 7);
#pragma unroll
                for (int ai = 0; ai < 2; ++ai)
#pragma unroll
                    for (int m = 0; m < 4; ++m) {
                        const RowInfo ri = row_info(u.pm * 256 + ai * 128 + wr * 64 + m * 16 + fr);
                        f32x4 x1 = acc[ai][bj][m][0], x2 = acc[ai][bj][m][1], o1 = x1, o2 = x2;
                        if (ri.lat) { const int pos = seg ? ri.pcol : ri.prow;
                            const f32x4 cs = *(const f32x4*)(tab + (pos * 2 + 0) * nf + f0), sn = *(const f32x4*)(tab + (pos * 2 + 1) * nf + f0);
                            o1 = x1 * cs - x2 * sn; o2 = x2 * cs + x1 * sn; }
                        u32x4 w; w.x = cvt_pk_bf16(o1.x, o1.y); w.y = cvt_pk_bf16(o1.z, o1.w); w.z = cvt_pk_bf16(o2.x, o2.y); w.w = cvt_pk_bf16(o2.z, o2.w);
                        *(u32x4*)(dst + (size_t)ri.row * ld + dcol) = w;
                        if (ht.kind == EK_ROPE32K) {
                            bf16_t* kt = wsp<bf16_t>(c, KT_RET) + ((size_t)(ri.b * 4 + head) * 128 + 32 * wc + 8 * fq) * SALL + (ri.s & ~31) + posperm(ri.s & 31);
                            kt[0 * SALL] = (bf16_t)(w.x & 0xffff); kt[1 * SALL] = (bf16_t)(w.x >> 16); kt[2 * SALL] = (bf16_t)(w.y & 0xffff); kt[3 * SALL] = (bf16_t)(w.y >> 16);
                            kt[4 * SALL] = (bf16_t)(w.z & 0xffff); kt[5 * SALL] = (bf16_t)(w.z >> 16); kt[6 * SALL] = (bf16_t)(w.w & 0xffff); kt[7 * SALL] = (bf16_t)(w.w >> 16);
                        }
                    }
            } else if (ht.kind == EK_VT) {
                const bool gq = ht.src == IO_BV;
#pragma unroll
                for (int ai = 0; ai < 2; ++ai)
#pragma unroll
                    for (int m = 0; m < 4; ++m) {
                        const RowInfo ri = row_info(u.pm * 256 + ai * 128 + wr * 64 + m * 16 + fr);
                        const int sp = (ri.s & ~31) + posperm(ri.s & 31);
#pragma unroll
                        for (int n = 0; n < 2; ++n) {
                            const int c7 = 32 * wc + 16 * n + 4 * fq;
                            bf16_t* vt = gq ? wsp<bf16_t>(c, VT_GQA) + ((size_t)(ri.b * 2 + (c7 >> 6)) * 64 + (c7 & 63)) * SALL + sp
                                            : wsp<bf16_t>(c, VT_RET) + ((size_t)(ri.b * 4 + (ht.dstoff >> 7)) * 128 + c7) * SALL + sp;
                            const unsigned w0 = cvt_pk_bf16(acc[ai][bj][m][n][0], acc[ai][bj][m][n][1]), w1 = cvt_pk_bf16(acc[ai][bj][m][n][2], acc[ai][bj][m][n][3]);
                            vt[0 * SALL] = (bf16_t)(w0 & 0xffff); vt[1 * SALL] = (bf16_t)(w0 >> 16); vt[2 * SALL] = (bf16_t)(w1 & 0xffff); vt[3 * SALL] = (bf16_t)(w1 >> 16);
                        }
                    }
            } else {
                if (wc == 0) {
#pragma unroll
                    for (int ai = 0; ai < 2; ++ai)
#pragma unroll
                        for (int m = 0; m < 4; ++m) {
                            const int row = u.pm * 256 + ai * 128 + wr * 64 + m * 16 + fr;
#pragma unroll
                            for (int n = 0; n < 2; ++n) { u32x2 w; w.x = cvt_pk_bf16(acc[ai][bj][m][n][0], acc[ai][bj][m][n][1]); w.y = cvt_pk_bf16(acc[ai][bj][m][n][2], acc[ai][bj][m][n][3]);
                                *(u32x2*)(dst + (size_t)row * 32 + 16 * n + 4 * fq) = w; }
                        }
                }
            }
        }
    }
};
struct SchedMerge {
    pg8::TileOrder ord; const char* H; const char* Wg; const char* Wb; const char* AB; const char* CD; int ld;
    __device__ __forceinline__ bool next(int i, pg8::Unit& u) const {
        int pm, pn; if (!ord.tile(i >> 3, pm, pn)) return false;
        const int k = (i >> 1) & 3, isP = i & 1;
        u.pm = pm; u.pn = pn; u.k = k; u.kind = isP;
        if (!isP) { u.A = H + (size_t)pm * 256 * 1024 * 2; u.B = Wg + (size_t)(k * 1024 + pn * 256) * 1024 * 2; u.nt = 16; }
        else { const char* bp = k == 0 ? AB : k == 1 ? AB + 1024 : k == 2 ? CD + 1024 : CD;
            u.A = bp + (size_t)pm * 256 * 1024 * 2; u.B = Wb + ((size_t)((k >> 1) * 1024 + pn * 256) * 1024 + 512 * (k & 1)) * 2; u.nt = 8; }
        return true;
    }
};
struct EpiMerge {
    GAS unsigned char* sig; GAS unsigned char* msum; GAS bf16_t* MG;
    __device__ __forceinline__ void operator()(const Acc& acc, const pg8::Unit& u, int wr, int wc, int fr, int fq) const {
        const unsigned toff = (unsigned)((wr * 4 + wc) * 64 + fq * 16 + fr) * 16u;
        if (u.kind == 0) {
#pragma unroll
            for (int ai = 0; ai < 2; ++ai)
#pragma unroll
                for (int bj = 0; bj < 2; ++bj)
#pragma unroll
                    for (int m = 0; m < 4; ++m) {
                        const int q = (ai * 2 + bj) * 4 + m; const f32x4 a = acc[ai][bj][m][0], b = acc[ai][bj][m][1];
                        unsigned t2 = toff; asm volatile("" : "+v"(t2));
                        u32x4 w; w.x = cvt_pk_bf16(sigmoidf_(a.x), sigmoidf_(a.y)); w.y = cvt_pk_bf16(sigmoidf_(a.z), sigmoidf_(a.w)); w.z = cvt_pk_bf16(sigmoidf_(b.x), sigmoidf_(b.y)); w.w = cvt_pk_bf16(sigmoidf_(b.z), sigmoidf_(b.w));
                        *(GAS u32x4*)(sig + q * 8192 + t2) = w;
                    }
        } else {
#pragma unroll
            for (int ai = 0; ai < 2; ++ai)
#pragma unroll
                for (int bj = 0; bj < 2; ++bj)
#pragma unroll
                    for (int m = 0; m < 4; ++m) {
                        const int q = (ai * 2 + bj) * 4 + m;
                        unsigned t2 = toff; asm volatile("" : "+v"(t2));
                        const u32x4 w = *(const GAS u32x4*)(sig + q * 8192 + t2);
                        f32x4 a = acc[ai][bj][m][0], b = acc[ai][bj][m][1];
                        if (!((DBG >> (8 + u.k)) & 1)) { a = (f32x4){0.f, 0.f, 0.f, 0.f}; b = a; }
                        a.x *= bf_lo(w.x); a.y *= bf_hi(w.x); a.z *= bf_lo(w.y); a.w *= bf_hi(w.y); b.x *= bf_lo(w.z); b.y *= bf_hi(w.z); b.z *= bf_lo(w.w); b.w *= bf_hi(w.w);
                        GAS f32x4* pm0 = (GAS f32x4*)(msum + (q * 2 + 0) * 8192 + t2); GAS f32x4* pm1 = (GAS f32x4*)(msum + (q * 2 + 1) * 8192 + t2);
                        if (u.k > 0) { a += *pm0; b += *pm1; }
                        if (u.k < 3) { *pm0 = a; *pm1 = b; }
                        else { const int row = u.pm * 256 + ai * 128 + wr * 64 + m * 16 + fr;
                            u32x4 o; o.x = cvt_pk_bf16(a.x, a.y); o.y = cvt_pk_bf16(a.z, a.w); o.z = cvt_pk_bf16(b.x, b.y); o.w = cvt_pk_bf16(b.z, b.w);
                            *(GAS u32x4*)(MG + (size_t)row * D + u.pn * 256 + bj * 128 + wc * 32 + 8 * fq) = o; }
                        asm volatile("" ::: "memory");
                    }
        }
    }
};

struct EpiMlaQ {
    Ctx c;
    __device__ __forceinline__ void operator()(const Acc& acc, const pg8::Unit& u, int wr, int wc, int fr, int fq) const {
        const float* tab = wsp<float>(c, WS_CS8);
#pragma unroll
        for (int ai = 0; ai < 2; ++ai)
#pragma unroll
            for (int m = 0; m < 4; ++m) {
                const RowInfo ri = row_info(u.pm * 256 + ai * 128 + wr * 64 + m * 16 + fr);
                const float* st = wsp<float>(c, ST_CQ) + (size_t)ri.row * 12;
                const f32x4 s0 = *(const f32x4*)st, s1 = *(const f32x4*)(st + 4), s2 = *(const f32x4*)(st + 8);
                const float rstd = 1.0f / sqrtf((((s0.x + s0.y) + (s0.z + s0.w)) + ((s1.x + s1.y) + (s1.z + s1.w)) + ((s2.x + s2.y) + (s2.z + s2.w))) * (1.0f / 384.0f) + LN_EPS);
                bf16_t* Q = wsp<bf16_t>(c, WS_QF) + (size_t)ri.row * 768;
#pragma unroll
                for (int bj = 0; bj < 2; ++bj) {
                    const int g = u.pn * 8 + bj * 4 + wc, h = g / 3, gi = g % 3;
                    const f32x4 a = acc[ai][bj][m][0] * rstd, b = acc[ai][bj][m][1] * rstd;
                    if (gi < 2) { u32x4 w; w.x = cvt_pk_bf16(a.x, a.y); w.y = cvt_pk_bf16(a.z, a.w); w.z = cvt_pk_bf16(b.x, b.y); w.w = cvt_pk_bf16(b.z, b.w);
                        *(u32x4*)(Q + 96 * h + 32 * gi + 8 * fq) = w; }
                    else { f32x4 o1 = a, o2 = b;
                        if (ri.lat) { const int pos = (fq >> 1) ? ri.pcol : ri.prow, e0 = 4 * (fq & 1);
                            const f32x4 cs = *(const f32x4*)(tab + (pos * 2 + 0) * 8 + e0), sn = *(const f32x4*)(tab + (pos * 2 + 1) * 8 + e0);
                            o1 = a * cs - b * sn; o2 = b * cs + a * sn; }
                        u32x2 w1, w2; w1.x = cvt_pk_bf16(o1.x, o1.y); w1.y = cvt_pk_bf16(o1.z, o1.w); w2.x = cvt_pk_bf16(o2.x, o2.y); w2.y = cvt_pk_bf16(o2.z, o2.w);
                        *(u32x2*)(Q + 96 * h + 64 + 4 * fq) = w1; *(u32x2*)(Q + 96 * h + 80 + 4 * fq) = w2; }
                }
            }
    }
};
struct EpiMlaKV {
    Ctx c;
    __device__ __forceinline__ void operator()(const Acc& acc, const pg8::Unit& u, int wr, int wc, int fr, int fq) const {
#pragma unroll
        for (int ai = 0; ai < 2; ++ai)
#pragma unroll
            for (int m = 0; m < 4; ++m) {
                const RowInfo ri = row_info(u.pm * 256 + ai * 128 + wr * 64 + m * 16 + fr);
                const float* st = wsp<float>(c, ST_CKV) + (size_t)ri.row * 8;
                const f32x4 s0 = *(const f32x4*)st, s1 = *(const f32x4*)(st + 4);
                const float rstd = 1.0f / sqrtf((((s0.x + s0.y) + (s0.z + s0.w)) + ((s1.x + s1.y) + (s1.z + s1.w))) * (1.0f / 256.0f) + LN_EPS);
                const int sp = (ri.s & ~31) + posperm(ri.s & 31);
#pragma unroll
                for (int bj = 0; bj < 2; ++bj) {
                    const int g = u.pn * 8 + bj * 4 + wc, h = g >> 2, gi = g & 3;
                    const f32x4 a = acc[ai][bj][m][0] * rstd, b = acc[ai][bj][m][1] * rstd;
                    if (gi < 2) { u32x4 w; w.x = cvt_pk_bf16(a.x, a.y); w.y = cvt_pk_bf16(a.z, a.w); w.z = cvt_pk_bf16(b.x, b.y); w.w = cvt_pk_bf16(b.z, b.w);
                        *(u32x4*)(wsp<bf16_t>(c, WS_KF) + ((size_t)(ri.b * 8 + h) * SALL + ri.s) * 96 + 32 * gi + 8 * fq) = w; }
                    else { bf16_t* vt = wsp<bf16_t>(c, WS_VTM) + ((size_t)(ri.b * 8 + h) * 64 + 32 * (gi - 2) + 4 * fq) * SALL + sp;
                        const unsigned w0 = cvt_pk_bf16(a.x, a.y), w1 = cvt_pk_bf16(a.z, a.w), w2 = cvt_pk_bf16(b.x, b.y), w3 = cvt_pk_bf16(b.z, b.w);
                        vt[0 * SALL] = (bf16_t)(w0 & 0xffff); vt[1 * SALL] = (bf16_t)(w0 >> 16); vt[2 * SALL] = (bf16_t)(w1 & 0xffff); vt[3 * SALL] = (bf16_t)(w1 >> 16);
                        vt[16 * SALL] = (bf16_t)(w2 & 0xffff); vt[17 * SALL] = (bf16_t)(w2 >> 16); vt[18 * SALL] = (bf16_t)(w3 & 0xffff); vt[19 * SALL] = (bf16_t)(w3 >> 16); }
                }
            }
    }
};
__device__ __forceinline__ f32x4 mfma16(bf16x8 a, bf16x8 b, f32x4 c) { return __builtin_amdgcn_mfma_f32_16x16x32_bf16(a, b, c, 0, 0, 0); }
__device__ __forceinline__ bf16x8 ldfrag(const bf16_t* p) { return *(const bf16x8*)p; }
__device__ __forceinline__ bf16x8 ldfrag_dev(const bf16_t* p) {
    const unsigned long long a = __hip_atomic_load((const unsigned long long*)p, __ATOMIC_RELAXED, __HIP_MEMORY_SCOPE_AGENT), b = __hip_atomic_load((const unsigned long long*)p + 1, __ATOMIC_RELAXED, __HIP_MEMORY_SCOPE_AGENT);
    u32x4 w; w.x = (unsigned)a; w.y = (unsigned)(a >> 32); w.z = (unsigned)b; w.w = (unsigned)(b >> 32); return __builtin_bit_cast(bf16x8, w);
}
__device__ __forceinline__ bf16x8 pack8(const f32x4 a, const f32x4 b) {
    u32x4 w; w.x = cvt_pk_bf16(a.x, a.y); w.y = cvt_pk_bf16(a.z, a.w); w.z = cvt_pk_bf16(b.x, b.y); w.w = cvt_pk_bf16(b.z, b.w); return __builtin_bit_cast(bf16x8, w);
}
__device__ __forceinline__ float sumsq8(bf16x8 v) { const u32x4 w = __builtin_bit_cast(u32x4, v); float s = 0.f;
    s += bf_lo(w.x) * bf_lo(w.x) + bf_hi(w.x) * bf_hi(w.x); s += bf_lo(w.y) * bf_lo(w.y) + bf_hi(w.y) * bf_hi(w.y);
    s += bf_lo(w.z) * bf_lo(w.z) + bf_hi(w.z) * bf_hi(w.z); s += bf_lo(w.w) * bf_lo(w.w) + bf_hi(w.w) * bf_hi(w.w); return s; }
__device__ __forceinline__ void st4bf(bf16_t* p, const f32x4 v) { u32x2 w; w.x = cvt_pk_bf16(v.x, v.y); w.y = cvt_pk_bf16(v.z, v.w); *(u32x2*)p = w; }

__device__ __forceinline__ void mla_kr_item(const Ctx& c, int it) {
    const int fr = c.lane & 15, fq = c.lane >> 4, row0 = 16 * it;
    const RowInfo ri = row_info(row0 + fr);
    const int seg = fq & 1, half = fq >> 1, pos = seg ? ri.pcol : ri.prow;
    const bf16_t* kr = wsp<bf16_t>(c, P_CKR) + (size_t)(row0 + fr) * 32 + 16 * seg;
    const u32x4 w1 = *(const u32x4*)kr, w2 = *(const u32x4*)(kr + 8);
    const float x1[8] = {bf_lo(w1.x), bf_hi(w1.x), bf_lo(w1.y), bf_hi(w1.y), bf_lo(w1.z), bf_hi(w1.z), bf_lo(w1.w), bf_hi(w1.w)};
    const float x2[8] = {bf_lo(w2.x), bf_hi(w2.x), bf_lo(w2.y), bf_hi(w2.y), bf_lo(w2.z), bf_hi(w2.z), bf_lo(w2.w), bf_hi(w2.w)};
    float o[8];
    const float* cp = wsp<float>(c, WS_CS8) + (pos * 2 + 0) * 8; const float* sp = cp + 8;
#pragma unroll
    for (int e = 0; e < 8; ++e) { const float cc = ri.lat ? cp[e] : 1.0f, sv = ri.lat ? sp[e] : 0.0f; o[e] = half == 0 ? x1[e] * cc - x2[e] * sv : x2[e] * cc + x1[e] * sv; }
    u32x4 krw; krw.x = cvt_pk_bf16(o[0], o[1]); krw.y = cvt_pk_bf16(o[2], o[3]); krw.z = cvt_pk_bf16(o[4], o[5]); krw.w = cvt_pk_bf16(o[6], o[7]);
#pragma unroll
    for (int h = 0; h < 8; ++h) *(u32x4*)(wsp<bf16_t>(c, WS_KF) + ((size_t)(ri.b * 8 + h) * SALL + ri.s) * 96 + 64 + 8 * fq) = krw;
}

template <int DQK, int NQT> struct AttnSt { f32x4 o[4][NQT]; float m[NQT], l[NQT]; bf16x8 q[NQT][DQK / 32]; };
template <int DQK, int NQT>
__device__ __forceinline__ void attn_init(AttnSt<DQK, NQT>& st, const bf16_t* Q, int ldq, float m0, float l0, int fr, int fq) {
#pragma unroll
    for (int qt = 0; qt < NQT; ++qt) { st.m[qt] = m0; st.l[qt] = l0;
#pragma unroll
        for (int ks = 0; ks < DQK / 32; ++ks) st.q[qt][ks] = ldfrag(Q + (size_t)(16 * qt + fr) * ldq + 32 * ks + 8 * fq);
#pragma unroll
        for (int d = 0; d < 4; ++d) st.o[d][qt] = (f32x4){0.f, 0.f, 0.f, 0.f}; }
}
template <int DQK, int NQT, bool MASK>
__device__ __forceinline__ void attn_steps(AttnSt<DQK, NQT>& st, const bf16_t* Kp, int ldk, const bf16_t* VTp, int nsteps, int qpos0, int kpos0, int fr, int fq) {
    for (int stp = 0; stp < nsteps; ++stp) {
        f32x4 s[2][NQT];
#pragma unroll
        for (int kt = 0; kt < 2; ++kt) {
            bf16x8 kf[DQK / 32];
#pragma unroll
            for (int ks = 0; ks < DQK / 32; ++ks) kf[ks] = ldfrag(Kp + (size_t)(32 * stp + 16 * kt + fr) * ldk + 32 * ks + 8 * fq);
#pragma unroll
            for (int qt = 0; qt < NQT; ++qt) { s[kt][qt] = (f32x4){0.f, 0.f, 0.f, 0.f};
#pragma unroll
                for (int ks = 0; ks < DQK / 32; ++ks) s[kt][qt] = mfma16(kf[ks], st.q[qt][ks], s[kt][qt]); }
        }
        bf16x8 vf[4];
#pragma unroll
        for (int d = 0; d < 4; ++d) vf[d] = ldfrag(VTp + (size_t)(16 * d + fr) * SALL + 32 * stp + 8 * fq);
#pragma unroll
        for (int qt = 0; qt < NQT; ++qt) {
            if (MASK) { const int qp = qpos0 + 16 * qt + fr;
#pragma unroll
                for (int kt = 0; kt < 2; ++kt)
#pragma unroll
                    for (int r = 0; r < 4; ++r) { const int dd = qp - (kpos0 + 32 * stp + 16 * kt + 4 * fq + r); if (dd > 128 || dd < -128) s[kt][qt][r] = -1e30f; } }
            float mx = fmaxf(fmaxf(fmaxf(s[0][qt].x, s[0][qt].y), fmaxf(s[0][qt].z, s[0][qt].w)), fmaxf(fmaxf(s[1][qt].x, s[1][qt].y), fmaxf(s[1][qt].z, s[1][qt].w)));
            mx = fmaxf(mx, __shfl_xor(mx, 16)); mx = fmaxf(mx, __shfl_xor(mx, 32));
            const float mn = fmaxf(st.m[qt], mx), alpha = fast_exp2(st.m[qt] - mn); st.m[qt] = mn;
            float ps = 0.f;
#pragma unroll
            for (int kt = 0; kt < 2; ++kt)
#pragma unroll
                for (int r = 0; r < 4; ++r) { float p = fast_exp2(s[kt][qt][r] - mn); if (MASK) p = s[kt][qt][r] < -1e29f ? 0.f : p; s[kt][qt][r] = p; ps += p; }
            st.l[qt] = st.l[qt] * alpha + ps;
            const bf16x8 pk = pack8(s[0][qt], s[1][qt]);
#pragma unroll
            for (int d = 0; d < 4; ++d) st.o[d][qt] = mfma16(vf[d], pk, st.o[d][qt] * alpha);
        }
    }
}
template <int DQK, int NQT>
__device__ __forceinline__ void attn_store(AttnSt<DQK, NQT>& st, bf16_t* O, int ldo, int fr, int fq, bool dry = false) {
#pragma unroll
    for (int qt = 0; qt < NQT; ++qt) { float l = st.l[qt]; l += __shfl_xor(l, 16); l += __shfl_xor(l, 32); const float inv = 1.0f / l;
#pragma unroll
        for (int d = 0; d < 4; ++d) if (!dry) st4bf(O + (size_t)(16 * qt + fr) * ldo + 16 * d + 4 * fq, st.o[d][qt] * inv); }
}
__device__ __forceinline__ void gqa_item(const Ctx& c, int l, int it, bool dry = false) {
    const int fr = c.lane & 15, fq = c.lane >> 4;
    const bool lat = it < 2048; int b, hq, tg;
    if (lat) { b = it >> 8; hq = (it >> 5) & 7; tg = it & 31; } else { const int j = it - 2048; b = j >> 5; hq = (j >> 2) & 7; tg = j & 3; }
    const int kvh = hq >> 2, row0 = lat ? b * SEQ + 64 * tg : NLAT + b * CTX + 64 * tg;
    bf16_t* Q = wsp<bf16_t>(c, P_AB) + 512 + (size_t)row0 * 1024 + hq * 64;
    const bf16_t* Kall = wsp<bf16_t>(c, P_BK) + kvh * 64;
    const bf16_t* VT = wsp<bf16_t>(c, VT_GQA) + (size_t)((b * 2 + kvh) * 64) * SALL;
    AttnSt<64, 4> st;
    attn_init<64, 4>(st, Q, 1024, c.in[I_SINK][l * 8 + hq] * LOG2E, fq == 0 ? 1.0f : 0.0f, fr, fq);
    if (lat) { const int tlo = 64 * tg - 128 < 0 ? 0 : 64 * tg - 128, thi = 64 * tg + 192 > SEQ ? SEQ : 64 * tg + 192;
        attn_steps<64, 4, true>(st, Kall + (size_t)(b * SEQ + tlo) * 128, 128, VT + CTX + tlo, (thi - tlo) >> 5, 64 * tg, tlo, fr, fq); }
    attn_steps<64, 4, false>(st, Kall + (size_t)(NLAT + b * CTX) * 128, 128, VT, 8, 0, 0, fr, fq);
    attn_store<64, 4>(st, Q, 1024, fr, fq, dry);
}
__device__ __forceinline__ void mla_item(const Ctx& c, int it) {
    const int fr = c.lane & 15, fq = c.lane >> 4;
    const bool lat = it < 2048; int b, h, tg;
    if (lat) { b = it >> 8; h = (it >> 5) & 7; tg = it & 31; } else { const int j = it - 2048; b = j >> 5; h = (j >> 2) & 7; tg = j & 3; }
    const int row0 = lat ? b * SEQ + 64 * tg : NLAT + b * CTX + 64 * tg;
    AttnSt<96, 4> st;
    attn_init<96, 4>(st, wsp<bf16_t>(c, WS_QF) + (size_t)row0 * 768 + h * 96, 768, -1e30f, 0.0f, fr, fq);
    attn_steps<96, 4, false>(st, wsp<bf16_t>(c, WS_KF) + (size_t)((b * 8 + h) * SALL) * 96, 96, wsp<bf16_t>(c, WS_VTM) + (size_t)((b * 8 + h) * 64) * SALL, lat ? SALL / 32 : CTX / 32, 0, 0, fr, fq);
    attn_store<96, 4>(st, wsp<bf16_t>(c, P_CD) + 512 + (size_t)row0 * 1024 + h * 64, 1024, fr, fq);
}

template <int DQK> struct AttnLds { static constexpr int KROW = DQK * 2 + 16, VROW = 64 * 2 + 16, KBYTES = 64 * KROW, BUF = KBYTES + 64 * VROW, KCH = DQK / 8; };
template <int DQK> struct TileRegs { u32x4 k0, k1, v; };
template <int DQK>
__device__ __forceinline__ void tile_gload(TileRegs<DQK>& r, const bf16_t* Kp, int ldk, const bf16_t* VTp, int tid) {
    constexpr int KCH = AttnLds<DQK>::KCH;
    { const int key = tid / KCH, part = tid % KCH; r.k0 = *(const u32x4*)(Kp + (size_t)key * ldk + part * 8); }
    if (DQK == 96) { const int cidx = tid + 512; if (cidx < 64 * KCH) { const int key = cidx / KCH, part = cidx % KCH; r.k1 = *(const u32x4*)(Kp + (size_t)key * ldk + part * 8); } }
    { const int dv = tid >> 3, part = tid & 7; r.v = *(const u32x4*)(VTp + (size_t)dv * SALL + part * 8); }
}
template <int DQK>
__device__ __forceinline__ void tile_swrite(const TileRegs<DQK>& r, LAS unsigned char* buf, int tid) {
    constexpr int KCH = AttnLds<DQK>::KCH, KROW = AttnLds<DQK>::KROW, VROW = AttnLds<DQK>::VROW;
    { const int key = tid / KCH, part = tid % KCH; *(LAS u32x4*)(buf + key * KROW + part * 16) = r.k0; }
    if (DQK == 96) { const int cidx = tid + 512; if (cidx < 64 * KCH) { const int key = cidx / KCH, part = cidx % KCH; *(LAS u32x4*)(buf + key * KROW + part * 16) = r.k1; } }
    { const int dv = tid >> 3, part = tid & 7; *(LAS u32x4*)(buf + AttnLds<DQK>::KBYTES + dv * VROW + part * 16) = r.v; }
}
template <int DQK, int NQT, bool MASK>
__device__ __forceinline__ void attn_tile(AttnSt<DQK, NQT>& st, const LAS unsigned char* buf, int qpos0, int kpos0, int fr, int fq) {
    constexpr int KROW = AttnLds<DQK>::KROW, VROW = AttnLds<DQK>::VROW;
#pragma unroll
    for (int stp = 0; stp < 2; ++stp) {
        f32x4 s[2][NQT];
#pragma unroll
        for (int kt = 0; kt < 2; ++kt) {
            bf16x8 kf[DQK / 32];
#pragma unroll
            for (int ks = 0; ks < DQK / 32; ++ks) kf[ks] = *(const LAS bf16x8*)(buf + (32 * stp + 16 * kt + fr) * KROW + ks * 64 + fq * 16);
#pragma unroll
            for (int qt = 0; qt < NQT; ++qt) { s[kt][qt] = (f32x4){0.f, 0.f, 0.f, 0.f};
#pragma unroll
                for (int ks = 0; ks < DQK / 32; ++ks) s[kt][qt] = mfma16(kf[ks], st.q[qt][ks], s[kt][qt]); }
        }
        bf16x8 vf[4];
#pragma unroll
        for (int d = 0; d < 4; ++d) vf[d] = *(const LAS bf16x8*)(buf + AttnLds<DQK>::KBYTES + (16 * d + fr) * VROW + stp * 64 + fq * 16);
#pragma unroll
        for (int qt = 0; qt < NQT; ++qt) {
            if (MASK) { const int qp = qpos0 + 16 * qt + fr;
#pragma unroll
                for (int kt = 0; kt < 2; ++kt)
#pragma unroll
                    for (int r = 0; r < 4; ++r) { const int dd = qp - (kpos0 + 32 * stp + 16 * kt + 4 * fq + r); if (dd > 128 || dd < -128) s[kt][qt][r] = -1e30f; } }
            float mx = fmaxf(fmaxf(fmaxf(s[0][qt].x, s[0][qt].y), fmaxf(s[0][qt].z, s[0][qt].w)), fmaxf(fmaxf(s[1][qt].x, s[1][qt].y), fmaxf(s[1][qt].z, s[1][qt].w)));
            mx = fmaxf(mx, __shfl_xor(mx, 16)); mx = fmaxf(mx, __shfl_xor(mx, 32));
            const float mn = fmaxf(st.m[qt], mx), alpha = fast_exp2(st.m[qt] - mn); st.m[qt] = mn;
            float ps = 0.f;
#pragma unroll
            for (int kt = 0; kt < 2; ++kt)
#pragma unroll
                for (int r = 0; r < 4; ++r) { float p = fast_exp2(s[kt][qt][r] - mn); if (MASK) p = s[kt][qt][r] < -1e29f ? 0.f : p; s[kt][qt][r] = p; ps += p; }
            st.l[qt] = st.l[qt] * alpha + ps;
            const bf16x8 pk = pack8(s[0][qt], s[1][qt]);
#pragma unroll
            for (int d = 0; d < 4; ++d) st.o[d][qt] = mfma16(vf[d], pk, st.o[d][qt] * alpha);
        }
    }
}
__device__ __forceinline__ void mla_block_item(const Ctx& c, int it) {
    const int fr = c.lane & 15, fq = c.lane >> 4, b = it >> 6, h = (it >> 3) & 7, qg = it & 7, row0 = b * SEQ + 256 * qg + 32 * c.wave;
    typedef AttnLds<96> L;
    const bf16_t* Kp = wsp<bf16_t>(c, WS_KF) + (size_t)((b * 8 + h) * SALL) * 96; const bf16_t* VTp = wsp<bf16_t>(c, WS_VTM) + (size_t)((b * 8 + h) * 64) * SALL;
    AttnSt<96, 2> st;
    attn_init<96, 2>(st, wsp<bf16_t>(c, WS_QF) + (size_t)row0 * 768 + h * 96, 768, -1e30f, 0.0f, fr, fq);
    TileRegs<96> tr;
    tile_gload<96>(tr, Kp, 96, VTp, c.tid); tile_swrite<96>(tr, c.lds, c.tid);
    __syncthreads();
    for (int t = 0; t < SALL / 64; ++t) {
        if (t + 1 < SALL / 64) tile_gload<96>(tr, Kp + (size_t)(64 * (t + 1)) * 96, 96, VTp + 64 * (t + 1), c.tid);
        attn_tile<96, 2, false>(st, c.lds + (t & 1) * L::BUF, 0, 0, fr, fq);
        if (t + 1 < SALL / 64) tile_swrite<96>(tr, c.lds + ((t + 1) & 1) * L::BUF, c.tid);
        __syncthreads();
    }
    attn_store<96, 2>(st, wsp<bf16_t>(c, P_CD) + 512 + (size_t)row0 * 1024 + h * 64, 1024, fr, fq);
}
__device__ __forceinline__ void gqa_block_item(const Ctx& c, int l, int it) {
    const int fr = c.lane & 15, fq = c.lane >> 4, b = it >> 6, kvh = (it >> 5) & 1, tq = it & 31, hq = kvh * 4 + (c.wave >> 1), q0 = 64 * tq + 32 * (c.wave & 1);
    typedef AttnLds<64> L;
    bf16_t* Q = wsp<bf16_t>(c, P_AB) + 512 + (size_t)(b * SEQ + q0) * 1024 + hq * 64;
    const bf16_t* Kall = wsp<bf16_t>(c, P_BK) + kvh * 64; const bf16_t* VT = wsp<bf16_t>(c, VT_GQA) + (size_t)((b * 2 + kvh) * 64) * SALL;
    AttnSt<64, 2> st;
    attn_init<64, 2>(st, Q, 1024, c.in[I_SINK][l * 8 + hq] * LOG2E, fq == 0 ? 1.0f : 0.0f, fr, fq);
    const int wlo = 64 * tq - 128 < 0 ? 0 : 64 * tq - 128, whi = 64 * tq + 192 > SEQ ? SEQ : 64 * tq + 192, ntile = 4 + ((whi - wlo) >> 6);
#define GQA_KP(t) ((t) < 4 ? Kall + (size_t)(NLAT + b * CTX + 64 * (t)) * 128 : Kall + (size_t)(b * SEQ + wlo + 64 * ((t) - 4)) * 128)
#define GQA_VP(t) ((t) < 4 ? VT + 64 * (t) : VT + CTX + wlo + 64 * ((t) - 4))
    TileRegs<64> tr;
    tile_gload<64>(tr, GQA_KP(0), 128, GQA_VP(0), c.tid); tile_swrite<64>(tr, c.lds, c.tid);
    __syncthreads();
    for (int t = 0; t < ntile; ++t) {
        if (t + 1 < ntile) tile_gload<64>(tr, GQA_KP(t + 1), 128, GQA_VP(t + 1), c.tid);
        if (t < 4) attn_tile<64, 2, false>(st, c.lds + (t & 1) * L::BUF, 0, 0, fr, fq);
        else { const int k0 = wlo + 64 * (t - 4); if (k0 + 63 >= q0 - 128 && k0 <= q0 + 31 + 128) attn_tile<64, 2, true>(st, c.lds + (t & 1) * L::BUF, q0, k0, fr, fq); }
        if (t + 1 < ntile) tile_swrite<64>(tr, c.lds + ((t + 1) & 1) * L::BUF, c.tid);
        __syncthreads();
    }
#undef GQA_KP
#undef GQA_VP
    attn_store<64, 2>(st, Q, 1024, fr, fq);
}

__device__ __forceinline__ int ret_row0(int b, int p) { return p < 2 ? NLAT + b * CTX + 128 * p : b * SEQ + 128 * (p - 2); }
__device__ __forceinline__ int ret_s0(int p) { return p < 2 ? 128 * p : CTX + 128 * (p - 2); }
__device__ __forceinline__ int ret_posb(int p) { return p < 2 ? 1 - p : 2 + (17 - p); }
__device__ __forceinline__ float ret_lg2(const Ctx& c, int l, int dir, int h) { const float x = c.in[I_RDECAY][(l * 2 + dir) * 4 + h]; return -log2f(1.0f + expf(-x)); }
__device__ __forceinline__ bf16_t* ret_state(const Ctx& c, int b, int h, int dir, int pos) { return wsp<bf16_t>(c, WS_RET) + ((size_t)(((b * 4 + h) * 2 + dir) * 18 + pos)) * 16384; }
__device__ __forceinline__ void ret_kv_item(const Ctx& c, int l, int it) {
    const int fr = c.lane & 15, fq = c.lane >> 4;
    const int w = it & 7, p = (it >> 3) % 18, bh = (it >> 3) / 18, b = bh >> 2, h = bh & 3, s0 = ret_s0(p);
    const float lgf = ret_lg2(c, l, 0, h), lgb = ret_lg2(c, l, 1, h);
    const bf16_t* KT = wsp<bf16_t>(c, KT_RET) + ((size_t)(b * 4 + h) * 128 + 16 * w + fr) * SALL + s0 + 8 * fq;
    const bf16_t* VT = wsp<bf16_t>(c, VT_RET) + ((size_t)(b * 4 + h) * 128 + fr) * SALL + s0 + 8 * fq;
    bf16x8 kf[4], kb[4];
#pragma unroll
    for (int u = 0; u < 4; ++u) { const u32x4 kw = *(const u32x4*)(KT + 32 * u); float v[8] = {bf_lo(kw.x), bf_hi(kw.x), bf_lo(kw.y), bf_hi(kw.y), bf_lo(kw.z), bf_hi(kw.z), bf_lo(kw.w), bf_hi(kw.w)};
        float vf[8], vb[8];
#pragma unroll
        for (int jj = 0; jj < 8; ++jj) { const int jl = 32 * u + 16 * (jj >> 2) + 4 * fq + (jj & 3);
            if (RDBG & 64) v[jj] = bf2f(wsp<bf16_t>(c, P_DK)[(size_t)(ret_row0(b, p) + jl) * 512 + h * 128 + 16 * w + fr]); vf[jj] = v[jj] * exp2f((float)(127 - jl) * lgf); vb[jj] = v[jj] * exp2f((float)jl * lgb); }
        u32x4 o; o.x = cvt_pk_bf16(vf[0], vf[1]); o.y = cvt_pk_bf16(vf[2], vf[3]); o.z = cvt_pk_bf16(vf[4], vf[5]); o.w = cvt_pk_bf16(vf[6], vf[7]); kf[u] = __builtin_bit_cast(bf16x8, o);
        o.x = cvt_pk_bf16(vb[0], vb[1]); o.y = cvt_pk_bf16(vb[2], vb[3]); o.z = cvt_pk_bf16(vb[4], vb[5]); o.w = cvt_pk_bf16(vb[6], vb[7]); kb[u] = __builtin_bit_cast(bf16x8, o);
        if (RDBG & 32) { const u32x4 cw = {0x3c233c23u, 0x3c233c23u, 0x3c233c23u, 0x3c233c23u}; kf[u] = __builtin_bit_cast(bf16x8, cw); kb[u] = kf[u]; } }
    bf16_t* Sf = ret_state(c, b, h, 0, p) + (size_t)fr * 128 + 16 * w + 4 * fq;
    bf16_t* Sb = ret_state(c, b, h, 1, ret_posb(p)) + (size_t)fr * 128 + 16 * w + 4 * fq;
#pragma unroll 2
    for (int d = 0; d < 8; ++d) {
        f32x4 af = (f32x4){0.f, 0.f, 0.f, 0.f}, ab = af;
#pragma unroll
        for (int u = 0; u < 4; ++u) { const bf16x8 vf = ldfrag(VT + (size_t)(16 * d) * SALL + 32 * u); af = mfma16(kf[u], vf, af); ab = mfma16(kb[u], vf, ab); }
        st4bf(Sf + (size_t)(16 * d) * 128, af); st4bf(Sb + (size_t)(16 * d) * 128, ab);
    }
}
__device__ __forceinline__ void ret_prefix(const Ctx& c, int l, int e) {
    const int chain = e >> 11, off = (e & 2047) * 8, dir = chain & 1, h = (chain >> 1) & 3;
    const float dec = exp2f(128.0f * ret_lg2(c, l, dir, h));
    bf16_t* S = wsp<bf16_t>(c, WS_RET) + (size_t)chain * 18 * 16384 + off;
    u32x4 kv[18];
#pragma unroll
    for (int p = 0; p < 18; ++p) kv[p] = *(const u32x4*)(S + (size_t)p * 16384);
    float R[8];
#pragma unroll
    for (int j = 0; j < 8; ++j) R[j] = 0.f;
#pragma unroll
    for (int p = 0; p < 18; ++p) {
        u32x4 o; o.x = cvt_pk_bf16(R[0], R[1]); o.y = cvt_pk_bf16(R[2], R[3]); o.z = cvt_pk_bf16(R[4], R[5]); o.w = cvt_pk_bf16(R[6], R[7]);
        *(u32x4*)(S + (size_t)p * 16384) = o;
        R[0] = R[0] * dec + bf_lo(kv[p].x); R[1] = R[1] * dec + bf_hi(kv[p].x); R[2] = R[2] * dec + bf_lo(kv[p].y); R[3] = R[3] * dec + bf_hi(kv[p].y);
        R[4] = R[4] * dec + bf_lo(kv[p].z); R[5] = R[5] * dec + bf_hi(kv[p].z); R[6] = R[6] * dec + bf_lo(kv[p].w); R[7] = R[7] * dec + bf_hi(kv[p].w);
    }
}
__device__ __forceinline__ void ret_out_item(const Ctx& c, int l, int it, bool dry = false) {
    const int fr = c.lane & 15, fq = c.lane >> 4;
    const int w = it & 7, p = (it >> 3) % 18, bh = (it >> 3) / 18, b = bh >> 2, h = bh & 3, s0 = ret_s0(p), row0 = ret_row0(b, p);
    const float lgf = ret_lg2(c, l, 0, h), lgb = ret_lg2(c, l, 1, h);
    const int il = 16 * w + fr;
    bf16x8 qf[4];
#pragma unroll
    for (int ks = 0; ks < 4; ++ks) qf[ks] = ldfrag(wsp<bf16_t>(c, P_DQ) + (size_t)(row0 + il) * 512 + h * 128 + 32 * ks + 8 * fq);
    f32x4 y[8];
    {
        f32x4 st[8];
        const bf16_t* K = wsp<bf16_t>(c, P_DK) + (size_t)(row0 + fr) * 512 + h * 128 + 8 * fq;
#pragma unroll
        for (int jt = 0; jt < 8; ++jt) { st[jt] = (f32x4){0.f, 0.f, 0.f, 0.f};
#pragma unroll
            for (int ks = 0; ks < 4; ++ks) st[jt] = mfma16(ldfrag(K + (size_t)(16 * jt) * 512 + 32 * ks), qf[ks], st[jt]);
#pragma unroll
            for (int r = 0; r < 4; ++r) { const int d = il - (16 * jt + 4 * fq + r); st[jt][r] *= d >= 0 ? exp2f((float)d * lgf) : exp2f((float)(-d) * lgb); } }
        const bf16_t* VT = wsp<bf16_t>(c, VT_RET) + ((size_t)(b * 4 + h) * 128 + fr) * SALL + s0 + 8 * fq;
        bf16x8 pk[4];
#pragma unroll
        for (int u = 0; u < 4; ++u) pk[u] = pack8(st[2 * u], st[2 * u + 1]);
#pragma unroll
        for (int d = 0; d < 8; ++d) { y[d] = (f32x4){0.f, 0.f, 0.f, 0.f};
#pragma unroll
            for (int u = 0; u < 4; ++u) y[d] = mfma16(ldfrag(VT + (size_t)(16 * d) * SALL + 32 * u), pk[u], y[d]);
            if (!(RDBG & 1)) y[d] = (f32x4){0.f, 0.f, 0.f, 0.f}; }
    }
    {
        const float xif = exp2f((float)(il + 1) * lgf), xib = exp2f((float)(128 - il) * lgb);
        const bf16_t* Rf = ret_state(c, b, h, 0, p) + (size_t)fr * 128 + 8 * fq;
        const bf16_t* Rb = ret_state(c, b, h, 1, ret_posb(p)) + (size_t)fr * 128 + 8 * fq;
#pragma unroll 2
        for (int d = 0; d < 8; ++d) { f32x4 cf = (f32x4){0.f, 0.f, 0.f, 0.f}, cb = cf;
#pragma unroll
            for (int ks = 0; ks < 4; ++ks) { bf16x8 rf_ = ldfrag(Rf + (size_t)(16 * d) * 128 + 32 * ks), rb_ = ldfrag(Rb + (size_t)(16 * d) * 128 + 32 * ks);
                if (RDBG & 16) { const u32x4 cw = {0x3c233c23u, 0x3c233c23u, 0x3c233c23u, 0x3c233c23u}; rf_ = __builtin_bit_cast(bf16x8, cw); rb_ = rf_; }
                cf = mfma16(rf_, qf[ks], cf); cb = mfma16(rb_, qf[ks], cb); }
            if (RDBG & 2) y[d] += cf * xif; if (RDBG & 4) y[d] += cb * xib; }
    }
    float s = 0.f;
#pragma unroll
    for (int d = 0; d < 8; ++d) s += (y[d].x + y[d].y) + (y[d].z + y[d].w);
    s += __shfl_xor(s, 16); s += __shfl_xor(s, 32);
    const float mu = s * (1.0f / 128.0f); float q = 0.f;
#pragma unroll
    for (int d = 0; d < 8; ++d) { y[d] = y[d] - mu; q += (y[d].x * y[d].x + y[d].y * y[d].y) + (y[d].z * y[d].z + y[d].w * y[d].w); }
    q += __shfl_xor(q, 16); q += __shfl_xor(q, 32);
    const float rstd = 1.0f / sqrtf(q * (1.0f / 128.0f) + LN_EPS);
    bf16_t* G = wsp<bf16_t>(c, P_CD) + (size_t)(row0 + il) * 1024 + h * 128 + 4 * fq;
    const float* gn = c.in[I_GNG] + l * 512 + h * 128 + 4 * fq;
#pragma unroll
    for (int d = 0; d < 8; ++d) { const u32x2 gw = *(const u32x2*)(G + 16 * d); const f32x4 gg = *(const f32x4*)(gn + 16 * d);
        f32x4 o = y[d] * rstd * gg; o.x *= bf_lo(gw.x); o.y *= bf_hi(gw.x); o.z *= bf_lo(gw.y); o.w *= bf_hi(gw.y); if (!dry) st4bf(G + 16 * d, o); }
}

__device__ __forceinline__ void tile128_load(u32x4 (&r)[4], const bf16_t* src, int ld, int tid) {
#pragma unroll
    for (int j = 0; j < 4; ++j) { const int i = tid + 512 * j; r[j] = *(const u32x4*)(src + (size_t)(i >> 4) * ld + (i & 15) * 8); }
}
__device__ __forceinline__ void tile128_store(const u32x4 (&r)[4], LAS unsigned char* t, int tid) {
#pragma unroll
    for (int j = 0; j < 4; ++j) { const int i = tid + 512 * j, row = i >> 4, cch = i & 15; *(LAS u32x4*)(t + row * 256 + ((cch ^ (row & 15)) << 4)) = r[j]; }
}
__device__ __forceinline__ bf16x8 tile128_frag(const LAS unsigned char* t, int rb, int kc, int fr, int fq) { return *(const LAS bf16x8*)(t + (rb + fr) * 256 + (((kc + fq) ^ fr) << 4)); }
__device__ __forceinline__ void ret_kv_block(const Ctx& c, int l, int it) {
    const int fr = c.lane & 15, fq = c.lane >> 4, w = c.wave;
    const int p = it % 18, bh = it / 18, b = bh >> 2, h = bh & 3, s0 = ret_s0(p);
    const float lgf = ret_lg2(c, l, 0, h), lgb = ret_lg2(c, l, 1, h);
    LAS unsigned char* tK = c.lds; LAS unsigned char* tV = c.lds + 32768;
    { u32x4 r0[4], r1[4];
      tile128_load(r0, wsp<bf16_t>(c, KT_RET) + (size_t)((b * 4 + h) * 128) * SALL + s0, SALL, c.tid);
      tile128_load(r1, wsp<bf16_t>(c, VT_RET) + (size_t)((b * 4 + h) * 128) * SALL + s0, SALL, c.tid);
      tile128_store(r0, tK, c.tid); tile128_store(r1, tV, c.tid); }
    __syncthreads();
    bf16x8 kf[4], kb[4];
#pragma unroll
    for (int u = 0; u < 4; ++u) { const u32x4 kw = __builtin_bit_cast(u32x4, tile128_frag(tK, 16 * w, 4 * u, fr, fq)); const float v[8] = {bf_lo(kw.x), bf_hi(kw.x), bf_lo(kw.y), bf_hi(kw.y), bf_lo(kw.z), bf_hi(kw.z), bf_lo(kw.w), bf_hi(kw.w)};
        float vf[8], vb[8];
#pragma unroll
        for (int jj = 0; jj < 8; ++jj) { const int jl = 32 * u + 16 * (jj >> 2) + 4 * fq + (jj & 3); vf[jj] = v[jj] * fast_exp2((float)(127 - jl) * lgf); vb[jj] = v[jj] * fast_exp2((float)jl * lgb); }
        u32x4 o; o.x = cvt_pk_bf16(vf[0], vf[1]); o.y = cvt_pk_bf16(vf[2], vf[3]); o.z = cvt_pk_bf16(vf[4], vf[5]); o.w = cvt_pk_bf16(vf[6], vf[7]); kf[u] = __builtin_bit_cast(bf16x8, o);
        o.x = cvt_pk_bf16(vb[0], vb[1]); o.y = cvt_pk_bf16(vb[2], vb[3]); o.z = cvt_pk_bf16(vb[4], vb[5]); o.w = cvt_pk_bf16(vb[6], vb[7]); kb[u] = __builtin_bit_cast(bf16x8, o); }
    bf16_t* Sf = ret_state(c, b, h, 0, p) + (size_t)fr * 128 + 16 * w + 4 * fq;
    bf16_t* Sb = ret_state(c, b, h, 1, ret_posb(p)) + (size_t)fr * 128 + 16 * w + 4 * fq;
#pragma unroll 2
    for (int d = 0; d < 8; ++d) {
        f32x4 af = (f32x4){0.f, 0.f, 0.f, 0.f}, ab = af;
#pragma unroll
        for (int u = 0; u < 4; ++u) { const bf16x8 vf = tile128_frag(tV, 16 * d, 4 * u, fr, fq); af = mfma16(kf[u], vf, af); ab = mfma16(kb[u], vf, ab); }
        st4bf(Sf + (size_t)(16 * d) * 128, af); st4bf(Sb + (size_t)(16 * d) * 128, ab);
    }
    __syncthreads();
}
__device__ __forceinline__ void ret_out_block(const Ctx& c, int l, int it) {
    const int fr = c.lane & 15, fq = c.lane >> 4, w = c.wave;
    const int p = it % 18, bh = it / 18, b = bh >> 2, h = bh & 3, s0 = ret_s0(p), row0 = ret_row0(b, p);
    const float lgf = ret_lg2(c, l, 0, h), lgb = ret_lg2(c, l, 1, h);
    LAS unsigned char* tK = c.lds; LAS unsigned char* tV = c.lds + 32768; LAS unsigned char* tF = c.lds + 65536; LAS unsigned char* tB = c.lds + 98304;
    { u32x4 r0[4], r1[4];
      tile128_load(r0, wsp<bf16_t>(c, P_DK) + (size_t)row0 * 512 + h * 128, 512, c.tid);
      tile128_load(r1, wsp<bf16_t>(c, VT_RET) + (size_t)((b * 4 + h) * 128) * SALL + s0, SALL, c.tid);
      tile128_store(r0, tK, c.tid); tile128_store(r1, tV, c.tid);
      tile128_load(r0, ret_state(c, b, h, 0, p), 128, c.tid);
      tile128_load(r1, ret_state(c, b, h, 1, ret_posb(p)), 128, c.tid);
      tile128_store(r0, tF, c.tid); tile128_store(r1, tB, c.tid); }
    const int il = 16 * w + fr;
    bf16x8 qf[4];
#pragma unroll
    for (int ks = 0; ks < 4; ++ks) qf[ks] = ldfrag(wsp<bf16_t>(c, P_DQ) + (size_t)(row0 + il) * 512 + h * 128 + 32 * ks + 8 * fq);
    __syncthreads();
    f32x4 y[8];
    {
        f32x4 st[8];
#pragma unroll
        for (int jt = 0; jt < 8; ++jt) { st[jt] = (f32x4){0.f, 0.f, 0.f, 0.f};
#pragma unroll
            for (int ks = 0; ks < 4; ++ks) st[jt] = mfma16(tile128_frag(tK, 16 * jt, 4 * ks, fr, fq), qf[ks], st[jt]);
#pragma unroll
            for (int r = 0; r < 4; ++r) { const int d = il - (16 * jt + 4 * fq + r); st[jt][r] *= d >= 0 ? fast_exp2((float)d * lgf) : fast_exp2((float)(-d) * lgb); } }
        bf16x8 pk[4];
#pragma unroll
        for (int u = 0; u < 4; ++u) pk[u] = pack8(st[2 * u], st[2 * u + 1]);
#pragma unroll
        for (int d = 0; d < 8; ++d) { y[d] = (f32x4){0.f, 0.f, 0.f, 0.f};
#pragma unroll
            for (int u = 0; u < 4; ++u) y[d] = mfma16(tile128_frag(tV, 16 * d, 4 * u, fr, fq), pk[u], y[d]); }
    }
    {
        const float xif = fast_exp2((float)(il + 1) * lgf), xib = fast_exp2((float)(128 - il) * lgb);
#pragma unroll 2
        for (int d = 0; d < 8; ++d) { f32x4 cf = (f32x4){0.f, 0.f, 0.f, 0.f}, cb = cf;
#pragma unroll
            for (int ks = 0; ks < 4; ++ks) { cf = mfma16(tile128_frag(tF, 16 * d, 4 * ks, fr, fq), qf[ks], cf); cb = mfma16(tile128_frag(tB, 16 * d, 4 * ks, fr, fq), qf[ks], cb); }
            y[d] += cf * xif + cb * xib; }
    }
    float s = 0.f;
#pragma unroll
    for (int d = 0; d < 8; ++d) s += (y[d].x + y[d].y) + (y[d].z + y[d].w);
    s += __shfl_xor(s, 16); s += __shfl_xor(s, 32);
    const float mu = s * (1.0f / 128.0f); float q = 0.f;
#pragma unroll
    for (int d = 0; d < 8; ++d) { y[d] = y[d] - mu; q += (y[d].x * y[d].x + y[d].y * y[d].y) + (y[d].z * y[d].z + y[d].w * y[d].w); }
    q += __shfl_xor(q, 16); q += __shfl_xor(q, 32);
    const float rstd = 1.0f / sqrtf(q * (1.0f / 128.0f) + LN_EPS);
    bf16_t* G = wsp<bf16_t>(c, P_CD) + (size_t)(row0 + il) * 1024 + h * 128 + 4 * fq;
    const float* gn = c.in[I_GNG] + l * 512 + h * 128 + 4 * fq;
#pragma unroll
    for (int d = 0; d < 8; ++d) { const u32x2 gw = *(const u32x2*)(G + 16 * d); const f32x4 gg = *(const f32x4*)(gn + 16 * d);
        f32x4 o = y[d] * rstd * gg; o.x *= bf_lo(gw.x); o.y *= bf_hi(gw.x); o.z *= bf_lo(gw.y); o.w *= bf_hi(gw.y); st4bf(G + 16 * d, o); }
    __syncthreads();
}

__device__ __forceinline__ void lru_item(const Ctx& c, int l, int it, bool final, bool dry = false) {
    const int n = it & 7, ch = (it >> 3) % 36, b = (it >> 3) / 36;
    const bool isctx = ch < 4; const int T = isctx ? CTX : SEQ, t0 = isctx ? 64 * ch : 64 * (ch - 4), rowbase = isctx ? NLAT + b * CTX : b * SEQ;
    LAS float* xa = (LAS float*)c.lds;
    LAS bf16_t* xab = (LAS bf16_t*)(c.lds + 16384);
    LAS float* ga = (LAS float*)(c.lds + 16384 + 9216);
    LAS float* gb = ga + 2 * 4096;
    LAS float* pa = gb + 2 * 4096;
    LAS float* h0 = pa + 1024;
    const bf16_t* AX = wsp<bf16_t>(c, P_AX);
    {
        const int t = c.tid >> 3, e8 = (c.tid & 7) * 8, cc = n * 64 + e8;
        const float* cw = c.in[I_CONVW] + l * 4 * 512 + cc; const float* cb = c.in[I_CONVB] + l * 512 + cc;
        float v[8]; { const f32x4 b0 = *(const f32x4*)cb, b1 = *(const f32x4*)(cb + 4); v[0] = b0.x; v[1] = b0.y; v[2] = b0.z; v[3] = b0.w; v[4] = b1.x; v[5] = b1.y; v[6] = b1.z; v[7] = b1.w; }
#pragma unroll
        for (int j = 0; j < 4; ++j) { const int tt = t0 + t + j - 2;
            if (tt >= 0 && tt < T) { const u32x4 xw = *(const u32x4*)(AX + (size_t)(rowbase + tt) * 512 + cc); const f32x4 w0 = *(const f32x4*)(cw + j * 512), w1 = *(const f32x4*)(cw + j * 512 + 4);
                v[0] += w0.x * bf_lo(xw.x); v[1] += w0.y * bf_hi(xw.x); v[2] += w0.z * bf_lo(xw.y); v[3] += w0.w * bf_hi(xw.y); v[4] += w1.x * bf_lo(xw.z); v[5] += w1.y * bf_hi(xw.z); v[6] += w1.z * bf_lo(xw.w); v[7] += w1.w * bf_hi(xw.w); } }
        *(LAS f32x4*)(xa + t * 64 + e8) = (f32x4){v[0], v[1], v[2], v[3]}; *(LAS f32x4*)(xa + t * 64 + e8 + 4) = (f32x4){v[4], v[5], v[6], v[7]};
        u32x4 o; o.x = cvt_pk_bf16(v[0], v[1]); o.y = cvt_pk_bf16(v[2], v[3]); o.z = cvt_pk_bf16(v[4], v[5]); o.w = cvt_pk_bf16(v[6], v[7]); *(LAS u32x4*)(xab + t * 72 + e8) = o;
    }
    if (final && c.tid < 128) {
        const int dir = c.tid >> 6, e = c.tid & 63, pos = dir == 0 ? ch : (isctx ? 3 - ch : 4 + (35 - ch));
        const float* sum = wsp<float>(c, WS_LRUSUM) + ((size_t)(b * 2 + dir) * 36) * 1024 + (n * 64 + e) * 2;
        float hst = 0.f;
        for (int q = 0; q < pos; ++q) { const f32x2 sq = *(const f32x2*)(sum + (size_t)q * 1024); hst = sq.x * hst + sq.y; }
        h0[dir * 64 + e] = hst;
    }
    __syncthreads();
    {
        const int fr = c.lane & 15, fq = c.lane >> 4, dir = c.wave >> 2, et = c.wave & 3, e = 16 * et + fr, cc = n * 64 + e;
        f32x4 ar[4], ai[4];
#pragma unroll
        for (int tt = 0; tt < 4; ++tt) { ar[tt] = (f32x4){0.f, 0.f, 0.f, 0.f}; ai[tt] = ar[tt]; }
        const bf16_t* Wa = wsp<bf16_t>(c, WM_LRU) + (size_t)((dir * 2 + 0) * 8 + n) * 4096 + e * 64 + 8 * fq;
        const bf16_t* Wx = wsp<bf16_t>(c, WM_LRU) + (size_t)((dir * 2 + 1) * 8 + n) * 4096 + e * 64 + 8 * fq;
#pragma unroll
        for (int ks = 0; ks < 2; ++ks) { const bf16x8 wa = ldfrag(Wa + 32 * ks), wx = ldfrag(Wx + 32 * ks);
#pragma unroll
            for (int tt = 0; tt < 4; ++tt) { const bf16x8 xf = *(const LAS bf16x8*)(xab + (16 * tt + fr) * 72 + 32 * ks + 8 * fq); ar[tt] = mfma16(xf, wa, ar[tt]); ai[tt] = mfma16(xf, wx, ai[tt]); } }
        const float ba = c.in[I_LBA][(l * 2 + dir) * 512 + cc], bx = c.in[I_LBX][(l * 2 + dir) * 512 + cc], lam = c.in[I_LLAM][(l * 2 + dir) * 512 + cc];
        const float sp8 = -8.0f * LOG2E * log1pf(expf(-lam));
#pragma unroll
        for (int tt = 0; tt < 4; ++tt)
#pragma unroll
            for (int r = 0; r < 4; ++r) { const int t = 16 * tt + 4 * fq + r;
                const float rg = sigmoidf_(ar[tt][r] + ba), ig = sigmoidf_(ai[tt][r] + bx);
                const float a = fast_exp2(rg * sp8), bt = __builtin_sqrtf(fmaxf(1.0f - a * a, 0.f)) * (ig * xa[t * 64 + e]);
                ga[(dir * 64 + t) * 64 + e] = a; gb[(dir * 64 + t) * 64 + e] = bt; }
    }
    __syncthreads();
    const int sdir = c.tid >> 8, part = (c.tid >> 6) & 3, se = c.tid & 63;
    float av[16], bv[16];
#pragma unroll
    for (int k = 0; k < 16; ++k) { const int i = 16 * part + k, t = sdir == 0 ? i : 63 - i; av[k] = ga[(sdir * 64 + t) * 64 + se]; bv[k] = gb[(sdir * 64 + t) * 64 + se]; }
    { float hh = 0.f, ap = 1.f;
#pragma unroll
      for (int k = 0; k < 16; ++k) { hh = av[k] * hh + bv[k]; ap *= av[k]; }
      *(LAS f32x2*)(pa + ((sdir * 4 + part) * 64 + se) * 2) = (f32x2){ap, hh}; }
    __syncthreads();
    if (!final) {
        if (part == 0) { float hh = 0.f, ap = 1.f;
#pragma unroll
            for (int q = 0; q < 4; ++q) { const f32x2 s = *(const LAS f32x2*)(pa + ((sdir * 4 + q) * 64 + se) * 2); hh = s.x * hh + s.y; ap *= s.x; }
            const int pos = sdir == 0 ? ch : (isctx ? 3 - ch : 4 + (35 - ch));
            *(f32x2*)(wsp<float>(c, WS_LRUSUM) + ((size_t)(b * 2 + sdir) * 36 + pos) * 1024 + (n * 64 + se) * 2) = (f32x2){ap, hh}; }
        return;
    }
    { float hh = h0[sdir * 64 + se];
      for (int q = 0; q < part; ++q) { const f32x2 s = *(const LAS f32x2*)(pa + ((sdir * 4 + q) * 64 + se) * 2); hh = s.x * hh + s.y; }
#pragma unroll
      for (int k = 0; k < 16; ++k) { const int i = 16 * part + k, t = sdir == 0 ? i : 63 - i; hh = av[k] * hh + bv[k]; gb[(sdir * 64 + t) * 64 + se] = hh; } }
    __syncthreads();
    {
        const int t = c.tid >> 3, e8 = (c.tid & 7) * 8;
        bf16_t* p = wsp<bf16_t>(c, P_AB) + (size_t)(rowbase + t0 + t) * 1024 + n * 64 + e8;
        const u32x4 g = *(const u32x4*)p;
        const f32x4 f0 = *(const LAS f32x4*)(gb + t * 64 + e8), f1 = *(const LAS f32x4*)(gb + t * 64 + e8 + 4), r0 = *(const LAS f32x4*)(gb + (64 + t) * 64 + e8), r1 = *(const LAS f32x4*)(gb + (64 + t) * 64 + e8 + 4);
        u32x4 o; o.x = cvt_pk_bf16((f0.x + r0.x) * bf_lo(g.x), (f0.y + r0.y) * bf_hi(g.x)); o.y = cvt_pk_bf16((f0.z + r0.z) * bf_lo(g.y), (f0.w + r0.w) * bf_hi(g.y));
        o.z = cvt_pk_bf16((f1.x + r1.x) * bf_lo(g.z), (f1.y + r1.y) * bf_hi(g.z)); o.w = cvt_pk_bf16((f1.z + r1.z) * bf_lo(g.w), (f1.w + r1.w) * bf_hi(g.w));
        if (!dry) *(u32x4*)p = o;
    }
    __syncthreads();
}
#ifndef DBG
#define DBG 0xFFF
#endif
constexpr int LDS_BYTES = 147456, MISC_OFF = 131072 + 320;
constexpr int CW_BAR = 4096;
struct Args { const float* in[27]; float* out; unsigned char* ws; };
__device__ __forceinline__ void make_ctx(Ctx& c, const Args& args, unsigned char* lds_raw) {
    int t = threadIdx.x; asm volatile("" : "+v"(t));
#pragma unroll
    for (int i = 0; i < 27; ++i) c.in[i] = args.in[i];
    float* o = args.out; unsigned char* w = args.ws; asm volatile("" : "+s"(o), "+s"(w));
    c.out = (float*)(GAS float*)o; c.ws = (unsigned char*)(GAS unsigned char*)w; c.lds = (LAS unsigned char*)lds_raw;
    c.tid = t; c.lane = t & 63; c.wave = __builtin_amdgcn_readfirstlane(t >> 6); c.G = gridDim.x; c.bid = blockIdx.x;
}
#define CTX() Ctx c; make_ctx(c, args, lds_raw)
__global__ void __launch_bounds__(512, 2) fwd_kernel(Args args) {
    extern __shared__ __attribute__((aligned(16))) unsigned char lds_raw[];
    XcdBarrier bar;
    { CTX();
      for (int u = c.tid; u < (LDS_BYTES - 131072) / 4; u += 512) ((LAS unsigned*)(c.lds + 131072))[u] = 0u;
      __syncthreads();
      bar = xcd_barrier_post(wsp<unsigned>(c, WS_CTL) + CW_BAR, (volatile LAS unsigned*)(c.lds + MISC_OFF) + 8); }
#define GRID_BAR() xcd_barrier(bar)
#define SCR(c) ((LAS float*)((c).lds + 57344 + (c).wave * 8704))
    { CTX(); p0_modtab(c); }
    { CTX(); p0_rope_tables(c); }
    { CTX(); int base = 0; conv_ffn(c, 0, 0, 0, base, c.bid * 8 + c.wave, c.G * 8, SCR(c)); conv_mixer(c, 0, base, c.bid * 8 + c.wave, c.G * 8, SCR(c)); }
    cg::this_grid().sync();
    GRID_BAR();
    { CTX(); p0_rows(c); }
    GRID_BAR();
#pragma unroll 1
    for (int l = 0; l < DEPTH; ++l) {
        const bool last = l == DEPTH - 1;
        const int nM = last ? 64 : 72;
        const int dbg = (DBG >> (3 * l)) & 7;
        if (dbg & 1) {
        for (int rep = 0; rep < ((TW & 16) ? 2 : 1); ++rep)
        { CTX(); SchedTiles S; S.ord.init(72, 22, c.G, c.bid); S.A = (const char*)wsp<bf16_t>(c, WS_H); S.B = (const char*)wsp<bf16_t>(c, WS_WF); S.ld = 1024; S.nt = 16;
          EpiSwiglu E{wsp<bf16_t>(c, WS_U)}; pg8::gemm_stream(c.lds, c.tid, S, E); }
        GRID_BAR();
        { CTX(); SchedTiles S; S.ord.init(72, 4, c.G, c.bid); S.A = (const char*)wsp<bf16_t>(c, WS_U); S.B = (const char*)(wsp<bf16_t>(c, WS_WF) + (size_t)5632 * 1024); S.ld = FF; S.nt = 44;
          EpiResid E{c, l, 2, 0.5f}; pg8::gemm_stream(c.lds, c.tid, S, E); }
        GRID_BAR();
        }
        { CTX(); phase_normalize(c, NT, c.in[I_LNG] + l * 3 * D, c.in[I_LNB] + l * 3 * D, l, 3, 4); }
        GRID_BAR();
        if (dbg & 2) {
        for (int rep = 0; rep < ((TW & 32) ? 2 : 1); ++rep)
        { CTX(); SchedTiles S; S.ord.init(72, 18, c.G, c.bid); S.A = (const char*)wsp<bf16_t>(c, WS_H); S.B = (const char*)wsp<bf16_t>(c, WM_INP); S.ld = 1024; S.nt = 16;
          EpiInp E{c}; pg8::gemm_stream(c.lds, c.tid, S, E); }
        GRID_BAR();
        { CTX(); SchedTiles S; S.ord.init(last ? 64 : 72, 3, c.G, c.bid); S.A = (const char*)(wsp<bf16_t>(c, P_CD) + 512); S.B = (const char*)wsp<bf16_t>(c, WM_UQ); S.ld = 1024; S.nt = 6;
          EpiMlaQ E{c}; pg8::gemm_stream(c.lds, c.tid, S, E); }
        { CTX(); SchedTiles S; S.ord.init(72, 4, c.G, c.bid); S.A = (const char*)wsp<bf16_t>(c, P_CKV); S.B = (const char*)wsp<bf16_t>(c, WM_UKV); S.ld = 256; S.nt = 4;
          EpiMlaKV E{c}; pg8::gemm_stream(c.lds, c.tid, S, E); __syncthreads(); }
        { CTX(); for (int it = c.bid; it < 8 * 36 * 8; it += c.G) lru_item(c, l, it, false); }
        { CTX(); for (int it = c.bid * 8 + c.wave; it < NT / 16; it += c.G * 8) mla_kr_item(c, it); }
        { CTX(); __syncthreads(); for (int it = c.bid; it < 8 * 4 * 18; it += c.G) ret_kv_block(c, l, it); }
        GRID_BAR();
        if (!(RDBG & 8)) { CTX(); for (int e = c.bid * 512 + c.tid; e < 64 * 2048; e += c.G * 512) ret_prefix(c, l, e); }
        GRID_BAR();
        { CTX(); for (int it = c.bid; it < 8 * 36 * 8; it += c.G) { if (last && ((it >> 3) % 36) < 4) continue; lru_item(c, l, it, true); } }
        { CTX(); for (int it = c.bid; it < 512; it += c.G) mla_block_item(c, it); }
        { CTX(); for (int it = c.bid; it < 512; it += c.G) gqa_block_item(c, l, it); }
        if (!last) { CTX(); const int gw = c.bid * 8 + c.wave, NGW = c.G * 8; for (int it = 2048 + gw; it < 2304; it += NGW) mla_item(c, it); for (int it = 2048 + gw; it < 2304; it += NGW) gqa_item(c, l, it); }
        { CTX(); __syncthreads(); for (int it = c.bid; it < 8 * 4 * 18; it += c.G) { if (last && (it % 18) < 2) continue; ret_out_block(c, l, it); } }
        GRID_BAR();
        { CTX(); SchedMerge S; S.ord.init(nM, 4, c.G, c.bid); S.H = (const char*)wsp<bf16_t>(c, WS_H); S.Wg = (const char*)wsp<bf16_t>(c, WM_G); S.Wb = (const char*)wsp<bf16_t>(c, WM_BR);
          S.AB = (const char*)wsp<bf16_t>(c, P_AB); S.CD = (const char*)wsp<bf16_t>(c, P_CD); S.ld = 1024;
          EpiMerge E{(GAS unsigned char*)(c.ws + WS_SCR_SIG + (size_t)c.bid * 131072), (GAS unsigned char*)(c.ws + WS_SCR_M + (size_t)c.bid * 262144), (GAS bf16_t*)wsp<bf16_t>(c, WS_MG)}; pg8::gemm_stream(c.lds, c.tid, S, E); }
        GRID_BAR();
        { CTX(); SchedTiles S; S.ord.init(nM, 4, c.G, c.bid); S.A = (const char*)wsp<bf16_t>(c, WS_MG); S.B = (const char*)wsp<bf16_t>(c, WM_OUT); S.ld = 1024; S.nt = 16;
          EpiResid E{c, l, 5, 1.0f}; pg8::gemm_stream(c.lds, c.tid, S, E); }
        GRID_BAR();
        }
        { CTX(); phase_normalize(c, nM * 256, c.in[I_LNG] + (l * 3 + 1) * D, c.in[I_LNB] + (l * 3 + 1) * D, l, 6, 7); }
        for (int rep = 0; rep < ((TW & 64) ? 2 : 1); ++rep)
        { CTX(); int base = 0; const int gw = c.bid * 8 + c.wave, NGW = c.G * 8; conv_ffn(c, l, 1, 1, base, gw, NGW, SCR(c)); if (!last) { conv_ffn(c, l + 1, 0, 0, base, gw, NGW, SCR(c)); conv_mixer(c, l + 1, base, gw, NGW, SCR(c)); } }
        GRID_BAR();
        if (dbg & 4) {
        { CTX(); SchedTiles S; S.ord.init(nM, 22, c.G, c.bid); S.A = (const char*)wsp<bf16_t>(c, WS_H); S.B = (const char*)wsp<bf16_t>(c, WS_WF + WF_SLOT); S.ld = 1024; S.nt = 16;
          EpiSwiglu E{wsp<bf16_t>(c, WS_U)}; pg8::gemm_stream(c.lds, c.tid, S, E); }
        GRID_BAR();
        { CTX(); SchedTiles S; S.ord.init(nM, 4, c.G, c.bid); S.A = (const char*)wsp<bf16_t>(c, WS_U); S.B = (const char*)(wsp<bf16_t>(c, WS_WF + WF_SLOT) + (size_t)5632 * 1024); S.ld = FF; S.nt = 44;
          EpiResid E{c, l, 8, 0.5f}; pg8::gemm_stream(c.lds, c.tid, S, E); }
        GRID_BAR();
        }
        { CTX(); phase_normalize(c, nM * 256, c.in[I_LNG] + (l * 3 + 2) * D, c.in[I_LNB] + (l * 3 + 2) * D, last ? -1 : l + 1, 0, 1); }
        if (!last) GRID_BAR();
    }
}

extern "C" void kernel_launch(void* const* d_in, const int* in_sizes, int n_in, void* d_out, int out_size, void* d_ws, size_t ws_size, hipStream_t stream) {
    static int grid = 0;
    if (grid == 0) {
        if (n_in != 27 || out_size != NLAT * D || ws_size < WS_END) { fprintf(stderr, "kernel_launch: unexpected problem (n_in %d, out %d, ws %zu < %zu)\n", n_in, out_size, ws_size, (size_t)WS_END); grid = -1; return; }
        int dev = 0, cus = 0, per_cu = 0;
        hipGetDevice(&dev); hipDeviceGetAttribute(&cus, hipDeviceAttributeMultiprocessorCount, dev);
        hipFuncSetAttribute((const void*)fwd_kernel, hipFuncAttributeMaxDynamicSharedMemorySize, LDS_BYTES);
        hipOccupancyMaxActiveBlocksPerMultiprocessor(&per_cu, (const void*)fwd_kernel, 512, LDS_BYTES);
        if (per_cu < 1) { fprintf(stderr, "kernel_launch: occupancy query says %d workgroups per CU\n", per_cu); per_cu = 1; }
        (void)hipGetLastError();
        grid = cus;
    }
    if (grid < 0) return;
    hipMemsetAsync((char*)d_ws + WS_CTL, 0, CTL_BYTES, stream);
    Args a{};
    for (int i = 0; i < 27; ++i) a.in[i] = (const float*)d_in[i];
    a.out = (float*)d_out; a.ws = (unsigned char*)d_ws;
    void* kargs[] = {&a};
    hipError_t e = hipLaunchCooperativeKernel((const void*)fwd_kernel, dim3(grid), dim3(512), kargs, LDS_BYTES, stream);
    if (e != hipSuccess) fprintf(stderr, "cooperative launch failed: %s (grid %d)\n", hipGetErrorString(e), grid);
}
```

```cpp
#include <hip/hip_runtime.h>
#include <hip/hip_cooperative_groups.h>
#include <cstdio>
#include <cstdint>
namespace cg = cooperative_groups;
#ifndef DBG
#define DBG 0xFFF
#endif
#ifndef RDBG
#define RDBG 7
#endif
#ifndef TW
#define TW 0
#endif

#define LAS __attribute__((address_space(3)))
#define GAS __attribute__((address_space(1)))
typedef unsigned short bf16_t;
typedef short bf16x8 __attribute__((ext_vector_type(8)));
typedef float f32x4 __attribute__((ext_vector_type(4)));
typedef float f32x2 __attribute__((ext_vector_type(2)));
typedef unsigned u32x4 __attribute__((ext_vector_type(4)));
typedef unsigned u32x2 __attribute__((ext_vector_type(2)));

constexpr int D = 1024, NB = 8, SEQ = 2048, CTX = 256, DEPTH = 2, FF = 2816;
constexpr int NLAT = NB * SEQ;
constexpr int NCTX = NB * CTX;
constexpr int NT = NLAT + NCTX;
constexpr int SALL = CTX + SEQ;
constexpr int IN_COLS = 8608, NINP = 4608;
constexpr float LN_EPS = 1e-5f;
constexpr float DN_ALPHA = 1.41421356237309515f;
constexpr float LOG2E = 1.44269504088896341f;

constexpr size_t MiB = 1u << 20;
constexpr size_t WS_CTL = 0, CTL_BYTES = 1 * MiB;
constexpr size_t WS_MISC = 1 * MiB;
constexpr size_t WS_MODTAB = WS_MISC;
constexpr size_t WS_CS8 = WS_MISC + 1 * MiB;
constexpr size_t WS_CS16 = WS_CS8 + 64 * 8 * 2 * 4;
constexpr size_t WS_CS32 = WS_CS16 + 64 * 16 * 2 * 4;
constexpr size_t WS_LRUSUM = WS_MISC + 1 * MiB + 512 * 1024;
constexpr size_t WS_WM = 5 * MiB;
constexpr size_t WM_INP = WS_WM, WM_G = WS_WM + 9 * MiB, WM_BR = WS_WM + 17 * MiB, WM_OUT = WS_WM + 21 * MiB, WM_UQ = WS_WM + 23 * MiB  , WM_UKV = WS_WM + 24 * MiB + 512 * 1024  , WM_LRU = WS_MISC + 1 * MiB + 64 * 1024;
constexpr size_t WS_XC = 30 * MiB;
constexpr size_t WS_H = 38 * MiB;
constexpr size_t WS_QF = 74 * MiB;
constexpr size_t WS_KF = 101 * MiB;
constexpr size_t WS_VTM = 128 * MiB;
constexpr size_t WS_MG = WS_KF;
constexpr size_t WS_RET = 146 * MiB;
constexpr size_t WS_BIG = 182 * MiB;
constexpr size_t P_AX = WS_BIG, P_DQ = WS_BIG + 18 * MiB, P_DK = WS_BIG + 36 * MiB, VT_RET = WS_BIG + 54 * MiB, KT_RET = WS_BIG + 72 * MiB, VT_GQA = WS_BIG + 90 * MiB;
constexpr size_t P_BK = WS_BIG + 94 * MiB + 512 * 1024;
constexpr size_t P_AB = WS_BIG + 99 * MiB;
constexpr size_t P_CD = WS_BIG + 135 * MiB;
constexpr size_t P_CKV = WS_BIG + 171 * MiB, P_CKR = P_CKV + (size_t)NT * 256 * 2;
constexpr size_t ST_CQ = P_CKR + (size_t)NT * 32 * 2  , ST_CKV = ST_CQ + (size_t)NT * 12 * 4  , WS_END = ST_CKV + (size_t)NT * 8 * 4;
constexpr size_t WS_U = WS_BIG;
constexpr size_t WS_WF = WS_BIG + 99 * MiB;
constexpr size_t WF_SLOT = (size_t)(5632 * 1024 + 1024 * 2816) * 2;
constexpr size_t WS_SLAB_FFN = WS_BIG + 136 * MiB;
constexpr size_t WS_SLAB_OUT = WS_BIG;
constexpr size_t WS_MGP = WS_QF;
constexpr size_t WS_SCR_SIG = WS_BIG, WS_SCR_M = WS_BIG + 32 * MiB;
static_assert(WS_WF + 2 * WF_SLOT <= WS_END && WS_U + (size_t)NT * FF * 2 <= WS_WF, "FFN overlay");
static_assert(WS_SCR_M + 64 * MiB <= P_AB, "merge scratch overlay");

typedef __bf16 bf16x2_t __attribute__((ext_vector_type(2)));
__device__ __forceinline__ unsigned cvt_pk_bf16(float lo, float hi) { bf16x2_t v; v.x = (__bf16)lo; v.y = (__bf16)hi; return __builtin_bit_cast(unsigned, v); }
__device__ __forceinline__ float bf_lo(unsigned w) { return __uint_as_float(w << 16); }
__device__ __forceinline__ float bf_hi(unsigned w) { return __uint_as_float(w & 0xffff0000u); }
__device__ __forceinline__ float bf2f(bf16_t b) { return __uint_as_float(((unsigned)b) << 16); }
__device__ __forceinline__ bf16_t f2bf(float f) { return (bf16_t)(cvt_pk_bf16(f, 0.f) & 0xffffu); }
__device__ __forceinline__ float fast_exp2(float x) { return __builtin_amdgcn_exp2f(x); }
__device__ __forceinline__ float fast_rcp(float x) { return __builtin_amdgcn_rcpf(x); }
__device__ __forceinline__ float sigmoidf_(float x) { return fast_rcp(1.0f + fast_exp2(-LOG2E * x)); }
__device__ __forceinline__ float siluf_(float x) { return x * sigmoidf_(x); }
__device__ __forceinline__ float geluf_(float v) { return v * sigmoidf_(1.5957691216057308f * (v + 0.044715f * v * v * v)); }
__device__ __forceinline__ float wave_sum(float v) {
#pragma unroll
    for (int o = 1; o < 64; o <<= 1) v += __shfl_xor(v, o);
    return v;
}
__device__ __forceinline__ int row_mod(int row) { return row < NLAT ? (row >> 11) : 8; }
__device__ __forceinline__ int posperm(int key) { return 8 * ((key >> 2) & 3) + 4 * ((key >> 4) & 1) + (key & 3); }
#define XB_TMO      128
#define XB_XCNT(j)  (256  + 64 * (j))
#define XB_XSUB(j)  (1280 + 64 * (j))
#define XB_XGEN(j)  (2304 + 64 * (j))
#define XB_TOP      3328
#define XB_TOPGEN   3392
#define XCD_BAR_WORDS 3456
#define XB_SPIN_CAP (1u << 20)
__device__ __forceinline__ unsigned xb_ld(unsigned* p)              { return __hip_atomic_load(p, __ATOMIC_RELAXED, __HIP_MEMORY_SCOPE_AGENT); }
__device__ __forceinline__ unsigned xb_add(unsigned* p, unsigned v) { return __hip_atomic_fetch_add(p, v, __ATOMIC_RELAXED, __HIP_MEMORY_SCOPE_AGENT); }
__device__ __forceinline__ unsigned xb_xcc_id() { return (unsigned)__builtin_amdgcn_s_getreg((3 << 11) | 20) & 0xFu; }
#define XB_SPIN(cond, bar) do { unsigned _sp = 0; while (cond) { __builtin_amdgcn_s_sleep(1); \
    if ((++_sp & 255u) == 0u) { if (xb_ld(&(bar)[XB_TMO])) break; if (_sp > XB_SPIN_CAP) { atomicAdd(&(bar)[XB_TMO], 1u); break; } } } } while (0)
struct XcdBarrier { unsigned* bar; unsigned x; volatile LAS unsigned* st; };
__device__ __forceinline__ XcdBarrier xcd_barrier_post(unsigned* bar, volatile LAS unsigned* st) {
    XcdBarrier b; b.bar = bar; b.x = xb_xcc_id(); b.st = st;
    if (threadIdx.x == 0) (void)xb_add(&bar[XB_XCNT(b.x)], 1u);
    return b;
}
__device__ __forceinline__ void xcd_barrier_complete(unsigned* bar, unsigned x, unsigned& nloc, unsigned& nx) {
    const unsigned G = gridDim.x * gridDim.y * gridDim.z;
    unsigned sum, cnt, mine, sp = 0u;
    for (;;) {
        sum = 0u; cnt = 0u; mine = 0u;
#pragma unroll
        for (unsigned j = 0; j < 16; ++j) { const unsigned c = xb_ld(&bar[XB_XCNT(j)]); sum += c; cnt += (c > 0u) ? 1u : 0u; mine = (j == x) ? c : mine; }
        if (sum == G) break;
        __builtin_amdgcn_s_sleep(1);
        if ((++sp & 255u) == 0u) { if (xb_ld(&bar[XB_TMO])) break; if (sp > XB_SPIN_CAP) { atomicAdd(&bar[XB_TMO], 1u); break; } }
    }
    nloc = mine > 0u ? mine : 1u; nx = cnt > 0u ? cnt : 1u;
}
__device__ __forceinline__ void xcd_barrier(const XcdBarrier& b) {
    asm volatile("s_waitcnt vmcnt(0)" ::: "memory");
    __syncthreads();
    if (threadIdx.x == 0) {
        unsigned* bar = b.bar; asm volatile("" : "+s"(bar));
        bar = (unsigned*)(GAS unsigned*)bar;
        unsigned bx = b.x; asm volatile("" : "+s"(bx));
        __builtin_amdgcn_s_waitcnt(0);
        unsigned nloc = b.st[0], nx = b.st[1];
        if (nloc == 0u) { xcd_barrier_complete(bar, bx, nloc, nx); b.st[0] = nloc; b.st[1] = nx; }
        const unsigned old = xb_add(&bar[XB_XSUB(bx)], 1u);
        const unsigned gen = old / nloc;
        if (old + 1u == (gen + 1u) * nloc) {
            __builtin_amdgcn_fence(__ATOMIC_RELEASE, "agent");
            asm volatile("s_waitcnt vmcnt(0)" ::: "memory");
            const unsigned og = xb_add(&bar[XB_TOP], 1u);
            const unsigned tg = og / nx;
            if (og + 1u == (tg + 1u) * nx) xb_add(&bar[XB_TOPGEN], 1u);
            else XB_SPIN(xb_ld(&bar[XB_TOPGEN]) == tg, bar);
            __builtin_amdgcn_fence(__ATOMIC_ACQUIRE, "agent");
            xb_add(&bar[XB_XGEN(bx)], 1u);
            asm volatile("s_waitcnt vmcnt(0)" ::: "memory");
        } else {
            XB_SPIN(xb_ld(&bar[XB_XGEN(bx)]) == gen, bar);
            __builtin_amdgcn_fence(__ATOMIC_ACQUIRE, "agent");
            asm volatile("s_waitcnt vmcnt(0)" ::: "memory");
        }
    }
    __syncthreads();
}

namespace pg8 {
constexpr int BM = 256, BK = 64, HALF = 128, HTB = HALF * BK * 2, STAGE_BYTES = 8 * HTB, NXCD = 8, WGM = 8;
__host__ __device__ __forceinline__ int lds_byte(int r, int c) { const int st = (r >> 4) * 2 + (c >> 5), rr = r & 15, cc = c & 31, ob = rr * 64 + cc * 2; return st * 1024 + (ob ^ (((ob >> 9) & 1) << 5)); }
__host__ __device__ __forceinline__ void stage_rc(int b, int& R, int& C) { const int st = b / 1024, sb = b % 1024, swz = sb ^ (((sb >> 9) & 1) << 5); R = (st >> 1) * 16 + swz / 64; C = (st & 1) * 32 + (swz % 64) / 2; }
__host__ __device__ __forceinline__ int perm32(int rho) { const int n = rho >> 4, i = rho & 15; return 8 * (i >> 2) + 4 * n + (i & 3); }

struct Unit { const char* A; const char* B; int nt, kind, pm, pn, k; };

struct TileOrder {
    int nM, nN, nwg, G, c;
    __device__ void init(int nM_, int nN_, int G_, int c_) { nM = nM_; nN = nN_; nwg = nM * nN; G = G_; c = c_; }
    __device__ bool tile(int i, int& pm, int& pn) const {
        const long L = (long)i * G + c; if (L >= nwg) return false;
        int wgid = (int)L; { const int q = nwg / NXCD, r = nwg % NXCD, xcd = wgid % NXCD, off = wgid / NXCD; wgid = (xcd < r ? xcd * (q + 1) : r * (q + 1) + (xcd - r) * q) + off; }
        const int nig = WGM * nN, gid = wgid / nig, fm = gid * WGM, gsz = (nM - fm) < WGM ? (nM - fm) : WGM;
        pm = fm + ((wgid % nig) % gsz); pn = (wgid % nig) / gsz; return true;
    }
};

template <class Epi, class Sched>
__device__ __forceinline__ void gemm_stream(LAS unsigned char* lds, const int tid, const Sched& S, const Epi& E) {
    const int wid = __builtin_amdgcn_readfirstlane(tid >> 6), lane = tid & 63, wr = wid >> 2, wc = wid & 3, fr = lane & 15, fq = lane >> 4;
    unsigned voff[2];
#pragma unroll
    for (int i = 0; i < 2; ++i) { int R, C; stage_rc(tid * 16 + i * 8192, R, C); voff[i] = (unsigned)(R * S.ld + C) * 2u; }
    const size_t hstep = (size_t)HALF * S.ld * 2;
    const size_t kstep = (size_t)(BK * 2);
    const unsigned ldsw = (unsigned)wid * 1024u;
    const int aoff = lds_byte(wr * 64 + fr, fq * 8), boff = lds_byte(wc * 32 + fr, fq * 8);
#define PG8_SA(b, h) (((b) * 2 + (h)) * HTB)
#define PG8_SB(b, h) ((4 + (b) * 2 + (h)) * HTB)
#define PG8_STAGE(bufoff, gbase, voff) do { _Pragma("unroll") for (int _i = 0; _i < 2; ++_i) \
        __builtin_amdgcn_global_load_lds((const unsigned*)((const char*)(gbase) + (voff)[_i]), (LAS unsigned*)(lds + (bufoff) + ldsw + _i * 8192), 16, 0, 0); } while (0)
#define PG8_LDA(dst, b, h) do { _Pragma("unroll") for (int m = 0; m < 4; ++m) _Pragma("unroll") for (int k = 0; k < 2; ++k) dst[m][k] = *(const LAS bf16x8*)(lds + PG8_SA(b, h) + aoff + m * 2048 + k * 1024); } while (0)
#define PG8_LDB(dst, b, h) do { _Pragma("unroll") for (int n = 0; n < 2; ++n) _Pragma("unroll") for (int k = 0; k < 2; ++k) dst[n][k] = *(const LAS bf16x8*)(lds + PG8_SB(b, h) + boff + n * 2048 + k * 1024); } while (0)
#define PG8_MMA(ai, bj, At, Bt) do { __builtin_amdgcn_s_setprio(1); _Pragma("unroll") for (int m = 0; m < 4; ++m) _Pragma("unroll") for (int n = 0; n < 2; ++n) _Pragma("unroll") for (int k = 0; k < 2; ++k) \
        acc[ai][bj][m][n] = __builtin_amdgcn_mfma_f32_16x16x32_bf16(Bt[n][k], At[m][k], acc[ai][bj][m][n], 0, 0, 0); __builtin_amdgcn_s_setprio(0); } while (0)
#define PG8_WAIT_V(n) asm volatile("s_waitcnt vmcnt(" #n ")" ::: "memory")
#define PG8_WAIT_L(n) asm volatile("s_waitcnt lgkmcnt(" #n ")" ::: "memory")
#define PG8_BAR __builtin_amdgcn_s_barrier()
#define PG8_SCHED __builtin_amdgcn_sched_barrier(0)
    Unit cur, nxt; int ui = 0;
    if (!S.next(0, cur)) return;
    f32x4 acc[2][2][4][2];
#pragma unroll
    for (int a = 0; a < 2; ++a)
#pragma unroll
        for (int b = 0; b < 2; ++b)
#pragma unroll
            for (int m = 0; m < 4; ++m)
#pragma unroll
                for (int n = 0; n < 2; ++n) acc[a][b][m][n] = (f32x4){0.f, 0.f, 0.f, 0.f};
    bf16x8 At[4][2], B0[2][2], B1[2][2];
    const char* cA = cur.A; const char* cB = cur.B;
    PG8_STAGE(PG8_SB(0, 0), cB, voff); PG8_STAGE(PG8_SB(0, 1), cB + hstep, voff); PG8_STAGE(PG8_SA(0, 0), cA, voff); PG8_STAGE(PG8_SA(0, 1), cA + hstep, voff);
    if (wr == 1) PG8_BAR;
    PG8_WAIT_V(2); PG8_BAR;
    PG8_STAGE(PG8_SB(1, 0), cB + kstep, voff); PG8_STAGE(PG8_SA(1, 0), cA + kstep, voff); PG8_STAGE(PG8_SB(1, 1), cB + hstep + kstep, voff);
    PG8_WAIT_V(6); PG8_BAR;
    for (;;) {
        const bool has_next = S.next(ui + 1, nxt);
        const char* nA; const char* nB;
        if (has_next) { nA = nxt.A; nB = nxt.B; } else { nA = cA; nB = cB; }
        const int nt = cur.nt;
        for (int t = 0; t < nt; t += 2) {
            const bool last = (t == nt - 2);
            const char* a1 = cA + (size_t)(t + 1) * kstep;
            const char* a2 = last ? nA : cA + (size_t)(t + 2) * kstep; const char* b2 = last ? nB : cB + (size_t)(t + 2) * kstep;
            const char* a3 = a2 + kstep; const char* b3 = b2 + kstep;
            PG8_LDB(B0, 0, 0); PG8_LDB(B1, 0, 1); PG8_SCHED; PG8_LDA(At, 0, 0); PG8_STAGE(PG8_SA(1, 1), a1 + hstep, voff);
            PG8_WAIT_V(8); PG8_WAIT_L(0); PG8_BAR; PG8_MMA(0, 0, At, B0); PG8_MMA(0, 1, At, B1); PG8_BAR; PG8_SCHED;
            PG8_LDA(At, 0, 1); PG8_STAGE(PG8_SB(0, 0), b2, voff); PG8_STAGE(PG8_SB(0, 1), b2 + hstep, voff); PG8_STAGE(PG8_SA(0, 0), a2, voff);
            PG8_WAIT_V(8); PG8_WAIT_L(0); PG8_BAR; PG8_MMA(1, 0, At, B0); PG8_MMA(1, 1, At, B1); PG8_BAR; PG8_SCHED;
            PG8_LDB(B0, 1, 0); PG8_LDB(B1, 1, 1); PG8_SCHED; PG8_LDA(At, 1, 0); PG8_STAGE(PG8_SA(0, 1), a2 + hstep, voff);
            PG8_WAIT_V(8); PG8_WAIT_L(0); PG8_BAR; PG8_MMA(0, 0, At, B0); PG8_MMA(0, 1, At, B1); PG8_BAR; PG8_SCHED;
            PG8_LDA(At, 1, 1); PG8_STAGE(PG8_SB(1, 0), b3, voff); PG8_STAGE(PG8_SB(1, 1), b3 + hstep, voff); PG8_STAGE(PG8_SA(1, 0), a3, voff);
            PG8_WAIT_V(8); PG8_WAIT_L(0); PG8_BAR; PG8_MMA(1, 0, At, B0); PG8_MMA(1, 1, At, B1); PG8_BAR; PG8_SCHED;
        }
        if (wr == 0) PG8_BAR;
        E(acc, cur, wr, wc, fr, fq);
        if (!has_next) break;
#pragma unroll
        for (int a = 0; a < 2; ++a)
#pragma unroll
            for (int b = 0; b < 2; ++b)
#pragma unroll
                for (int m = 0; m < 4; ++m)
#pragma unroll
                    for (int n = 0; n < 2; ++n) acc[a][b][m][n] = (f32x4){0.f, 0.f, 0.f, 0.f};
        cur = nxt; cA = nA; cB = nB; ++ui;
        if (wr == 1) PG8_BAR;
    }
    PG8_WAIT_V(0);
    PG8_BAR;
#undef PG8_SA
#undef PG8_SB
#undef PG8_STAGE
#undef PG8_LDA
#undef PG8_LDB
#undef PG8_MMA
#undef PG8_WAIT_V
#undef PG8_WAIT_L
#undef PG8_BAR
#undef PG8_SCHED
}
}
struct Ctx {
    const float* in[27]; float* out; unsigned char* ws;
    LAS unsigned char* lds; int tid, lane, wave, G, bid;
};
enum { I_X = 0, I_C, I_CTX, I_CCTX, I_WMOD, I_BMOD, I_LNG, I_LNB, I_FFNIN, I_FFNOUT, I_WIN, I_CONVW, I_CONVB, I_LWA, I_LBA, I_LWX, I_LBX, I_LLAM, I_SINK, I_QNORM, I_KVNORM, I_WUQ, I_WUKV, I_RDECAY, I_GNG, I_WBR, I_WOUT };
template <class T> __device__ __forceinline__ T* wsp(const Ctx& c, size_t off) { return (T*)(c.ws + off); }
__device__ __forceinline__ float* xrow_ptr(const Ctx& c, int row) { return row < NLAT ? c.out + (size_t)row * D : wsp<float>(c, WS_XC) + (size_t)(row - NLAT) * D; }
__device__ __forceinline__ const float* modp(const Ctx& c, int l, int r, int k) { return wsp<float>(c, WS_MODTAB) + ((size_t)(l * 9 + r) * 9 + k) * D; }

enum { MAP_NAT = 0, MAP_PERM32, MAP_SWIGLU, MAP_INP, MAP_GATE, MAP_UQ, MAP_UKV };
constexpr int IO_AX = 0, IO_AY = 512, IO_BQ = 1024, IO_BK = 1536, IO_BV = 1664, IO_CQ = 1792, IO_CKV = 2176, IO_CKR = 2432, IO_DQ = 2464, IO_DK = 2976, IO_DV = 3488, IO_DG = 4000, IO_GT = 4512;
enum { EK_PLAIN = 0, EK_GELU, EK_SILU, EK_ROPE16, EK_ROPE32, EK_ROPE32K, EK_VT, EK_CKR };
struct HalfTile { int kind, src, dstoff; };
__device__ __forceinline__ HalfTile inp_half(int pn, int bj) {
    const int h = pn * 2 + bj;
    switch (pn) {
        case 0: case 1:   return HalfTile{EK_PLAIN, IO_AX + 128 * h, 128 * h};
        case 2: case 3:   return HalfTile{EK_GELU, IO_AY + 128 * (h - 4), 128 * (h - 4)};
        case 4: case 5:   return HalfTile{EK_ROPE16, IO_BQ + 128 * (h - 8), 128 * (h - 8)};
        case 6:           return bj == 0 ? HalfTile{EK_ROPE16, IO_BK, 0} : HalfTile{EK_VT, IO_BV, 0};
        case 7:           return HalfTile{EK_PLAIN, IO_CQ + 128 * (h - 14), 128 * (h - 14)};
        case 8:           return bj == 0 ? HalfTile{EK_PLAIN, IO_CQ + 256, 256} : HalfTile{EK_CKR, IO_CKR, 0};
        case 9:           return HalfTile{EK_PLAIN, IO_CKV + 128 * (h - 18), 128 * (h - 18)};
        case 10: case 11: return HalfTile{EK_ROPE32, IO_DQ + 128 * (h - 20), 128 * (h - 20)};
        case 12: case 13: return HalfTile{EK_ROPE32K, IO_DK + 128 * (h - 24), 128 * (h - 24)};
        case 14: case 15: return HalfTile{EK_VT, IO_DV + 128 * (h - 28), 128 * (h - 28)};
        default:          return HalfTile{EK_SILU, IO_DG + 128 * (h - 32), 128 * (h - 32)};
    }
}
struct RowMap {
    int mode; const float* kscale; float cscale;
    __device__ __forceinline__ int col(int R, float& sc) const {
        sc = cscale;
        switch (mode) {
            case MAP_NAT: return R;
            case MAP_PERM32: return (R & ~31) + pg8::perm32(R & 31);
            case MAP_SWIGLU: { const int pn = R >> 8, cs = R & 255, bj = cs >> 7, wc = (cs >> 5) & 3, n = (cs >> 4) & 1, i = cs & 15;
                return (n ? FF : 0) + 128 * pn + 32 * wc + 8 * (i >> 2) + 4 * bj + (i & 3); }
            case MAP_GATE: return IO_GT + (R & ~31) + pg8::perm32(R & 31);
            case MAP_UQ: {
                const int g = R >> 5, h = g / 3, gi = g % 3, rho = R & 31, n = rho >> 4, i = rho & 15;
                if (gi < 2) return 96 * h + 32 * gi + pg8::perm32(rho);
                return 96 * h + 64 + 16 * (i >> 3) + 8 * n + (i & 7); }
            case MAP_UKV: {
                const int g = R >> 5, h = g >> 2, gi = g & 3, rho = R & 31;
                if (gi < 2) return 128 * h + 32 * gi + pg8::perm32(rho);
                return 128 * h + 32 * gi + rho; }
            default: {
                const int pn = R >> 8, cs = R & 255, bj = cs >> 7, c7 = cs & 127, wc = (cs >> 5) & 3, n = (cs >> 4) & 1, i = cs & 15;
                const HalfTile ht = inp_half(pn, bj);
                switch (ht.kind) {
                    case EK_PLAIN: case EK_GELU: case EK_SILU: return ht.src + 32 * wc + pg8::perm32(cs & 31);
                    case EK_ROPE16: if (ht.src != IO_BK) sc = 0.125f * LOG2E; return ht.src + c7;
                    case EK_VT: return ht.src + c7;
                    case EK_ROPE32: return ht.src + 64 * (wc >> 1) + 32 * n + 16 * (wc & 1) + i;
                    case EK_ROPE32K: sc = 0.08838834764831845f; return ht.src + 64 * (wc >> 1) + 32 * n + 16 * (wc & 1) + i;
                    default: return c7 < 32 ? ht.src + c7 : -1;
                }
            }
        }
    }
};
__device__ __forceinline__ void conv_block(const float* W, int ldw, bf16_t* WT, int ldk, LAS float* scr, int k0, int n0, const RowMap& mp, int lane) {
    float cs; const int sc = mp.col(n0 + (lane & 31), cs);
    float vv[32];
    const float* Wp = W + (size_t)(k0 + (lane >> 5)) * ldw + (sc >= 0 ? sc : 0);
#pragma unroll
    for (int i = 0; i < 32; ++i) vv[i] = Wp[(size_t)(2 * i) * ldw];
#pragma unroll
    for (int i = 0; i < 32; ++i) { const int kk = 2 * i + (lane >> 5);
        float v = sc >= 0 ? vv[i] * cs : 0.f; if (mp.kscale) v *= mp.kscale[k0 + kk];
        scr[kk * 33 + (lane & 31)] = v; }
    asm volatile("s_waitcnt lgkmcnt(0)" ::: "memory");
    const int c = lane & 7;
#pragma unroll
    for (int j = 0; j < 4; ++j) { const int n = (lane >> 3) + 8 * j; const LAS float* s = scr + (8 * c) * 33 + n;
        u32x4 o; o.x = cvt_pk_bf16(s[0 * 33], s[1 * 33]); o.y = cvt_pk_bf16(s[2 * 33], s[3 * 33]); o.z = cvt_pk_bf16(s[4 * 33], s[5 * 33]); o.w = cvt_pk_bf16(s[6 * 33], s[7 * 33]);
        *(u32x4*)(WT + (size_t)(n0 + n) * ldk + k0 + 8 * c) = o; }
    asm volatile("s_waitcnt lgkmcnt(0)" ::: "memory");
}
struct ConvJob { const float* W; int ldw, K, N; bf16_t* WT; int ldk; RowMap mp; };
__device__ __forceinline__ void conv_job_run(const Ctx& c, const ConvJob& j, int& base, int gw, int NGW, LAS float* scr) {
    const int nkb = j.K / 64, nnb = j.N / 32, nblk = nkb * nnb;
    int first = gw - (base % NGW); if (first < 0) first += NGW;
    for (int b = first; b < nblk; b += NGW) conv_block(j.W, j.ldw, j.WT, j.ldk, scr, 64 * (b / nnb), 32 * (b % nnb), j.mp, c.lane);
    base += nblk;
}
__device__ __forceinline__ void conv_ffn(const Ctx& c, int l, int f, int slot, int& base, int gw, int NGW, LAS float* scr) {
    bf16_t* w1t = wsp<bf16_t>(c, WS_WF + slot * WF_SLOT); bf16_t* w2t = w1t + (size_t)5632 * 1024;
    ConvJob j1{c.in[I_FFNIN] + (size_t)(l * 2 + f) * 1024 * 5632, 5632, 1024, 5632, w1t, 1024, RowMap{MAP_SWIGLU, nullptr, 1.f}};
    conv_job_run(c, j1, base, gw, NGW, scr);
    ConvJob j2{c.in[I_FFNOUT] + (size_t)(l * 2 + f) * FF * 1024, 1024, FF, 1024, w2t, FF, RowMap{MAP_NAT, nullptr, 1.f}};
    conv_job_run(c, j2, base, gw, NGW, scr);
}
__device__ __forceinline__ void conv_mixer(const Ctx& c, int l, int& base, int gw, int NGW, LAS float* scr) {
    const float* win = c.in[I_WIN] + (size_t)l * 1024 * IN_COLS;
    { ConvJob j{win, IN_COLS, 1024, NINP, wsp<bf16_t>(c, WM_INP), 1024, RowMap{MAP_INP, nullptr, 1.f}}; conv_job_run(c, j, base, gw, NGW, scr); }
    { ConvJob j{win, IN_COLS, 1024, 4096, wsp<bf16_t>(c, WM_G), 1024, RowMap{MAP_GATE, nullptr, 1.f}}; conv_job_run(c, j, base, gw, NGW, scr); }
    for (int k = 0; k < 4; ++k) {
        ConvJob j{c.in[I_WBR] + (size_t)(l * 4 + k) * 512 * 1024, 1024, 512, 1024, wsp<bf16_t>(c, WM_BR) + (size_t)(k >> 1) * 1024 * 1024 + 512 * (k & 1), 1024, RowMap{MAP_PERM32, nullptr, 1.f}}; conv_job_run(c, j, base, gw, NGW, scr); }
    { ConvJob j{c.in[I_WOUT] + (size_t)l * 1024 * 1024, 1024, 1024, 1024, wsp<bf16_t>(c, WM_OUT), 1024, RowMap{MAP_NAT, nullptr, 1.f}}; conv_job_run(c, j, base, gw, NGW, scr); }
    { ConvJob j{c.in[I_WUQ] + (size_t)l * 384 * 768, 768, 384, 768, wsp<bf16_t>(c, WM_UQ), 1024, RowMap{MAP_UQ, c.in[I_QNORM] + l * 384, 0.10206207261596577f * LOG2E}}; conv_job_run(c, j, base, gw, NGW, scr); }
    { ConvJob j{c.in[I_WUKV] + (size_t)l * 256 * 1024, 1024, 256, 1024, wsp<bf16_t>(c, WM_UKV), 256, RowMap{MAP_UKV, c.in[I_KVNORM] + l * 256, 1.f}}; conv_job_run(c, j, base, gw, NGW, scr); }
    for (int m = 0; m < 32; ++m) {
        const int dir = m >> 4, gate = (m >> 3) & 1, n = m & 7;
        const float* W = (gate ? c.in[I_LWX] : c.in[I_LWA]) + (size_t)(((l * 2 + dir) * 8 + n) * 64) * 64;
        ConvJob j{W, 64, 64, 64, wsp<bf16_t>(c, WM_LRU) + (size_t)m * 4096, 64, RowMap{MAP_NAT, nullptr, 1.f}}; conv_job_run(c, j, base, gw, NGW, scr);
    }
}

__device__ __forceinline__ void p0_modtab(const Ctx& c) {
    LAS float* S = (LAS float*)c.lds;
    LAS float* R = (LAS float*)(c.lds + 9 * 1024 * 4);
    for (int i = c.tid; i < 9 * 1024; i += 512) { const int r = i >> 10, k = i & 1023; const float v = r < 8 ? c.in[I_C][r * 1024 + k] : c.in[I_CCTX][k]; S[i] = v / (1.0f + expf(-v)); }
    __syncthreads();
    for (int it = c.bid; it < 2 * 144; it += c.G) {
        const int l = it / 144, cg_ = it % 144, col = 64 * cg_ + c.lane;
        const float* W = c.in[I_WMOD] + (size_t)l * 1024 * 9216 + col;
        float acc[9];
#pragma unroll
        for (int r = 0; r < 9; ++r) acc[r] = 0.f;
        const int k0 = c.wave * 128;
#pragma unroll 2
        for (int k = k0; k < k0 + 128; k += 4) {
            const float w0 = W[(size_t)k * 9216], w1 = W[(size_t)(k + 1) * 9216], w2 = W[(size_t)(k + 2) * 9216], w3 = W[(size_t)(k + 3) * 9216];
#pragma unroll
            for (int r = 0; r < 9; ++r) { const f32x4 s = *(const LAS f32x4*)(S + r * 1024 + k); acc[r] += s.x * w0 + s.y * w1 + s.z * w2 + s.w * w3; }
        }
#pragma unroll
        for (int r = 0; r < 9; ++r) R[(c.wave * 9 + r) * 64 + c.lane] = acc[r];
        __syncthreads();
        for (int i = c.tid; i < 9 * 64; i += 512) { const int r = i >> 6, ln = i & 63; float s = 0.f;
#pragma unroll
            for (int w = 0; w < 8; ++w) s += R[(w * 9 + r) * 64 + ln];
            wsp<float>(c, WS_MODTAB)[(size_t)(l * 9 + r) * 9216 + 64 * cg_ + ln] = s + c.in[I_BMOD][l * 9216 + 64 * cg_ + ln]; }
        __syncthreads();
    }
}
__device__ __forceinline__ void p0_rope_tables(const Ctx& c) {
    if (c.bid != c.G - 1) return;
    for (int i = c.tid; i < 64 * 56; i += 512) {
        const int pos = i / 56, r = i % 56; int nf, f; float* tab;
        if (r < 8) { nf = 8; f = r; tab = wsp<float>(c, WS_CS8); } else if (r < 24) { nf = 16; f = r - 8; tab = wsp<float>(c, WS_CS16); } else { nf = 32; f = r - 24; tab = wsp<float>(c, WS_CS32); }
        const float inv = powf(10000.0f, -(float)f / (float)nf), ang = (float)pos * inv;
        tab[(pos * 2 + 0) * nf + f] = cosf(ang); tab[(pos * 2 + 1) * nf + f] = sinf(ang);
    }
}
__device__ __forceinline__ void p0_rows(const Ctx& c) {
    const int gw = c.bid * 8 + c.wave, NGW = c.G * 8;
    for (int row = gw; row < NT; row += NGW) {
        const float* src = row < NLAT ? c.in[I_X] + (size_t)row * D : c.in[I_CTX] + (size_t)(row - NLAT) * D;
        float* xr = xrow_ptr(c, row); bf16_t* hr = wsp<bf16_t>(c, WS_H) + (size_t)row * D;
        const int r = row_mod(row); const float* sh = modp(c, 0, r, 0); const float* sc = modp(c, 0, r, 1);
#pragma unroll
        for (int j = 0; j < 4; ++j) { const int col = 256 * j + 4 * c.lane;
            const f32x4 v = *(const f32x4*)(src + col), s1 = *(const f32x4*)(sc + col), s0 = *(const f32x4*)(sh + col);
            *(f32x4*)(xr + col) = v;
            const f32x4 h = v * (s1 + 1.0f) + s0; u32x2 o; o.x = cvt_pk_bf16(h.x, h.y); o.y = cvt_pk_bf16(h.z, h.w); *(u32x2*)(hr + col) = o; }
    }
}
__device__ __forceinline__ void phase_normalize(const Ctx& c, int nrows, const float* g, const float* b, int ln, int ksh, int ksc, const float* slab = nullptr, int lg = 0, int kg = 0, float coef = 0.f, bool dry = false) {
    const int gw = c.bid * 8 + c.wave, NGW = c.G * 8;
    for (int row = gw; row < nrows; row += NGW) {
        float* xr = xrow_ptr(c, row);
        f32x4 v[4]; float s = 0.f;
#pragma unroll
        for (int j = 0; j < 4; ++j) { v[j] = *(const f32x4*)(xr + 256 * j + 4 * c.lane); }
        if (slab && row >= NLAT) { const float* gp = modp(c, lg, 8, kg);
#pragma unroll
            for (int j = 0; j < 4; ++j) { const int col = 256 * j + 4 * c.lane; const float* sp = slab + (size_t)(row - NLAT) * D + col;
                const f32x4 a = (*(const f32x4*)sp + *(const f32x4*)(sp + (size_t)NCTX * D)) + (*(const f32x4*)(sp + 2 * (size_t)NCTX * D) + *(const f32x4*)(sp + 3 * (size_t)NCTX * D));
                v[j] = v[j] * DN_ALPHA + *(const f32x4*)(gp + col) * coef * a; } }
#pragma unroll
        for (int j = 0; j < 4; ++j) s += (v[j].x + v[j].y) + (v[j].z + v[j].w);
        const float mean = wave_sum(s) * (1.f / D); float s2 = 0.f;
#pragma unroll
        for (int j = 0; j < 4; ++j) { v[j] = v[j] - mean; s2 += (v[j].x * v[j].x + v[j].y * v[j].y) + (v[j].z * v[j].z + v[j].w * v[j].w); }
        const float rstd = 1.f / sqrtf(wave_sum(s2) * (1.f / D) + LN_EPS);
        const int r = row_mod(row);
#pragma unroll
        for (int j = 0; j < 4; ++j) { const int col = 256 * j + 4 * c.lane;
            const f32x4 y = v[j] * rstd * *(const f32x4*)(g + col) + *(const f32x4*)(b + col);
            if (!dry) *(f32x4*)(xr + col) = y;
            if (ln >= 0 && !dry) { const f32x4 h = y * (*(const f32x4*)(modp(c, ln, r, ksc) + col) + 1.0f) + *(const f32x4*)(modp(c, ln, r, ksh) + col);
                u32x2 o; o.x = cvt_pk_bf16(h.x, h.y); o.y = cvt_pk_bf16(h.z, h.w); *(u32x2*)(wsp<bf16_t>(c, WS_H) + (size_t)row * D + col) = o; } }
    }
}
typedef f32x4 Acc[2][2][4][2];
struct SchedTiles {
    pg8::TileOrder ord; const char* A; const char* B; int ld, nt;
    __device__ __forceinline__ bool next(int i, pg8::Unit& u) const {
        int pm, pn; if (!ord.tile(i, pm, pn)) return false;
        u.A = A + (size_t)pm * 256 * ld * 2; u.B = B + (size_t)pn * 256 * ld * 2; u.nt = nt; u.kind = 0; u.pm = pm; u.pn = pn; u.k = 0; return true;
    }
};
struct SchedInpLast {
    pg8::TileOrder ord; const char* A; const char* B; int ld, nt;
    __device__ __forceinline__ bool next(int i, pg8::Unit& u) const {
        int pm, pn;
        if (!ord.tile(i, pm, pn)) { const long q = (long)i * ord.G + ord.c - ord.nwg; if (q < 0 || q >= 72) return false;
            const int j = (int)q % 9; pm = 64 + (int)q / 9; pn = j < 2 ? j : j == 2 ? 6 : j == 3 ? 8 : j == 4 ? 9 : 7 + j; }
        u.A = A + (size_t)pm * 256 * ld * 2; u.B = B + (size_t)pn * 256 * ld * 2; u.nt = nt; u.kind = 0; u.pm = pm; u.pn = pn; u.k = 0; return true;
    }
};
struct EpiSwiglu {
    bf16_t* U;
    __device__ __forceinline__ void operator()(const Acc& acc, const pg8::Unit& u, int wr, int wc, int fr, int fq) const {
#pragma unroll
        for (int ai = 0; ai < 2; ++ai)
#pragma unroll
            for (int m = 0; m < 4; ++m) {
                const int row = u.pm * 256 + ai * 128 + wr * 64 + m * 16 + fr;
                float o[8];
#pragma unroll
                for (int bj = 0; bj < 2; ++bj)
#pragma unroll
                    for (int j = 0; j < 4; ++j) o[4 * bj + j] = siluf_(acc[ai][bj][m][0][j]) * acc[ai][bj][m][1][j];
                u32x4 w; w.x = cvt_pk_bf16(o[0], o[1]); w.y = cvt_pk_bf16(o[2], o[3]); w.z = cvt_pk_bf16(o[4], o[5]); w.w = cvt_pk_bf16(o[6], o[7]);
                *(u32x4*)(U + (size_t)row * FF + 128 * u.pn + 32 * wc + 8 * fq) = w;
            }
    }
};
struct SchedResid {
    pg8::TileOrder ord; const char* A; const char* B; int ld, nt; bool ctx; const char* Actx; size_t partA; int kpart;
    __device__ __forceinline__ bool next(int i, pg8::Unit& u) const {
        int pm, pn;
        if (ord.tile(i, pm, pn)) { u.A = A + (size_t)pm * 256 * ld * 2; u.B = B + (size_t)pn * 256 * ld * 2; u.nt = nt; u.kind = 0; u.pm = pm; u.pn = pn; u.k = 0; return true; }
        if (!ctx) return false;
        const int R = (ord.nwg + ord.G - 1) / ord.G; const long q = (long)(i - R) * ord.G + ord.c;
        if (i < R || q >= 128) return false;
        const int unit = (int)q >> 2, part = (int)q & 3; pm = 64 + (unit >> 2); pn = unit & 3;
        u.pm = pm; u.pn = pn; u.kind = 1; u.k = part;
        if (kpart) { const int base = ((nt / 4) & ~1), rem = (nt - 4 * base) / 2, kt0 = part * base + 2 * (part < rem ? part : rem); u.nt = base + (part < rem ? 2 : 0);
            u.A = A + (size_t)pm * 256 * ld * 2 + (size_t)kt0 * 128; u.B = B + (size_t)pn * 256 * ld * 2 + (size_t)kt0 * 128; }
        else { u.nt = nt; u.A = Actx + (size_t)part * partA + (size_t)(pm - 64) * 256 * ld * 2; u.B = B + (size_t)pn * 256 * ld * 2; }
        return true;
    }
};
struct EpiResid {
    Ctx c; int l, kg; float coef; float* slab;
    __device__ __forceinline__ void operator()(const Acc& acc, const pg8::Unit& u, int wr, int wc, int fr, int fq) const {
        const int col0 = u.pn * 256 + wc * 32 + 4 * fq;
        if (u.kind == 1) {
#pragma unroll
            for (int ai = 0; ai < 2; ++ai)
#pragma unroll
                for (int m = 0; m < 4; ++m) { float* sr = slab + ((size_t)u.k * NCTX + (size_t)(u.pm - 64) * 256 + ai * 128 + wr * 64 + m * 16 + fr) * D + col0;
#pragma unroll
                    for (int bj = 0; bj < 2; ++bj)
#pragma unroll
                        for (int n = 0; n < 2; ++n) *(f32x4*)(sr + bj * 128 + n * 16) = acc[ai][bj][m][n]; }
            return;
        }
        const float* gate = modp(c, l, row_mod(u.pm * 256), kg);
        f32x4 gv[2][2];
#pragma unroll
        for (int bj = 0; bj < 2; ++bj)
#pragma unroll
            for (int n = 0; n < 2; ++n) gv[bj][n] = *(const f32x4*)(gate + col0 + bj * 128 + n * 16) * coef;
#pragma unroll
        for (int ai = 0; ai < 2; ++ai)
#pragma unroll
            for (int m = 0; m < 4; ++m) {
                float* xr = xrow_ptr(c, u.pm * 256 + ai * 128 + wr * 64 + m * 16 + fr) + col0;
#pragma unroll
                for (int bj = 0; bj < 2; ++bj)
#pragma unroll
                    for (int n = 0; n < 2; ++n) { float* p = xr + bj * 128 + n * 16; const f32x4 x = *(const f32x4*)p; *(f32x4*)p = x * DN_ALPHA + gv[bj][n] * acc[ai][bj][m][n]; }
                if (m & 1) asm volatile("" ::: "memory");
            }
    }
};
struct RowInfo { int row, b, s, prow, pcol; bool lat; };
__device__ __forceinline__ RowInfo row_info(int row) {
    RowInfo r; r.row = row; r.lat = row < NLAT;
    if (r.lat) { const int t = row & 2047; r.b = row >> 11; r.s = CTX + t; r.prow = t >> 6; r.pcol = t & 63; }
    else { const int q = row - NLAT; r.b = q >> 8; r.s = q & 255; r.prow = 0; r.pcol = 0; }
    return r;
}
struct EpiInp {
    Ctx c;
    __device__ __forceinline__ void dst_of(int src, bf16_t*& dst, int& ld) const {
        if (src < IO_AY) { dst = wsp<bf16_t>(c, P_AX); ld = 512; }
        else if (src < IO_BQ) { dst = wsp<bf16_t>(c, P_AB); ld = 1024; }
        else if (src < IO_BK) { dst = wsp<bf16_t>(c, P_AB) + 512; ld = 1024; }
        else if (src < IO_BV) { dst = wsp<bf16_t>(c, P_BK); ld = 128; }
        else if (src < IO_CKV) { dst = wsp<bf16_t>(c, P_CD) + 512; ld = 1024; }
        else if (src < IO_CKR) { dst = wsp<bf16_t>(c, P_CKV); ld = 256; }
        else if (src < IO_DQ) { dst = wsp<bf16_t>(c, P_CKR); ld = 32; }
        else if (src < IO_DK) { dst = wsp<bf16_t>(c, P_DQ); ld = 512; }
        else if (src < IO_DV) { dst = wsp<bf16_t>(c, P_DK); ld = 512; }
        else { dst = wsp<bf16_t>(c, P_CD); ld = 1024; }
    }
    __device__ __forceinline__ void operator()(const Acc& acc, const pg8::Unit& u, int wr, int wc, int fr, int fq) const {
#pragma unroll
        for (int bj = 0; bj < 2; ++bj) {
            const HalfTile ht = inp_half(u.pn, bj);
            bf16_t* dst; int ld; dst_of(ht.src, dst, ld);
            const int dcol = ht.dstoff + 32 * wc + 8 * fq;
            if (ht.kind == EK_PLAIN || ht.kind == EK_GELU || ht.kind == EK_SILU) {
#pragma unroll
                for (int ai = 0; ai < 2; ++ai)
#pragma unroll
                    for (int m = 0; m < 4; ++m) {
                        const int row = u.pm * 256 + ai * 128 + wr * 64 + m * 16 + fr;
                        float o[8];
#pragma unroll
                        for (int j = 0; j < 4; ++j) { o[j] = acc[ai][bj][m][0][j]; o[4 + j] = acc[ai][bj][m][1][j]; }
                        if (ht.kind == EK_GELU) {
#pragma unroll
                            for (int j = 0; j < 8; ++j) o[j] = geluf_(o[j]); }
                        if (ht.kind == EK_SILU) {
#pragma unroll
                            for (int j = 0; j < 8; ++j) o[j] = siluf_(o[j]); }
                        u32x4 w; w.x = cvt_pk_bf16(o[0], o[1]); w.y = cvt_pk_bf16(o[2], o[3]); w.z = cvt_pk_bf16(o[4], o[5]); w.w = cvt_pk_bf16(o[6], o[7]);
                        *(u32x4*)(dst + (size_t)row * ld + dcol) = w;
                        if (ht.src >= IO_CQ && ht.src < IO_CKR) {
                            float ss = (bf_lo(w.x) * bf_lo(w.x) + bf_hi(w.x) * bf_hi(w.x)) + (bf_lo(w.y) * bf_lo(w.y) + bf_hi(w.y) * bf_hi(w.y)) + (bf_lo(w.z) * bf_lo(w.z) + bf_hi(w.z) * bf_hi(w.z)) + (bf_lo(w.w) * bf_lo(w.w) + bf_hi(w.w) * bf_hi(w.w));
                            ss += __shfl_xor(ss, 16); ss += __shfl_xor(ss, 32);
                            if (fq == 0) { if (ht.src < IO_CKV) wsp<float>(c, ST_CQ)[(size_t)row * 12 + ((ht.dstoff + 32 * wc) >> 5)] = ss; else wsp<float>(c, ST_CKV)[(size_t)row * 8 + ((ht.dstoff + 32 * wc) >> 5)] = ss; }
                        }
                    }
            } else if (ht.kind == EK_ROPE16 || ht.kind == EK_ROPE32 || ht.kind == EK_ROPE32K) {
                const bool r16 = ht.kind == EK_ROPE16;
                const int seg = r16 ? (wc & 1) : (wc >> 1), nf = r16 ? 16 : 32, f0 = r16 ? 4 * fq : 16 * (wc & 1) + 4 * fq;
                const float* tab = wsp<float>(c, r16 ? WS_CS16 : WS_CS32);
                const int head = (ht.dstoff >> 7);
#pragma unroll
                for (int ai = 0; ai < 2; ++ai)
#pragma unroll
                    for (int m = 0; m < 4; ++m) {
                        const RowInfo ri = row_info(u.pm * 256 + ai * 128 + wr * 64 + m * 16 + fr);
                        f32x4 x1 = acc[ai][bj][m][0], x2 = acc[ai][bj][m][1], o1 = x1, o2 = x2;
                        if (ri.lat) { const int pos = seg ? ri.pcol : ri.prow;
                            const f32x4 cs = *(const f32x4*)(tab + (pos * 2 + 0) * nf + f0), sn = *(const f32x4*)(tab + (pos * 2 + 1) * nf + f0);
                            o1 = x1 * cs - x2 * sn; o2 = x2 * cs + x1 * sn; }
                        u32x4 w; w.x = cvt_pk_bf16(o1.x, o1.y); w.y = cvt_pk_bf16(o1.z, o1.w); w.z = cvt_pk_bf16(o2.x, o2.y); w.w = cvt_pk_bf16(o2.z, o2.w);
                        *(u32x4*)(dst + (size_t)ri.row * ld + dcol) = w;
                        if (ht.kind == EK_ROPE32K) {
                            bf16_t* kt = wsp<bf16_t>(c, KT_RET) + ((size_t)(ri.b * 4 + head) * 128 + 32 * wc + 8 * fq) * SALL + (ri.s & ~31) + posperm(ri.s & 31);
                            kt[0 * SALL] = (bf16_t)(w.x & 0xffff); kt[1 * SALL] = (bf16_t)(w.x >> 16); kt[2 * SALL] = (bf16_t)(w.y & 0xffff); kt[3 * SALL] = (bf16_t)(w.y >> 16);
                            kt[4 * SALL] = (bf16_t)(w.z & 0xffff); kt[5 * SALL] = (bf16_t)(w.z >> 16); kt[6 * SALL] = (bf16_t)(w.w & 0xffff); kt[7 * SALL] = (bf16_t)(w.w >> 16);
                        }
                    }
            } else if (ht.kind == EK_VT) {
                const bool gq = ht.src == IO_BV;
#pragma unroll
                for (int ai = 0; ai < 2; ++ai)
#pragma unroll
                    for (int m = 0; m < 4; ++m) {
                        const RowInfo ri = row_info(u.pm * 256 + ai * 128 + wr * 64 + m * 16 + fr);
                        const int sp = (ri.s & ~31) + posperm(ri.s & 31);
#pragma unroll
                        for (int n = 0; n < 2; ++n) {
                            const int c7 = 32 * wc + 16 * n + 4 * fq;
                            bf16_t* vt = gq ? wsp<bf16_t>(c, VT_GQA) + ((size_t)(ri.b * 2 + (c7 >> 6)) * 64 + (c7 & 63)) * SALL + sp
                                            : wsp<bf16_t>(c, VT_RET) + ((size_t)(ri.b * 4 + (ht.dstoff >> 7)) * 128 + c7) * SALL + sp;
                            const unsigned w0 = cvt_pk_bf16(acc[ai][bj][m][n][0], acc[ai][bj][m][n][1]), w1 = cvt_pk_bf16(acc[ai][bj][m][n][2], acc[ai][bj][m][n][3]);
                            vt[0 * SALL] = (bf16_t)(w0 & 0xffff); vt[1 * SALL] = (bf16_t)(w0 >> 16); vt[2 * SALL] = (bf16_t)(w1 & 0xffff); vt[3 * SALL] = (bf16_t)(w1 >> 16);
                        }
                    }
            } else {
                if (wc == 0) {
#pragma unroll
                    for (int ai = 0; ai < 2; ++ai)
#pragma unroll
                        for (int m = 0; m < 4; ++m) {
                            const int row = u.pm * 256 + ai * 128 + wr * 64 + m * 16 + fr;
#pragma unroll
                            for (int n = 0; n < 2; ++n) { u32x2 w; w.x = cvt_pk_bf16(acc[ai][bj][m][n][0], acc[ai][bj][m][n][1]); w.y = cvt_pk_bf16(acc[ai][bj][m][n][2], acc[ai][bj][m][n][3]);
                                *(u32x2*)(dst + (size_t)row * 32 + 16 * n + 4 * fq) = w; }
                        }
                }
            }
        }
    }
};
struct SchedMerge {
    pg8::TileOrder ord; const char* H; const char* Wg; const char* Wb; const char* AB; const char* CD; int ld; bool ctx;
    __device__ __forceinline__ bool next(int i, pg8::Unit& u) const {
        int pm, pn, k, isP;
        if (ord.tile(i >> 3, pm, pn)) { k = (i >> 1) & 3; isP = i & 1; u.kind = isP; }
        else { if (!ctx) return false;
            const int R = (ord.nwg + ord.G - 1) / ord.G; const int j = i - 8 * R; if (j < 0) return false;
            const long q = (long)(j >> 1) * ord.G + ord.c; if (q >= 128) return false;
            const int unit = (int)q >> 2; k = (int)q & 3; pm = 64 + (unit >> 2); pn = unit & 3; isP = j & 1; u.kind = isP ? 2 : 0; }
        u.pm = pm; u.pn = pn; u.k = k;
        if (!isP) { u.A = H + (size_t)pm * 256 * 1024 * 2; u.B = Wg + (size_t)(k * 1024 + pn * 256) * 1024 * 2; u.nt = 16; }
        else { const char* bp = k == 0 ? AB : k == 1 ? AB + 1024 : k == 2 ? CD + 1024 : CD;
            u.A = bp + (size_t)pm * 256 * 1024 * 2; u.B = Wb + ((size_t)((k >> 1) * 1024 + pn * 256) * 1024 + 512 * (k & 1)) * 2; u.nt = 8; }
        return true;
    }
};
struct EpiMerge {
    GAS unsigned char* sig; GAS unsigned char* msum; GAS bf16_t* MG; GAS bf16_t* MGP;
    __device__ __forceinline__ void operator()(const Acc& acc, const pg8::Unit& u, int wr, int wc, int fr, int fq) const {
        const unsigned toff = (unsigned)((wr * 4 + wc) * 64 + fq * 16 + fr) * 16u;
        if (u.kind == 0) {
#pragma unroll
            for (int ai = 0; ai < 2; ++ai)
#pragma unroll
                for (int bj = 0; bj < 2; ++bj)
#pragma unroll
                    for (int m = 0; m < 4; ++m) {
                        const int q = (ai * 2 + bj) * 4 + m; const f32x4 a = acc[ai][bj][m][0], b = acc[ai][bj][m][1];
                        unsigned t2 = toff; asm volatile("" : "+v"(t2));
                        u32x4 w; w.x = cvt_pk_bf16(sigmoidf_(a.x), sigmoidf_(a.y)); w.y = cvt_pk_bf16(sigmoidf_(a.z), sigmoidf_(a.w)); w.z = cvt_pk_bf16(sigmoidf_(b.x), sigmoidf_(b.y)); w.w = cvt_pk_bf16(sigmoidf_(b.z), sigmoidf_(b.w));
                        *(GAS u32x4*)(sig + q * 8192 + t2) = w;
                    }
        } else {
#pragma unroll
            for (int ai = 0; ai < 2; ++ai)
#pragma unroll
                for (int bj = 0; bj < 2; ++bj)
#pragma unroll
                    for (int m = 0; m < 4; ++m) {
                        const int q = (ai * 2 + bj) * 4 + m;
                        unsigned t2 = toff; asm volatile("" : "+v"(t2));
                        const u32x4 w = *(const GAS u32x4*)(sig + q * 8192 + t2);
                        f32x4 a = acc[ai][bj][m][0], b = acc[ai][bj][m][1];
                        if (!((DBG >> (8 + u.k)) & 1)) { a = (f32x4){0.f, 0.f, 0.f, 0.f}; b = a; }
                        a.x *= bf_lo(w.x); a.y *= bf_hi(w.x); a.z *= bf_lo(w.y); a.w *= bf_hi(w.y); b.x *= bf_lo(w.z); b.y *= bf_hi(w.z); b.z *= bf_lo(w.w); b.w *= bf_hi(w.w);
                        if (u.kind == 2) {
                            u32x4 o; o.x = cvt_pk_bf16(a.x, a.y); o.y = cvt_pk_bf16(a.z, a.w); o.z = cvt_pk_bf16(b.x, b.y); o.w = cvt_pk_bf16(b.z, b.w);
                            *(GAS u32x4*)(MGP + ((size_t)u.k * NCTX + (size_t)(u.pm - 64) * 256 + ai * 128 + wr * 64 + m * 16 + fr) * D + u.pn * 256 + bj * 128 + wc * 32 + 8 * fq) = o;
                            asm volatile("" ::: "memory"); continue; }
                        GAS f32x4* pm0 = (GAS f32x4*)(msum + (q * 2 + 0) * 8192 + t2); GAS f32x4* pm1 = (GAS f32x4*)(msum + (q * 2 + 1) * 8192 + t2);
                        if (u.k > 0) { a += *pm0; b += *pm1; }
                        if (u.k < 3) { *pm0 = a; *pm1 = b; }
                        else { const int row = u.pm * 256 + ai * 128 + wr * 64 + m * 16 + fr;
                            u32x4 o; o.x = cvt_pk_bf16(a.x, a.y); o.y = cvt_pk_bf16(a.z, a.w); o.z = cvt_pk_bf16(b.x, b.y); o.w = cvt_pk_bf16(b.z, b.w);
                            *(GAS u32x4*)(MG + (size_t)row * D + u.pn * 256 + bj * 128 + wc * 32 + 8 * fq) = o; }
                        asm volatile("" ::: "memory");
                    }
        }
    }
};

struct EpiMlaQ {
    Ctx c;
    __device__ __forceinline__ void operator()(const Acc& acc, const pg8::Unit& u, int wr, int wc, int fr, int fq) const {
        const float* tab = wsp<float>(c, WS_CS8);
#pragma unroll
        for (int ai = 0; ai < 2; ++ai)
#pragma unroll
            for (int m = 0; m < 4; ++m) {
                const RowInfo ri = row_info(u.pm * 256 + ai * 128 + wr * 64 + m * 16 + fr);
                const float* st = wsp<float>(c, ST_CQ) + (size_t)ri.row * 12;
                const f32x4 s0 = *(const f32x4*)st, s1 = *(const f32x4*)(st + 4), s2 = *(const f32x4*)(st + 8);
                const float rstd = 1.0f / sqrtf((((s0.x + s0.y) + (s0.z + s0.w)) + ((s1.x + s1.y) + (s1.z + s1.w)) + ((s2.x + s2.y) + (s2.z + s2.w))) * (1.0f / 384.0f) + LN_EPS);
                bf16_t* Q = wsp<bf16_t>(c, WS_QF) + (size_t)ri.row * 768;
#pragma unroll
                for (int bj = 0; bj < 2; ++bj) {
                    const int g = u.pn * 8 + bj * 4 + wc, h = g / 3, gi = g % 3;
                    const f32x4 a = acc[ai][bj][m][0] * rstd, b = acc[ai][bj][m][1] * rstd;
                    if (gi < 2) { u32x4 w; w.x = cvt_pk_bf16(a.x, a.y); w.y = cvt_pk_bf16(a.z, a.w); w.z = cvt_pk_bf16(b.x, b.y); w.w = cvt_pk_bf16(b.z, b.w);
                        *(u32x4*)(Q + 96 * h + 32 * gi + 8 * fq) = w; }
                    else { f32x4 o1 = a, o2 = b;
                        if (ri.lat) { const int pos = (fq >> 1) ? ri.pcol : ri.prow, e0 = 4 * (fq & 1);
                            const f32x4 cs = *(const f32x4*)(tab + (pos * 2 + 0) * 8 + e0), sn = *(const f32x4*)(tab + (pos * 2 + 1) * 8 + e0);
                            o1 = a * cs - b * sn; o2 = b * cs + a * sn; }
                        u32x2 w1, w2; w1.x = cvt_pk_bf16(o1.x, o1.y); w1.y = cvt_pk_bf16(o1.z, o1.w); w2.x = cvt_pk_bf16(o2.x, o2.y); w2.y = cvt_pk_bf16(o2.z, o2.w);
                        *(u32x2*)(Q + 96 * h + 64 + 4 * fq) = w1; *(u32x2*)(Q + 96 * h + 80 + 4 * fq) = w2; }
                }
            }
    }
};
struct EpiMlaKV {
    Ctx c;
    __device__ __forceinline__ void operator()(const Acc& acc, const pg8::Unit& u, int wr, int wc, int fr, int fq) const {
#pragma unroll
        for (int ai = 0; ai < 2; ++ai)
#pragma unroll
            for (int m = 0; m < 4; ++m) {
                const RowInfo ri = row_info(u.pm * 256 + ai * 128 + wr * 64 + m * 16 + fr);
                const float* st = wsp<float>(c, ST_CKV) + (size_t)ri.row * 8;
                const f32x4 s0 = *(const f32x4*)st, s1 = *(const f32x4*)(st + 4);
                const float rstd = 1.0f / sqrtf((((s0.x + s0.y) + (s0.z + s0.w)) + ((s1.x + s1.y) + (s1.z + s1.w))) * (1.0f / 256.0f) + LN_EPS);
                const int sp = (ri.s & ~31) + posperm(ri.s & 31);
#pragma unroll
                for (int bj = 0; bj < 2; ++bj) {
                    const int g = u.pn * 8 + bj * 4 + wc, h = g >> 2, gi = g & 3;
                    const f32x4 a = acc[ai][bj][m][0] * rstd, b = acc[ai][bj][m][1] * rstd;
                    if (gi < 2) { u32x4 w; w.x = cvt_pk_bf16(a.x, a.y); w.y = cvt_pk_bf16(a.z, a.w); w.z = cvt_pk_bf16(b.x, b.y); w.w = cvt_pk_bf16(b.z, b.w);
                        *(u32x4*)(wsp<bf16_t>(c, WS_KF) + ((size_t)(ri.b * 8 + h) * SALL + ri.s) * 96 + 32 * gi + 8 * fq) = w; }
                    else { bf16_t* vt = wsp<bf16_t>(c, WS_VTM) + ((size_t)(ri.b * 8 + h) * 64 + 32 * (gi - 2) + 4 * fq) * SALL + sp;
                        const unsigned w0 = cvt_pk_bf16(a.x, a.y), w1 = cvt_pk_bf16(a.z, a.w), w2 = cvt_pk_bf16(b.x, b.y), w3 = cvt_pk_bf16(b.z, b.w);
                        vt[0 * SALL] = (bf16_t)(w0 & 0xffff); vt[1 * SALL] = (bf16_t)(w0 >> 16); vt[2 * SALL] = (bf16_t)(w1 & 0xffff); vt[3 * SALL] = (bf16_t)(w1 >> 16);
                        vt[16 * SALL] = (bf16_t)(w2 & 0xffff); vt[17 * SALL] = (bf16_t)(w2 >> 16); vt[18 * SALL] = (bf16_t)(w3 & 0xffff); vt[19 * SALL] = (bf16_t)(w3 >> 16); }
                }
            }
    }
};
__device__ __forceinline__ f32x4 mfma16(bf16x8 a, bf16x8 b, f32x4 c) { return __builtin_amdgcn_mfma_f32_16x16x32_bf16(a, b, c, 0, 0, 0); }
__device__ __forceinline__ bf16x8 ldfrag(const bf16_t* p) { return *(const bf16x8*)p; }
__device__ __forceinline__ bf16x8 ldfrag_dev(const bf16_t* p) {
    const unsigned long long a = __hip_atomic_load((const unsigned long long*)p, __ATOMIC_RELAXED, __HIP_MEMORY_SCOPE_AGENT), b = __hip_atomic_load((const unsigned long long*)p + 1, __ATOMIC_RELAXED, __HIP_MEMORY_SCOPE_AGENT);
    u32x4 w; w.x = (unsigned)a; w.y = (unsigned)(a >> 32); w.z = (unsigned)b; w.w = (unsigned)(b >> 32); return __builtin_bit_cast(bf16x8, w);
}
__device__ __forceinline__ bf16x8 pack8(const f32x4 a, const f32x4 b) {
    u32x4 w; w.x = cvt_pk_bf16(a.x, a.y); w.y = cvt_pk_bf16(a.z, a.w); w.z = cvt_pk_bf16(b.x, b.y); w.w = cvt_pk_bf16(b.z, b.w); return __builtin_bit_cast(bf16x8, w);
}
__device__ __forceinline__ float sumsq8(bf16x8 v) { const u32x4 w = __builtin_bit_cast(u32x4, v); float s = 0.f;
    s += bf_lo(w.x) * bf_lo(w.x) + bf_hi(w.x) * bf_hi(w.x); s += bf_lo(w.y) * bf_lo(w.y) + bf_hi(w.y) * bf_hi(w.y);
    s += bf_lo(w.z) * bf_lo(w.z) + bf_hi(w.z) * bf_hi(w.z); s += bf_lo(w.w) * bf_lo(w.w) + bf_hi(w.w) * bf_hi(w.w); return s; }
__device__ __forceinline__ void st4bf(bf16_t* p, const f32x4 v) { u32x2 w; w.x = cvt_pk_bf16(v.x, v.y); w.y = cvt_pk_bf16(v.z, v.w); *(u32x2*)p = w; }

__device__ __forceinline__ void mla_kr_item(const Ctx& c, int it) {
    const int fr = c.lane & 15, fq = c.lane >> 4, row0 = 16 * it;
    const RowInfo ri = row_info(row0 + fr);
    const int seg = fq & 1, half = fq >> 1, pos = seg ? ri.pcol : ri.prow;
    const bf16_t* kr = wsp<bf16_t>(c, P_CKR) + (size_t)(row0 + fr) * 32 + 16 * seg;
    const u32x4 w1 = *(const u32x4*)kr, w2 = *(const u32x4*)(kr + 8);
    const float x1[8] = {bf_lo(w1.x), bf_hi(w1.x), bf_lo(w1.y), bf_hi(w1.y), bf_lo(w1.z), bf_hi(w1.z), bf_lo(w1.w), bf_hi(w1.w)};
    const float x2[8] = {bf_lo(w2.x), bf_hi(w2.x), bf_lo(w2.y), bf_hi(w2.y), bf_lo(w2.z), bf_hi(w2.z), bf_lo(w2.w), bf_hi(w2.w)};
    float o[8];
    const float* cp = wsp<float>(c, WS_CS8) + (pos * 2 + 0) * 8; const float* sp = cp + 8;
#pragma unroll
    for (int e = 0; e < 8; ++e) { const float cc = ri.lat ? cp[e] : 1.0f, sv = ri.lat ? sp[e] : 0.0f; o[e] = half == 0 ? x1[e] * cc - x2[e] * sv : x2[e] * cc + x1[e] * sv; }
    u32x4 krw; krw.x = cvt_pk_bf16(o[0], o[1]); krw.y = cvt_pk_bf16(o[2], o[3]); krw.z = cvt_pk_bf16(o[4], o[5]); krw.w = cvt_pk_bf16(o[6], o[7]);
#pragma unroll
    for (int h = 0; h < 8; ++h) *(u32x4*)(wsp<bf16_t>(c, WS_KF) + ((size_t)(ri.b * 8 + h) * SALL + ri.s) * 96 + 64 + 8 * fq) = krw;
}

template <int DQK, int NQT> struct AttnSt { f32x4 o[4][NQT]; float m[NQT], l[NQT]; bf16x8 q[NQT][DQK / 32]; };
template <int DQK, int NQT>
__device__ __forceinline__ void attn_init(AttnSt<DQK, NQT>& st, const bf16_t* Q, int ldq, float m0, float l0, int fr, int fq) {
#pragma unroll
    for (int qt = 0; qt < NQT; ++qt) { st.m[qt] = m0; st.l[qt] = l0;
#pragma unroll
        for (int ks = 0; ks < DQK / 32; ++ks) st.q[qt][ks] = ldfrag(Q + (size_t)(16 * qt + fr) * ldq + 32 * ks + 8 * fq);
#pragma unroll
        for (int d = 0; d < 4; ++d) st.o[d][qt] = (f32x4){0.f, 0.f, 0.f, 0.f}; }
}
template <int DQK, int NQT, bool MASK>
__device__ __forceinline__ void attn_steps(AttnSt<DQK, NQT>& st, const bf16_t* Kp, int ldk, const bf16_t* VTp, int nsteps, int qpos0, int kpos0, int fr, int fq) {
    for (int stp = 0; stp < nsteps; ++stp) {
        f32x4 s[2][NQT];
#pragma unroll
        for (int kt = 0; kt < 2; ++kt) {
            bf16x8 kf[DQK / 32];
#pragma unroll
            for (int ks = 0; ks < DQK / 32; ++ks) kf[ks] = ldfrag(Kp + (size_t)(32 * stp + 16 * kt + fr) * ldk + 32 * ks + 8 * fq);
#pragma unroll
            for (int qt = 0; qt < NQT; ++qt) { s[kt][qt] = (f32x4){0.f, 0.f, 0.f, 0.f};
#pragma unroll
                for (int ks = 0; ks < DQK / 32; ++ks) s[kt][qt] = mfma16(kf[ks], st.q[qt][ks], s[kt][qt]); }
        }
        bf16x8 vf[4];
#pragma unroll
        for (int d = 0; d < 4; ++d) vf[d] = ldfrag(VTp + (size_t)(16 * d + fr) * SALL + 32 * stp + 8 * fq);
#pragma unroll
        for (int qt = 0; qt < NQT; ++qt) {
            if (MASK) { const int qp = qpos0 + 16 * qt + fr;
#pragma unroll
                for (int kt = 0; kt < 2; ++kt)
#pragma unroll
                    for (int r = 0; r < 4; ++r) { const int dd = qp - (kpos0 + 32 * stp + 16 * kt + 4 * fq + r); if (dd > 128 || dd < -128) s[kt][qt][r] = -1e30f; } }
            float mx = fmaxf(fmaxf(fmaxf(s[0][qt].x, s[0][qt].y), fmaxf(s[0][qt].z, s[0][qt].w)), fmaxf(fmaxf(s[1][qt].x, s[1][qt].y), fmaxf(s[1][qt].z, s[1][qt].w)));
            mx = fmaxf(mx, __shfl_xor(mx, 16)); mx = fmaxf(mx, __shfl_xor(mx, 32));
            const float mn = fmaxf(st.m[qt], mx), alpha = fast_exp2(st.m[qt] - mn); st.m[qt] = mn;
            float ps = 0.f;
#pragma unroll
            for (int kt = 0; kt < 2; ++kt)
#pragma unroll
                for (int r = 0; r < 4; ++r) { float p = fast_exp2(s[kt][qt][r] - mn); if (MASK) p = s[kt][qt][r] < -1e29f ? 0.f : p; s[kt][qt][r] = p; ps += p; }
            st.l[qt] = st.l[qt] * alpha + ps;
            const bf16x8 pk = pack8(s[0][qt], s[1][qt]);
#pragma unroll
            for (int d = 0; d < 4; ++d) st.o[d][qt] = mfma16(vf[d], pk, st.o[d][qt] * alpha);
        }
    }
}
template <int DQK, int NQT>
__device__ __forceinline__ void attn_store(AttnSt<DQK, NQT>& st, bf16_t* O, int ldo, int fr, int fq, bool dry = false) {
#pragma unroll
    for (int qt = 0; qt < NQT; ++qt) { float l = st.l[qt]; l += __shfl_xor(l, 16); l += __shfl_xor(l, 32); const float inv = 1.0f / l;
#pragma unroll
        for (int d = 0; d < 4; ++d) if (!dry) st4bf(O + (size_t)(16 * qt + fr) * ldo + 16 * d + 4 * fq, st.o[d][qt] * inv); }
}
__device__ __forceinline__ void gqa_item(const Ctx& c, int l, int it, bool dry = false) {
    const int fr = c.lane & 15, fq = c.lane >> 4;
    const bool lat = it < 2048; int b, hq, tg;
    if (lat) { b = it >> 8; hq = (it >> 5) & 7; tg = it & 31; } else { const int j = it - 2048; b = j >> 5; hq = (j >> 2) & 7; tg = j & 3; }
    const int kvh = hq >> 2, row0 = lat ? b * SEQ + 64 * tg : NLAT + b * CTX + 64 * tg;
    bf16_t* Q = wsp<bf16_t>(c, P_AB) + 512 + (size_t)row0 * 1024 + hq * 64;
    const bf16_t* Kall = wsp<bf16_t>(c, P_BK) + kvh * 64;
    const bf16_t* VT = wsp<bf16_t>(c, VT_GQA) + (size_t)((b * 2 + kvh) * 64) * SALL;
    AttnSt<64, 4> st;
    attn_init<64, 4>(st, Q, 1024, c.in[I_SINK][l * 8 + hq] * LOG2E, fq == 0 ? 1.0f : 0.0f, fr, fq);
    if (lat) { const int tlo = 64 * tg - 128 < 0 ? 0 : 64 * tg - 128, thi = 64 * tg + 192 > SEQ ? SEQ : 64 * tg + 192;
        attn_steps<64, 4, true>(st, Kall + (size_t)(b * SEQ + tlo) * 128, 128, VT + CTX + tlo, (thi - tlo) >> 5, 64 * tg, tlo, fr, fq); }
    attn_steps<64, 4, false>(st, Kall + (size_t)(NLAT + b * CTX) * 128, 128, VT, 8, 0, 0, fr, fq);
    attn_store<64, 4>(st, Q, 1024, fr, fq, dry);
}
__device__ __forceinline__ void mla_item(const Ctx& c, int it) {
    const int fr = c.lane & 15, fq = c.lane >> 4;
    const bool lat = it < 2048; int b, h, tg;
    if (lat) { b = it >> 8; h = (it >> 5) & 7; tg = it & 31; } else { const int j = it - 2048; b = j >> 5; h = (j >> 2) & 7; tg = j & 3; }
    const int row0 = lat ? b * SEQ + 64 * tg : NLAT + b * CTX + 64 * tg;
    AttnSt<96, 4> st;
    attn_init<96, 4>(st, wsp<bf16_t>(c, WS_QF) + (size_t)row0 * 768 + h * 96, 768, -1e30f, 0.0f, fr, fq);
    attn_steps<96, 4, false>(st, wsp<bf16_t>(c, WS_KF) + (size_t)((b * 8 + h) * SALL) * 96, 96, wsp<bf16_t>(c, WS_VTM) + (size_t)((b * 8 + h) * 64) * SALL, lat ? SALL / 32 : CTX / 32, 0, 0, fr, fq);
    attn_store<96, 4>(st, wsp<bf16_t>(c, P_CD) + 512 + (size_t)row0 * 1024 + h * 64, 1024, fr, fq);
}

template <int DQK> struct AttnLds { static constexpr int KROW = DQK * 2 + 16, VROW = 64 * 2 + 16, KBYTES = 64 * KROW, BUF = KBYTES + 64 * VROW, KCH = DQK / 8; };
template <int DQK> struct TileRegs { u32x4 k0, k1, v; };
template <int DQK>
__device__ __forceinline__ void tile_gload(TileRegs<DQK>& r, const bf16_t* Kp, int ldk, const bf16_t* VTp, int tid) {
    constexpr int KCH = AttnLds<DQK>::KCH;
    { const int key = tid / KCH, part = tid % KCH; r.k0 = *(const u32x4*)(Kp + (size_t)key * ldk + part * 8); }
    if (DQK == 96) { const int cidx = tid + 512; if (cidx < 64 * KCH) { const int key = cidx / KCH, part = cidx % KCH; r.k1 = *(const u32x4*)(Kp + (size_t)key * ldk + part * 8); } }
    { const int dv = tid >> 3, part = tid & 7; r.v = *(const u32x4*)(VTp + (size_t)dv * SALL + part * 8); }
}
template <int DQK>
__device__ __forceinline__ void tile_swrite(const TileRegs<DQK>& r, LAS unsigned char* buf, int tid) {
    constexpr int KCH = AttnLds<DQK>::KCH, KROW = AttnLds<DQK>::KROW, VROW = AttnLds<DQK>::VROW;
    { const int key = tid / KCH, part = tid % KCH; *(LAS u32x4*)(buf + key * KROW + part * 16) = r.k0; }
    if (DQK == 96) { const int cidx = tid + 512; if (cidx < 64 * KCH) { const int key = cidx / KCH, part = cidx % KCH; *(LAS u32x4*)(buf + key * KROW + part * 16) = r.k1; } }
    { const int dv = tid >> 3, part = tid & 7; *(LAS u32x4*)(buf + AttnLds<DQK>::KBYTES + dv * VROW + part * 16) = r.v; }
}
template <int DQK, int NQT, bool MASK, int VAR = 0>
__device__ __forceinline__ void attn_tile(AttnSt<DQK, NQT>& st, const LAS unsigned char* buf, int qpos0, int kpos0, int fr, int fq) {
    constexpr int KROW = AttnLds<DQK>::KROW, VROW = AttnLds<DQK>::VROW;
#pragma unroll
    for (int stp = 0; stp < 2; ++stp) {
        f32x4 s[2][NQT];
#pragma unroll
        for (int kt = 0; kt < 2; ++kt) {
            bf16x8 kf[DQK / 32];
#pragma unroll
            for (int ks = 0; ks < DQK / 32; ++ks) kf[ks] = *(const LAS bf16x8*)(buf + (32 * stp + 16 * kt + fr) * KROW + ks * 64 + fq * 16);
#pragma unroll
            for (int qt = 0; qt < NQT; ++qt) { s[kt][qt] = (f32x4){0.f, 0.f, 0.f, 0.f};
#pragma unroll
                for (int ks = 0; ks < DQK / 32; ++ks) s[kt][qt] = mfma16(kf[ks], st.q[qt][ks], s[kt][qt]); }
        }
        bf16x8 vf[4];
#pragma unroll
        for (int d = 0; d < 4; ++d) vf[d] = *(const LAS bf16x8*)(buf + AttnLds<DQK>::KBYTES + (16 * d + fr) * VROW + stp * 64 + fq * 16);
#pragma unroll
        for (int qt = 0; qt < NQT; ++qt) {
            if (MASK) { const int qp = qpos0 + 16 * qt + fr;
#pragma unroll
                for (int kt = 0; kt < 2; ++kt)
#pragma unroll
                    for (int r = 0; r < 4; ++r) { const int dd = qp - (kpos0 + 32 * stp + 16 * kt + 4 * fq + r); if (dd > 128 || dd < -128) s[kt][qt][r] = -1e30f; } }
            float mx = fmaxf(fmaxf(fmaxf(s[0][qt].x, s[0][qt].y), fmaxf(s[0][qt].z, s[0][qt].w)), fmaxf(fmaxf(s[1][qt].x, s[1][qt].y), fmaxf(s[1][qt].z, s[1][qt].w)));
            if (VAR != 1) { mx = fmaxf(mx, __shfl_xor(mx, 16)); mx = fmaxf(mx, __shfl_xor(mx, 32)); }
            const float mn = fmaxf(st.m[qt], mx), alpha = fast_exp2(st.m[qt] - mn); st.m[qt] = mn;
            float ps = 0.f;
#pragma unroll
            for (int kt = 0; kt < 2; ++kt)
#pragma unroll
                for (int r = 0; r < 4; ++r) { float p = VAR == 2 ? s[kt][qt][r] - mn : fast_exp2(s[kt][qt][r] - mn); if (MASK) p = s[kt][qt][r] < -1e29f ? 0.f : p; s[kt][qt][r] = p; ps += p; }
            st.l[qt] = st.l[qt] * alpha + ps;
            const bf16x8 pk = pack8(s[0][qt], s[1][qt]);
#pragma unroll
            for (int d = 0; d < 4; ++d) st.o[d][qt] = mfma16(vf[d], pk, VAR == 3 ? st.o[d][qt] : st.o[d][qt] * alpha);
        }
    }
}
#define ATT_STEP(DQK, t, R, COMPUTE, KP, LDK, VP) do { \
        COMPUTE; \
        if ((t) + 1 < ntile) tile_swrite<DQK>(R, c.lds + (((t) + 1) & 1) * L::BUF, c.tid); \
        __syncthreads(); \
        if ((t) + 3 < ntile) tile_gload<DQK>(R, KP((t) + 3), LDK, VP((t) + 3), c.tid); } while (0)
template <int VAR = 0> __device__ __forceinline__ void mla_block_item(const Ctx& c, int it, bool dry = false) {
    const int fr = c.lane & 15, fq = c.lane >> 4, b = it >> 6, h = (it >> 3) & 7, qg = it & 7, row0 = b * SEQ + 256 * qg + 32 * c.wave;
    typedef AttnLds<96> L;
    const bf16_t* Kp = wsp<bf16_t>(c, WS_KF) + (size_t)((b * 8 + h) * SALL) * 96; const bf16_t* VTp = wsp<bf16_t>(c, WS_VTM) + (size_t)((b * 8 + h) * 64) * SALL;
    AttnSt<96, 2> st;
    attn_init<96, 2>(st, wsp<bf16_t>(c, WS_QF) + (size_t)row0 * 768 + h * 96, 768, -1e30f, 0.0f, fr, fq);
    constexpr int ntile = SALL / 64;
#define MLA_KP(t) (Kp + (size_t)(64 * (t)) * 96)
#define MLA_VP(t) (VTp + 64 * (t))
    TileRegs<96> r0, r1;
    tile_gload<96>(r0, MLA_KP(0), 96, MLA_VP(0), c.tid); tile_swrite<96>(r0, c.lds, c.tid);
    tile_gload<96>(r0, MLA_KP(1), 96, MLA_VP(1), c.tid); tile_gload<96>(r1, MLA_KP(2), 96, MLA_VP(2), c.tid);
    __syncthreads();
    for (int t = 0; t < ntile; t += 2) {
        ATT_STEP(96, t, r0, (attn_tile<96, 2, false, VAR>(st, c.lds + (t & 1) * L::BUF, 0, 0, fr, fq)), MLA_KP, 96, MLA_VP);
        ATT_STEP(96, t + 1, r1, (attn_tile<96, 2, false, VAR>(st, c.lds + ((t + 1) & 1) * L::BUF, 0, 0, fr, fq)), MLA_KP, 96, MLA_VP);
    }
#undef MLA_KP
#undef MLA_VP
    attn_store<96, 2>(st, wsp<bf16_t>(c, P_CD) + 512 + (size_t)row0 * 1024 + h * 64, 1024, fr, fq, dry);
}
__device__ __forceinline__ void gqa_block_item(const Ctx& c, int l, int it, bool dry = false) {
    const int fr = c.lane & 15, fq = c.lane >> 4, b = it >> 6, kvh = (it >> 5) & 1, tq = it & 31, hq = kvh * 4 + (c.wave >> 1), q0 = 64 * tq + 32 * (c.wave & 1);
    typedef AttnLds<64> L;
    bf16_t* Q = wsp<bf16_t>(c, P_AB) + 512 + (size_t)(b * SEQ + q0) * 1024 + hq * 64;
    const bf16_t* Kall = wsp<bf16_t>(c, P_BK) + kvh * 64; const bf16_t* VT = wsp<bf16_t>(c, VT_GQA) + (size_t)((b * 2 + kvh) * 64) * SALL;
    AttnSt<64, 2> st;
    attn_init<64, 2>(st, Q, 1024, c.in[I_SINK][l * 8 + hq] * LOG2E, fq == 0 ? 1.0f : 0.0f, fr, fq);
    const int wlo = 64 * tq - 128 < 0 ? 0 : 64 * tq - 128, whi = 64 * tq + 192 > SEQ ? SEQ : 64 * tq + 192, ntile = 4 + ((whi - wlo) >> 6);
#define GQA_KP(t) ((t) < 4 ? Kall + (size_t)(NLAT + b * CTX + 64 * (t)) * 128 : Kall + (size_t)(b * SEQ + wlo + 64 * ((t) - 4)) * 128)
#define GQA_VP(t) ((t) < 4 ? VT + 64 * (t) : VT + CTX + wlo + 64 * ((t) - 4))
#define GQA_COMPUTE(t) do { if ((t) < 4) attn_tile<64, 2, false>(st, c.lds + ((t) & 1) * L::BUF, 0, 0, fr, fq); \
        else { const int k0 = wlo + 64 * ((t) - 4); if (k0 + 63 >= q0 - 128 && k0 <= q0 + 31 + 128) attn_tile<64, 2, true>(st, c.lds + ((t) & 1) * L::BUF, q0, k0, fr, fq); } } while (0)
    TileRegs<64> r0, r1;
    tile_gload<64>(r0, GQA_KP(0), 128, GQA_VP(0), c.tid); tile_swrite<64>(r0, c.lds, c.tid);
    tile_gload<64>(r0, GQA_KP(1), 128, GQA_VP(1), c.tid); tile_gload<64>(r1, GQA_KP(2), 128, GQA_VP(2), c.tid);
    __syncthreads();
    for (int t = 0; t < ntile; t += 2) {
        ATT_STEP(64, t, r0, GQA_COMPUTE(t), GQA_KP, 128, GQA_VP);
        if (t + 1 < ntile) ATT_STEP(64, t + 1, r1, GQA_COMPUTE(t + 1), GQA_KP, 128, GQA_VP);
    }
#undef GQA_KP
#undef GQA_VP
#undef GQA_COMPUTE
    attn_store<64, 2>(st, Q, 1024, fr, fq, dry);
}
#undef ATT_STEP

__device__ __forceinline__ int ret_row0(int b, int p) { return p < 2 ? NLAT + b * CTX + 128 * p : b * SEQ + 128 * (p - 2); }
__device__ __forceinline__ int ret_s0(int p) { return p < 2 ? 128 * p : CTX + 128 * (p - 2); }
__device__ __forceinline__ int ret_posb(int p) { return p < 2 ? 1 - p : 2 + (17 - p); }
__device__ __forceinline__ float ret_lg2(const Ctx& c, int l, int dir, int h) { const float x = c.in[I_RDECAY][(l * 2 + dir) * 4 + h]; return -log2f(1.0f + expf(-x)); }
__device__ __forceinline__ bf16_t* ret_state(const Ctx& c, int b, int h, int dir, int pos) { return wsp<bf16_t>(c, WS_RET) + ((size_t)(((b * 4 + h) * 2 + dir) * 18 + pos)) * 16384; }
__device__ __forceinline__ void ret_kv_item(const Ctx& c, int l, int it) {
    const int fr = c.lane & 15, fq = c.lane >> 4;
    const int w = it & 7, p = (it >> 3) % 18, bh = (it >> 3) / 18, b = bh >> 2, h = bh & 3, s0 = ret_s0(p);
    const float lgf = ret_lg2(c, l, 0, h), lgb = ret_lg2(c, l, 1, h);
    const bf16_t* KT = wsp<bf16_t>(c, KT_RET) + ((size_t)(b * 4 + h) * 128 + 16 * w + fr) * SALL + s0 + 8 * fq;
    const bf16_t* VT = wsp<bf16_t>(c, VT_RET) + ((size_t)(b * 4 + h) * 128 + fr) * SALL + s0 + 8 * fq;
    bf16x8 kf[4], kb[4];
#pragma unroll
    for (int u = 0; u < 4; ++u) { const u32x4 kw = *(const u32x4*)(KT + 32 * u); float v[8] = {bf_lo(kw.x), bf_hi(kw.x), bf_lo(kw.y), bf_hi(kw.y), bf_lo(kw.z), bf_hi(kw.z), bf_lo(kw.w), bf_hi(kw.w)};
        float vf[8], vb[8];
#pragma unroll
        for (int jj = 0; jj < 8; ++jj) { const int jl = 32 * u + 16 * (jj >> 2) + 4 * fq + (jj & 3);
            if (RDBG & 64) v[jj] = bf2f(wsp<bf16_t>(c, P_DK)[(size_t)(ret_row0(b, p) + jl) * 512 + h * 128 + 16 * w + fr]); vf[jj] = v[jj] * exp2f((float)(127 - jl) * lgf); vb[jj] = v[jj] * exp2f((float)jl * lgb); }
        u32x4 o; o.x = cvt_pk_bf16(vf[0], vf[1]); o.y = cvt_pk_bf16(vf[2], vf[3]); o.z = cvt_pk_bf16(vf[4], vf[5]); o.w = cvt_pk_bf16(vf[6], vf[7]); kf[u] = __builtin_bit_cast(bf16x8, o);
        o.x = cvt_pk_bf16(vb[0], vb[1]); o.y = cvt_pk_bf16(vb[2], vb[3]); o.z = cvt_pk_bf16(vb[4], vb[5]); o.w = cvt_pk_bf16(vb[6], vb[7]); kb[u] = __builtin_bit_cast(bf16x8, o);
        if (RDBG & 32) { const u32x4 cw = {0x3c233c23u, 0x3c233c23u, 0x3c233c23u, 0x3c233c23u}; kf[u] = __builtin_bit_cast(bf16x8, cw); kb[u] = kf[u]; } }
    bf16_t* Sf = ret_state(c, b, h, 0, p) + (size_t)fr * 128 + 16 * w + 4 * fq;
    bf16_t* Sb = ret_state(c, b, h, 1, ret_posb(p)) + (size_t)fr * 128 + 16 * w + 4 * fq;
#pragma unroll 2
    for (int d = 0; d < 8; ++d) {
        f32x4 af = (f32x4){0.f, 0.f, 0.f, 0.f}, ab = af;
#pragma unroll
        for (int u = 0; u < 4; ++u) { const bf16x8 vf = ldfrag(VT + (size_t)(16 * d) * SALL + 32 * u); af = mfma16(kf[u], vf, af); ab = mfma16(kb[u], vf, ab); }
        st4bf(Sf + (size_t)(16 * d) * 128, af); st4bf(Sb + (size_t)(16 * d) * 128, ab);
    }
}
__device__ __forceinline__ void ret_prefix(const Ctx& c, int l, int e) {
    const int chain = e >> 11, off = (e & 2047) * 8, dir = chain & 1, h = (chain >> 1) & 3;
    const float dec = exp2f(128.0f * ret_lg2(c, l, dir, h));
    bf16_t* S = wsp<bf16_t>(c, WS_RET) + (size_t)chain * 18 * 16384 + off;
    u32x4 kv[18];
#pragma unroll
    for (int p = 0; p < 18; ++p) kv[p] = *(const u32x4*)(S + (size_t)p * 16384);
    float R[8];
#pragma unroll
    for (int j = 0; j < 8; ++j) R[j] = 0.f;
#pragma unroll
    for (int p = 0; p < 18; ++p) {
        u32x4 o; o.x = cvt_pk_bf16(R[0], R[1]); o.y = cvt_pk_bf16(R[2], R[3]); o.z = cvt_pk_bf16(R[4], R[5]); o.w = cvt_pk_bf16(R[6], R[7]);
        *(u32x4*)(S + (size_t)p * 16384) = o;
        R[0] = R[0] * dec + bf_lo(kv[p].x); R[1] = R[1] * dec + bf_hi(kv[p].x); R[2] = R[2] * dec + bf_lo(kv[p].y); R[3] = R[3] * dec + bf_hi(kv[p].y);
        R[4] = R[4] * dec + bf_lo(kv[p].z); R[5] = R[5] * dec + bf_hi(kv[p].z); R[6] = R[6] * dec + bf_lo(kv[p].w); R[7] = R[7] * dec + bf_hi(kv[p].w);
    }
}
__device__ __forceinline__ void ret_out_item(const Ctx& c, int l, int it, bool dry = false) {
    const int fr = c.lane & 15, fq = c.lane >> 4;
    const int w = it & 7, p = (it >> 3) % 18, bh = (it >> 3) / 18, b = bh >> 2, h = bh & 3, s0 = ret_s0(p), row0 = ret_row0(b, p);
    const float lgf = ret_lg2(c, l, 0, h), lgb = ret_lg2(c, l, 1, h);
    const int il = 16 * w + fr;
    bf16x8 qf[4];
#pragma unroll
    for (int ks = 0; ks < 4; ++ks) qf[ks] = ldfrag(wsp<bf16_t>(c, P_DQ) + (size_t)(row0 + il) * 512 + h * 128 + 32 * ks + 8 * fq);
    f32x4 y[8];
    {
        f32x4 st[8];
        const bf16_t* K = wsp<bf16_t>(c, P_DK) + (size_t)(row0 + fr) * 512 + h * 128 + 8 * fq;
#pragma unroll
        for (int jt = 0; jt < 8; ++jt) { st[jt] = (f32x4){0.f, 0.f, 0.f, 0.f};
#pragma unroll
            for (int ks = 0; ks < 4; ++ks) st[jt] = mfma16(ldfrag(K + (size_t)(16 * jt) * 512 + 32 * ks), qf[ks], st[jt]);
#pragma unroll
            for (int r = 0; r < 4; ++r) { const int d = il - (16 * jt + 4 * fq + r); st[jt][r] *= d >= 0 ? exp2f((float)d * lgf) : exp2f((float)(-d) * lgb); } }
        const bf16_t* VT = wsp<bf16_t>(c, VT_RET) + ((size_t)(b * 4 + h) * 128 + fr) * SALL + s0 + 8 * fq;
        bf16x8 pk[4];
#pragma unroll
        for (int u = 0; u < 4; ++u) pk[u] = pack8(st[2 * u], st[2 * u + 1]);
#pragma unroll
        for (int d = 0; d < 8; ++d) { y[d] = (f32x4){0.f, 0.f, 0.f, 0.f};
#pragma unroll
            for (int u = 0; u < 4; ++u) y[d] = mfma16(ldfrag(VT + (size_t)(16 * d) * SALL + 32 * u), pk[u], y[d]);
            if (!(RDBG & 1)) y[d] = (f32x4){0.f, 0.f, 0.f, 0.f}; }
    }
    {
        const float xif = exp2f((float)(il + 1) * lgf), xib = exp2f((float)(128 - il) * lgb);
        const bf16_t* Rf = ret_state(c, b, h, 0, p) + (size_t)fr * 128 + 8 * fq;
        const bf16_t* Rb = ret_state(c, b, h, 1, ret_posb(p)) + (size_t)fr * 128 + 8 * fq;
#pragma unroll 2
        for (int d = 0; d < 8; ++d) { f32x4 cf = (f32x4){0.f, 0.f, 0.f, 0.f}, cb = cf;
#pragma unroll
            for (int ks = 0; ks < 4; ++ks) { bf16x8 rf_ = ldfrag(Rf + (size_t)(16 * d) * 128 + 32 * ks), rb_ = ldfrag(Rb + (size_t)(16 * d) * 128 + 32 * ks);
                if (RDBG & 16) { const u32x4 cw = {0x3c233c23u, 0x3c233c23u, 0x3c233c23u, 0x3c233c23u}; rf_ = __builtin_bit_cast(bf16x8, cw); rb_ = rf_; }
                cf = mfma16(rf_, qf[ks], cf); cb = mfma16(rb_, qf[ks], cb); }
            if (RDBG & 2) y[d] += cf * xif; if (RDBG & 4) y[d] += cb * xib; }
    }
    float s = 0.f;
#pragma unroll
    for (int d = 0; d < 8; ++d) s += (y[d].x + y[d].y) + (y[d].z + y[d].w);
    s += __shfl_xor(s, 16); s += __shfl_xor(s, 32);
    const float mu = s * (1.0f / 128.0f); float q = 0.f;
#pragma unroll
    for (int d = 0; d < 8; ++d) { y[d] = y[d] - mu; q += (y[d].x * y[d].x + y[d].y * y[d].y) + (y[d].z * y[d].z + y[d].w * y[d].w); }
    q += __shfl_xor(q, 16); q += __shfl_xor(q, 32);
    const float rstd = 1.0f / sqrtf(q * (1.0f / 128.0f) + LN_EPS);
    bf16_t* G = wsp<bf16_t>(c, P_CD) + (size_t)(row0 + il) * 1024 + h * 128 + 4 * fq;
    const float* gn = c.in[I_GNG] + l * 512 + h * 128 + 4 * fq;
#pragma unroll
    for (int d = 0; d < 8; ++d) { const u32x2 gw = *(const u32x2*)(G + 16 * d); const f32x4 gg = *(const f32x4*)(gn + 16 * d);
        f32x4 o = y[d] * rstd * gg; o.x *= bf_lo(gw.x); o.y *= bf_hi(gw.x); o.z *= bf_lo(gw.y); o.w *= bf_hi(gw.y); if (!dry) st4bf(G + 16 * d, o); }
}

__device__ __forceinline__ void tile128_load(u32x4 (&r)[4], const bf16_t* src, int ld, int tid) {
#pragma unroll
    for (int j = 0; j < 4; ++j) { const int i = tid + 512 * j; r[j] = *(const u32x4*)(src + (size_t)(i >> 4) * ld + (i & 15) * 8); }
}
__device__ __forceinline__ void tile128_store(const u32x4 (&r)[4], LAS unsigned char* t, int tid) {
#pragma unroll
    for (int j = 0; j < 4; ++j) { const int i = tid + 512 * j, row = i >> 4, cch = i & 15; *(LAS u32x4*)(t + row * 256 + ((cch ^ (row & 15)) << 4)) = r[j]; }
}
__device__ __forceinline__ bf16x8 tile128_frag(const LAS unsigned char* t, int rb, int kc, int fr, int fq) { return *(const LAS bf16x8*)(t + (rb + fr) * 256 + (((kc + fq) ^ fr) << 4)); }
__device__ __forceinline__ void ret_kv_block(const Ctx& c, int l, int it) {
    const int fr = c.lane & 15, fq = c.lane >> 4, w = c.wave;
    const int p = it % 18, bh = it / 18, b = bh >> 2, h = bh & 3, s0 = ret_s0(p);
    const float lgf = ret_lg2(c, l, 0, h), lgb = ret_lg2(c, l, 1, h);
    LAS unsigned char* tK = c.lds; LAS unsigned char* tV = c.lds + 32768;
    { u32x4 r0[4], r1[4];
      tile128_load(r0, wsp<bf16_t>(c, KT_RET) + (size_t)((b * 4 + h) * 128) * SALL + s0, SALL, c.tid);
      tile128_load(r1, wsp<bf16_t>(c, VT_RET) + (size_t)((b * 4 + h) * 128) * SALL + s0, SALL, c.tid);
      tile128_store(r0, tK, c.tid); tile128_store(r1, tV, c.tid); }
    __syncthreads();
    bf16x8 kf[4], kb[4];
#pragma unroll
    for (int u = 0; u < 4; ++u) { const u32x4 kw = __builtin_bit_cast(u32x4, tile128_frag(tK, 16 * w, 4 * u, fr, fq)); const float v[8] = {bf_lo(kw.x), bf_hi(kw.x), bf_lo(kw.y), bf_hi(kw.y), bf_lo(kw.z), bf_hi(kw.z), bf_lo(kw.w), bf_hi(kw.w)};
        float vf[8], vb[8];
#pragma unroll
        for (int jj = 0; jj < 8; ++jj) { const int jl = 32 * u + 16 * (jj >> 2) + 4 * fq + (jj & 3); vf[jj] = v[jj] * fast_exp2((float)(127 - jl) * lgf); vb[jj] = v[jj] * fast_exp2((float)jl * lgb); }
        u32x4 o; o.x = cvt_pk_bf16(vf[0], vf[1]); o.y = cvt_pk_bf16(vf[2], vf[3]); o.z = cvt_pk_bf16(vf[4], vf[5]); o.w = cvt_pk_bf16(vf[6], vf[7]); kf[u] = __builtin_bit_cast(bf16x8, o);
        o.x = cvt_pk_bf16(vb[0], vb[1]); o.y = cvt_pk_bf16(vb[2], vb[3]); o.z = cvt_pk_bf16(vb[4], vb[5]); o.w = cvt_pk_bf16(vb[6], vb[7]); kb[u] = __builtin_bit_cast(bf16x8, o); }
    bf16_t* Sf = ret_state(c, b, h, 0, p) + (size_t)fr * 128 + 16 * w + 4 * fq;
    bf16_t* Sb = ret_state(c, b, h, 1, ret_posb(p)) + (size_t)fr * 128 + 16 * w + 4 * fq;
#pragma unroll 2
    for (int d = 0; d < 8; ++d) {
        f32x4 af = (f32x4){0.f, 0.f, 0.f, 0.f}, ab = af;
#pragma unroll
        for (int u = 0; u < 4; ++u) { const bf16x8 vf = tile128_frag(tV, 16 * d, 4 * u, fr, fq); af = mfma16(kf[u], vf, af); ab = mfma16(kb[u], vf, ab); }
        st4bf(Sf + (size_t)(16 * d) * 128, af); st4bf(Sb + (size_t)(16 * d) * 128, ab);
    }
    __syncthreads();
}
__device__ __forceinline__ void ret_out_block(const Ctx& c, int l, int it, bool dry = false) {
    const int fr = c.lane & 15, fq = c.lane >> 4, w = c.wave;
    const int p = it % 18, bh = it / 18, b = bh >> 2, h = bh & 3, s0 = ret_s0(p), row0 = ret_row0(b, p);
    const float lgf = ret_lg2(c, l, 0, h), lgb = ret_lg2(c, l, 1, h);
    LAS unsigned char* tK = c.lds; LAS unsigned char* tV = c.lds + 32768; LAS unsigned char* tF = c.lds + 65536; LAS unsigned char* tB = c.lds + 98304;
    { u32x4 r0[4], r1[4];
      tile128_load(r0, wsp<bf16_t>(c, P_DK) + (size_t)row0 * 512 + h * 128, 512, c.tid);
      tile128_load(r1, wsp<bf16_t>(c, VT_RET) + (size_t)((b * 4 + h) * 128) * SALL + s0, SALL, c.tid);
      tile128_store(r0, tK, c.tid); tile128_store(r1, tV, c.tid);
      tile128_load(r0, ret_state(c, b, h, 0, p), 128, c.tid);
      tile128_load(r1, ret_state(c, b, h, 1, ret_posb(p)), 128, c.tid);
      tile128_store(r0, tF, c.tid); tile128_store(r1, tB, c.tid); }
    const int il = 16 * w + fr;
    bf16x8 qf[4];
#pragma unroll
    for (int ks = 0; ks < 4; ++ks) qf[ks] = ldfrag(wsp<bf16_t>(c, P_DQ) + (size_t)(row0 + il) * 512 + h * 128 + 32 * ks + 8 * fq);
    __syncthreads();
    f32x4 y[8];
    {
        f32x4 st[8];
#pragma unroll
        for (int jt = 0; jt < 8; ++jt) { st[jt] = (f32x4){0.f, 0.f, 0.f, 0.f};
#pragma unroll
            for (int ks = 0; ks < 4; ++ks) st[jt] = mfma16(tile128_frag(tK, 16 * jt, 4 * ks, fr, fq), qf[ks], st[jt]);
#pragma unroll
            for (int r = 0; r < 4; ++r) { const int d = il - (16 * jt + 4 * fq + r); st[jt][r] *= d >= 0 ? fast_exp2((float)d * lgf) : fast_exp2((float)(-d) * lgb); } }
        bf16x8 pk[4];
#pragma unroll
        for (int u = 0; u < 4; ++u) pk[u] = pack8(st[2 * u], st[2 * u + 1]);
#pragma unroll
        for (int d = 0; d < 8; ++d) { y[d] = (f32x4){0.f, 0.f, 0.f, 0.f};
#pragma unroll
            for (int u = 0; u < 4; ++u) y[d] = mfma16(tile128_frag(tV, 16 * d, 4 * u, fr, fq), pk[u], y[d]); }
    }
    {
        const float xif = fast_exp2((float)(il + 1) * lgf), xib = fast_exp2((float)(128 - il) * lgb);
#pragma unroll 2
        for (int d = 0; d < 8; ++d) { f32x4 cf = (f32x4){0.f, 0.f, 0.f, 0.f}, cb = cf;
#pragma unroll
            for (int ks = 0; ks < 4; ++ks) { cf = mfma16(tile128_frag(tF, 16 * d, 4 * ks, fr, fq), qf[ks], cf); cb = mfma16(tile128_frag(tB, 16 * d, 4 * ks, fr, fq), qf[ks], cb); }
            y[d] += cf * xif + cb * xib; }
    }
    float s = 0.f;
#pragma unroll
    for (int d = 0; d < 8; ++d) s += (y[d].x + y[d].y) + (y[d].z + y[d].w);
    s += __shfl_xor(s, 16); s += __shfl_xor(s, 32);
    const float mu = s * (1.0f / 128.0f); float q = 0.f;
#pragma unroll
    for (int d = 0; d < 8; ++d) { y[d] = y[d] - mu; q += (y[d].x * y[d].x + y[d].y * y[d].y) + (y[d].z * y[d].z + y[d].w * y[d].w); }
    q += __shfl_xor(q, 16); q += __shfl_xor(q, 32);
    const float rstd = 1.0f / sqrtf(q * (1.0f / 128.0f) + LN_EPS);
    bf16_t* G = wsp<bf16_t>(c, P_CD) + (size_t)(row0 + il) * 1024 + h * 128 + 4 * fq;
    const float* gn = c.in[I_GNG] + l * 512 + h * 128 + 4 * fq;
#pragma unroll
    for (int d = 0; d < 8; ++d) { const u32x2 gw = *(const u32x2*)(G + 16 * d); const f32x4 gg = *(const f32x4*)(gn + 16 * d);
        f32x4 o = y[d] * rstd * gg; o.x *= bf_lo(gw.x); o.y *= bf_hi(gw.x); o.z *= bf_lo(gw.y); o.w *= bf_hi(gw.y); if (!dry) st4bf(G + 16 * d, o); }
    __syncthreads();
}

__device__ __forceinline__ void lru_item(const Ctx& c, int l, int it, bool final, bool dry = false) {
    const int n = it & 7, ch = (it >> 3) % 36, b = (it >> 3) / 36;
    const bool isctx = ch < 4; const int T = isctx ? CTX : SEQ, t0 = isctx ? 64 * ch : 64 * (ch - 4), rowbase = isctx ? NLAT + b * CTX : b * SEQ;
    LAS float* xa = (LAS float*)c.lds;
    LAS bf16_t* xab = (LAS bf16_t*)(c.lds + 16384);
    LAS float* ga = (LAS float*)(c.lds + 16384 + 9216);
    LAS float* gb = ga + 2 * 4096;
    LAS float* pa = gb + 2 * 4096;
    LAS float* h0 = pa + 1024;
    const bf16_t* AX = wsp<bf16_t>(c, P_AX);
    {
        const int t = c.tid >> 3, e8 = (c.tid & 7) * 8, cc = n * 64 + e8;
        const float* cw = c.in[I_CONVW] + l * 4 * 512 + cc; const float* cb = c.in[I_CONVB] + l * 512 + cc;
        float v[8]; { const f32x4 b0 = *(const f32x4*)cb, b1 = *(const f32x4*)(cb + 4); v[0] = b0.x; v[1] = b0.y; v[2] = b0.z; v[3] = b0.w; v[4] = b1.x; v[5] = b1.y; v[6] = b1.z; v[7] = b1.w; }
#pragma unroll
        for (int j = 0; j < 4; ++j) { const int tt = t0 + t + j - 2;
            if (tt >= 0 && tt < T) { const u32x4 xw = *(const u32x4*)(AX + (size_t)(rowbase + tt) * 512 + cc); const f32x4 w0 = *(const f32x4*)(cw + j * 512), w1 = *(const f32x4*)(cw + j * 512 + 4);
                v[0] += w0.x * bf_lo(xw.x); v[1] += w0.y * bf_hi(xw.x); v[2] += w0.z * bf_lo(xw.y); v[3] += w0.w * bf_hi(xw.y); v[4] += w1.x * bf_lo(xw.z); v[5] += w1.y * bf_hi(xw.z); v[6] += w1.z * bf_lo(xw.w); v[7] += w1.w * bf_hi(xw.w); } }
        *(LAS f32x4*)(xa + t * 64 + e8) = (f32x4){v[0], v[1], v[2], v[3]}; *(LAS f32x4*)(xa + t * 64 + e8 + 4) = (f32x4){v[4], v[5], v[6], v[7]};
        u32x4 o; o.x = cvt_pk_bf16(v[0], v[1]); o.y = cvt_pk_bf16(v[2], v[3]); o.z = cvt_pk_bf16(v[4], v[5]); o.w = cvt_pk_bf16(v[6], v[7]); *(LAS u32x4*)(xab + t * 72 + e8) = o;
    }
    if (final && c.tid < 128) {
        const int dir = c.tid >> 6, e = c.tid & 63, pos = dir == 0 ? ch : (isctx ? 3 - ch : 4 + (35 - ch));
        const float* sum = wsp<float>(c, WS_LRUSUM) + ((size_t)(b * 2 + dir) * 36) * 1024 + (n * 64 + e) * 2;
        float hst = 0.f;
        for (int q = 0; q < pos; ++q) { const f32x2 sq = *(const f32x2*)(sum + (size_t)q * 1024); hst = sq.x * hst + sq.y; }
        h0[dir * 64 + e] = hst;
    }
    __syncthreads();
    {
        const int fr = c.lane & 15, fq = c.lane >> 4, dir = c.wave >> 2, et = c.wave & 3, e = 16 * et + fr, cc = n * 64 + e;
        f32x4 ar[4], ai[4];
#pragma unroll
        for (int tt = 0; tt < 4; ++tt) { ar[tt] = (f32x4){0.f, 0.f, 0.f, 0.f}; ai[tt] = ar[tt]; }
        const bf16_t* Wa = wsp<bf16_t>(c, WM_LRU) + (size_t)((dir * 2 + 0) * 8 + n) * 4096 + e * 64 + 8 * fq;
        const bf16_t* Wx = wsp<bf16_t>(c, WM_LRU) + (size_t)((dir * 2 + 1) * 8 + n) * 4096 + e * 64 + 8 * fq;
#pragma unroll
        for (int ks = 0; ks < 2; ++ks) { const bf16x8 wa = ldfrag(Wa + 32 * ks), wx = ldfrag(Wx + 32 * ks);
#pragma unroll
            for (int tt = 0; tt < 4; ++tt) { const bf16x8 xf = *(const LAS bf16x8*)(xab + (16 * tt + fr) * 72 + 32 * ks + 8 * fq); ar[tt] = mfma16(xf, wa, ar[tt]); ai[tt] = mfma16(xf, wx, ai[tt]); } }
        const float ba = c.in[I_LBA][(l * 2 + dir) * 512 + cc], bx = c.in[I_LBX][(l * 2 + dir) * 512 + cc], lam = c.in[I_LLAM][(l * 2 + dir) * 512 + cc];
        const float sp8 = -8.0f * LOG2E * log1pf(expf(-lam));
#pragma unroll
        for (int tt = 0; tt < 4; ++tt)
#pragma unroll
            for (int r = 0; r < 4; ++r) { const int t = 16 * tt + 4 * fq + r;
                const float rg = sigmoidf_(ar[tt][r] + ba), ig = sigmoidf_(ai[tt][r] + bx);
                const float a = fast_exp2(rg * sp8), bt = __builtin_sqrtf(fmaxf(1.0f - a * a, 0.f)) * (ig * xa[t * 64 + e]);
                ga[(dir * 64 + t) * 64 + e] = a; gb[(dir * 64 + t) * 64 + e] = bt; }
    }
    __syncthreads();
    const int sdir = c.tid >> 8, part = (c.tid >> 6) & 3, se = c.tid & 63;
    float av[16], bv[16];
#pragma unroll
    for (int k = 0; k < 16; ++k) { const int i = 16 * part + k, t = sdir == 0 ? i : 63 - i; av[k] = ga[(sdir * 64 + t) * 64 + se]; bv[k] = gb[(sdir * 64 + t) * 64 + se]; }
    { float hh = 0.f, ap = 1.f;
#pragma unroll
      for (int k = 0; k < 16; ++k) { hh = av[k] * hh + bv[k]; ap *= av[k]; }
      *(LAS f32x2*)(pa + ((sdir * 4 + part) * 64 + se) * 2) = (f32x2){ap, hh}; }
    __syncthreads();
    if (!final) {
        if (part == 0) { float hh = 0.f, ap = 1.f;
#pragma unroll
            for (int q = 0; q < 4; ++q) { const f32x2 s = *(const LAS f32x2*)(pa + ((sdir * 4 + q) * 64 + se) * 2); hh = s.x * hh + s.y; ap *= s.x; }
            const int pos = sdir == 0 ? ch : (isctx ? 3 - ch : 4 + (35 - ch));
            *(f32x2*)(wsp<float>(c, WS_LRUSUM) + ((size_t)(b * 2 + sdir) * 36 + pos) * 1024 + (n * 64 + se) * 2) = (f32x2){ap, hh}; }
        return;
    }
    { float hh = h0[sdir * 64 + se];
      for (int q = 0; q < part; ++q) { const f32x2 s = *(const LAS f32x2*)(pa + ((sdir * 4 + q) * 64 + se) * 2); hh = s.x * hh + s.y; }
#pragma unroll
      for (int k = 0; k < 16; ++k) { const int i = 16 * part + k, t = sdir == 0 ? i : 63 - i; hh = av[k] * hh + bv[k]; gb[(sdir * 64 + t) * 64 + se] = hh; } }
    __syncthreads();
    {
        const int t = c.tid >> 3, e8 = (c.tid & 7) * 8;
        bf16_t* p = wsp<bf16_t>(c, P_AB) + (size_t)(rowbase + t0 + t) * 1024 + n * 64 + e8;
        const u32x4 g = *(const u32x4*)p;
        const f32x4 f0 = *(const LAS f32x4*)(gb + t * 64 + e8), f1 = *(const LAS f32x4*)(gb + t * 64 + e8 + 4), r0 = *(const LAS f32x4*)(gb + (64 + t) * 64 + e8), r1 = *(const LAS f32x4*)(gb + (64 + t) * 64 + e8 + 4);
        u32x4 o; o.x = cvt_pk_bf16((f0.x + r0.x) * bf_lo(g.x), (f0.y + r0.y) * bf_hi(g.x)); o.y = cvt_pk_bf16((f0.z + r0.z) * bf_lo(g.y), (f0.w + r0.w) * bf_hi(g.y));
        o.z = cvt_pk_bf16((f1.x + r1.x) * bf_lo(g.z), (f1.y + r1.y) * bf_hi(g.z)); o.w = cvt_pk_bf16((f1.z + r1.z) * bf_lo(g.w), (f1.w + r1.w) * bf_hi(g.w));
        if (!dry) *(u32x4*)p = o;
    }
    __syncthreads();
}
#ifndef DBG
#define DBG 0xFFF
#endif
constexpr int LDS_BYTES = 147456, MISC_OFF = 131072 + 320;
constexpr int CW_BAR = 4096;
struct Args { const float* in[27]; float* out; unsigned char* ws; };
__device__ __forceinline__ void make_ctx(Ctx& c, const Args& args, unsigned char* lds_raw) {
    int t = threadIdx.x; asm volatile("" : "+v"(t));
#pragma unroll
    for (int i = 0; i < 27; ++i) c.in[i] = args.in[i];
    float* o = args.out; unsigned char* w = args.ws; asm volatile("" : "+s"(o), "+s"(w));
    c.out = (float*)(GAS float*)o; c.ws = (unsigned char*)(GAS unsigned char*)w; c.lds = (LAS unsigned char*)lds_raw;
    c.tid = t; c.lane = t & 63; c.wave = __builtin_amdgcn_readfirstlane(t >> 6); c.G = gridDim.x; c.bid = blockIdx.x;
}
#define CTX() Ctx c; make_ctx(c, args, lds_raw)
__global__ void __launch_bounds__(512, 2) fwd_kernel(Args args) {
    extern __shared__ __attribute__((aligned(16))) unsigned char lds_raw[];
    XcdBarrier bar;
    { CTX();
      for (int u = c.tid; u < (LDS_BYTES - 131072) / 4; u += 512) ((LAS unsigned*)(c.lds + 131072))[u] = 0u;
      __syncthreads();
      bar = xcd_barrier_post(wsp<unsigned>(c, WS_CTL) + CW_BAR, (volatile LAS unsigned*)(c.lds + MISC_OFF) + 8); }
#define GRID_BAR() xcd_barrier(bar)
#define SCR(c) ((LAS float*)((c).lds + 57344 + (c).wave * 8704))
    { CTX(); p0_modtab(c); }
    { CTX(); p0_rope_tables(c); }
    { CTX(); int base = 0; conv_ffn(c, 0, 0, 0, base, c.bid * 8 + c.wave, c.G * 8, SCR(c)); conv_mixer(c, 0, base, c.bid * 8 + c.wave, c.G * 8, SCR(c)); }
    cg::this_grid().sync();
    { CTX(); p0_rows(c); }
    GRID_BAR();
#pragma unroll 1
    for (int l = 0; l < DEPTH; ++l) {
        const bool last = l == DEPTH - 1;
        const int nM = last ? 64 : 72;
        const int dbg = (DBG >> (3 * l)) & 7;
        if (dbg & 1) {
        for (int rep = 0; rep < ((TW & 16) ? 2 : 1); ++rep)
        { CTX(); SchedTiles S; S.ord.init(72, 22, c.G, c.bid); S.A = (const char*)wsp<bf16_t>(c, WS_H); S.B = (const char*)wsp<bf16_t>(c, WS_WF); S.ld = 1024; S.nt = 16;
          EpiSwiglu E{wsp<bf16_t>(c, WS_U)}; pg8::gemm_stream(c.lds, c.tid, S, E); }
        GRID_BAR();
        { CTX(); SchedResid S; S.ord.init(64, 4, c.G, c.bid); S.A = (const char*)wsp<bf16_t>(c, WS_U); S.B = (const char*)(wsp<bf16_t>(c, WS_WF) + (size_t)5632 * 1024); S.ld = FF; S.nt = 44; S.ctx = true; S.Actx = nullptr; S.partA = 0; S.kpart = 1;
          EpiResid E{c, l, 2, 0.5f, wsp<float>(c, WS_SLAB_FFN)}; pg8::gemm_stream(c.lds, c.tid, S, E); }
        GRID_BAR();
        }
        if (TW & 1) { CTX(); phase_normalize(c, NT, c.in[I_LNG] + l * 3 * D, c.in[I_LNB] + l * 3 * D, l, 3, 4, wsp<float>(c, WS_SLAB_FFN), l, 2, 0.5f, c.G != 123457); }
        { CTX(); phase_normalize(c, NT, c.in[I_LNG] + l * 3 * D, c.in[I_LNB] + l * 3 * D, l, 3, 4, wsp<float>(c, WS_SLAB_FFN), l, 2, 0.5f); }
        GRID_BAR();
        if (dbg & 2) {
        if (!last) { CTX(); SchedTiles S; S.ord.init(72, 18, c.G, c.bid); S.A = (const char*)wsp<bf16_t>(c, WS_H); S.B = (const char*)wsp<bf16_t>(c, WM_INP); S.ld = 1024; S.nt = 16;
          EpiInp E{c}; pg8::gemm_stream(c.lds, c.tid, S, E); }
        else { CTX(); SchedInpLast S; S.ord.init(64, 18, c.G, c.bid); S.A = (const char*)wsp<bf16_t>(c, WS_H); S.B = (const char*)wsp<bf16_t>(c, WM_INP); S.ld = 1024; S.nt = 16;
          EpiInp E{c}; pg8::gemm_stream(c.lds, c.tid, S, E); }
        GRID_BAR();
        { CTX(); SchedTiles S; S.ord.init(last ? 64 : 72, 3, c.G, c.bid); S.A = (const char*)(wsp<bf16_t>(c, P_CD) + 512); S.B = (const char*)wsp<bf16_t>(c, WM_UQ); S.ld = 1024; S.nt = 6;
          EpiMlaQ E{c}; pg8::gemm_stream(c.lds, c.tid, S, E); }
        { CTX(); SchedTiles S; S.ord.init(72, 4, c.G, c.bid); S.A = (const char*)wsp<bf16_t>(c, P_CKV); S.B = (const char*)wsp<bf16_t>(c, WM_UKV); S.ld = 256; S.nt = 4;
          EpiMlaKV E{c}; pg8::gemm_stream(c.lds, c.tid, S, E); __syncthreads(); }
        for (int rep = 0; rep < ((TW & 2) ? 2 : 1); ++rep) { CTX(); for (int it = c.bid; it < 8 * 36 * 8; it += c.G) lru_item(c, l, it, false); }
        { CTX(); for (int it = c.bid * 8 + c.wave; it < NT / 16; it += c.G * 8) mla_kr_item(c, it); }
        for (int rep = 0; rep < ((TW & 4) ? 2 : 1); ++rep) { CTX(); __syncthreads(); for (int it = c.bid; it < 8 * 4 * 18; it += c.G) ret_kv_block(c, l, it); }
        GRID_BAR();
        if (!(RDBG & 8)) { CTX(); for (int e = c.bid * 512 + c.tid; e < 64 * 2048; e += c.G * 512) ret_prefix(c, l, e); }
        GRID_BAR();
        if (TW & 8) { CTX(); for (int it = c.bid; it < 8 * 36 * 8; it += c.G) { if (last && ((it >> 3) % 36) < 4) continue; lru_item(c, l, it, true, c.G != 123457); } }
        { CTX(); for (int it = c.bid; it < 8 * 36 * 8; it += c.G) { if (last && ((it >> 3) % 36) < 4) continue; lru_item(c, l, it, true); } }
        if (TW & 0xF00) { CTX(); const bool dryv = c.G != 123457; for (int it = c.bid; it < 512; it += c.G) mla_block_item<((TW >> 8) & 15) - 1>(c, it, dryv); }
        { CTX(); for (int it = c.bid; it < 512; it += c.G) mla_block_item<0>(c, it); }
        if (TW & 128) { CTX(); for (int it = c.bid; it < 512; it += c.G) gqa_block_item(c, l, it, c.G != 123457); }
        { CTX(); for (int it = c.bid; it < 512; it += c.G) gqa_block_item(c, l, it); }
        if (!last) { CTX(); const int gw = c.bid * 8 + c.wave, NGW = c.G * 8; for (int it = 2048 + gw; it < 2304; it += NGW) mla_item(c, it); for (int it = 2048 + gw; it < 2304; it += NGW) gqa_item(c, l, it); }
        if (TW & 32) { CTX(); __syncthreads(); for (int it = c.bid; it < 8 * 4 * 18; it += c.G) { if (last && (it % 18) < 2) continue; ret_out_block(c, l, it, c.G != 123457); } }
        { CTX(); __syncthreads(); for (int it = c.bid; it < 8 * 4 * 18; it += c.G) { if (last && (it % 18) < 2) continue; ret_out_block(c, l, it); } }
        GRID_BAR();
        { CTX(); SchedMerge S; S.ord.init(64, 4, c.G, c.bid); S.ctx = !last; S.H = (const char*)wsp<bf16_t>(c, WS_H); S.Wg = (const char*)wsp<bf16_t>(c, WM_G); S.Wb = (const char*)wsp<bf16_t>(c, WM_BR);
          S.AB = (const char*)wsp<bf16_t>(c, P_AB); S.CD = (const char*)wsp<bf16_t>(c, P_CD); S.ld = 1024;
          EpiMerge E{(GAS unsigned char*)(c.ws + WS_SCR_SIG + (size_t)c.bid * 131072), (GAS unsigned char*)(c.ws + WS_SCR_M + (size_t)c.bid * 262144), (GAS bf16_t*)wsp<bf16_t>(c, WS_MG), (GAS bf16_t*)wsp<bf16_t>(c, WS_MGP)}; pg8::gemm_stream(c.lds, c.tid, S, E); }
        GRID_BAR();
        { CTX(); SchedResid S; S.ord.init(64, 4, c.G, c.bid); S.A = (const char*)wsp<bf16_t>(c, WS_MG); S.B = (const char*)wsp<bf16_t>(c, WM_OUT); S.ld = 1024; S.nt = 16; S.ctx = !last; S.Actx = (const char*)wsp<bf16_t>(c, WS_MGP); S.partA = (size_t)NCTX * D * 2; S.kpart = 0;
          EpiResid E{c, l, 5, 1.0f, wsp<float>(c, WS_SLAB_OUT)}; pg8::gemm_stream(c.lds, c.tid, S, E); }
        GRID_BAR();
        }
        { CTX(); phase_normalize(c, nM * 256, c.in[I_LNG] + (l * 3 + 1) * D, c.in[I_LNB] + (l * 3 + 1) * D, l, 6, 7, wsp<float>(c, WS_SLAB_OUT), l, 5, 1.0f); }
        for (int rep = 0; rep < ((TW & 64) ? 2 : 1); ++rep)
        { CTX(); int base = 0; const int gw = c.bid * 8 + c.wave, NGW = c.G * 8; conv_ffn(c, l, 1, 1, base, gw, NGW, SCR(c)); if (!last) { conv_ffn(c, l + 1, 0, 0, base, gw, NGW, SCR(c)); conv_mixer(c, l + 1, base, gw, NGW, SCR(c)); } }
        GRID_BAR();
        if (dbg & 4) {
        { CTX(); SchedTiles S; S.ord.init(nM, 22, c.G, c.bid); S.A = (const char*)wsp<bf16_t>(c, WS_H); S.B = (const char*)wsp<bf16_t>(c, WS_WF + WF_SLOT); S.ld = 1024; S.nt = 16;
          EpiSwiglu E{wsp<bf16_t>(c, WS_U)}; pg8::gemm_stream(c.lds, c.tid, S, E); }
        GRID_BAR();
        { CTX(); SchedResid S; S.ord.init(64, 4, c.G, c.bid); S.A = (const char*)wsp<bf16_t>(c, WS_U); S.B = (const char*)(wsp<bf16_t>(c, WS_WF + WF_SLOT) + (size_t)5632 * 1024); S.ld = FF; S.nt = 44; S.ctx = !last; S.Actx = nullptr; S.partA = 0; S.kpart = 1;
          EpiResid E{c, l, 8, 0.5f, wsp<float>(c, WS_SLAB_FFN)}; pg8::gemm_stream(c.lds, c.tid, S, E); }
        GRID_BAR();
        }
        { CTX(); phase_normalize(c, nM * 256, c.in[I_LNG] + (l * 3 + 2) * D, c.in[I_LNB] + (l * 3 + 2) * D, last ? -1 : l + 1, 0, 1, wsp<float>(c, WS_SLAB_FFN), l, 8, 0.5f); }
        if (!last) GRID_BAR();
    }
}

extern "C" void kernel_launch(void* const* d_in, const int* in_sizes, int n_in, void* d_out, int out_size, void* d_ws, size_t ws_size, hipStream_t stream) {
    static int grid = 0;
    if (grid == 0) {
        if (n_in != 27 || out_size != NLAT * D || ws_size < WS_END) { fprintf(stderr, "kernel_launch: unexpected problem (n_in %d, out %d, ws %zu < %zu)\n", n_in, out_size, ws_size, (size_t)WS_END); grid = -1; return; }
        int dev = 0, cus = 0, per_cu = 0;
        hipGetDevice(&dev); hipDeviceGetAttribute(&cus, hipDeviceAttributeMultiprocessorCount, dev);
        hipFuncSetAttribute((const void*)fwd_kernel, hipFuncAttributeMaxDynamicSharedMemorySize, LDS_BYTES);
        hipOccupancyMaxActiveBlocksPerMultiprocessor(&per_cu, (const void*)fwd_kernel, 512, LDS_BYTES);
        if (per_cu < 1) { fprintf(stderr, "kernel_launch: occupancy query says %d workgroups per CU\n", per_cu); per_cu = 1; }
        (void)hipGetLastError();
        grid = cus;
    }
    if (grid < 0) return;
    hipMemsetAsync((char*)d_ws + WS_CTL, 0, CTL_BYTES, stream);
    Args a{};
    for (int i = 0; i < 27; ++i) a.in[i] = (const float*)d_in[i];
    a.out = (float*)d_out; a.ws = (unsigned char*)d_ws;
    void* kargs[] = {&a};
    hipError_t e = hipLaunchCooperativeKernel((const void*)fwd_kernel, dim3(grid), dim3(512), kargs, LDS_BYTES, stream);
    if (e != hipSuccess) fprintf(stderr, "cooperative launch failed: %s (grid %d)\n", hipGetErrorString(e), grid);
}
```

```cpp
#include <hip/hip_runtime.h>
#include <hip/hip_cooperative_groups.h>
#include <cstdio>
#include <cstdint>
namespace cg = cooperative_groups;
#ifndef DBG
#define DBG 0xFFF
#endif
#ifndef RDBG
#define RDBG 7
#endif
#ifndef TW
#define TW 0
#endif

#define LAS __attribute__((address_space(3)))
#define GAS __attribute__((address_space(1)))
typedef unsigned short bf16_t;
typedef short bf16x8 __attribute__((ext_vector_type(8)));
typedef float f32x4 __attribute__((ext_vector_type(4)));
typedef float f32x2 __attribute__((ext_vector_type(2)));
typedef unsigned u32x4 __attribute__((ext_vector_type(4)));
typedef unsigned u32x2 __attribute__((ext_vector_type(2)));

constexpr int D = 1024, NB = 8, SEQ = 2048, CTX = 256, DEPTH = 2, FF = 2816;
constexpr int NLAT = NB * SEQ;
constexpr int NCTX = NB * CTX;
constexpr int NT = NLAT + NCTX;
constexpr int SALL = CTX + SEQ;
constexpr int IN_COLS = 8608, NINP = 4608;
constexpr float LN_EPS = 1e-5f;
constexpr float DN_ALPHA = 1.41421356237309515f;
constexpr float LOG2E = 1.44269504088896341f;

constexpr size_t MiB = 1u << 20;
constexpr size_t WS_CTL = 0, CTL_BYTES = 1 * MiB;
constexpr size_t WS_MISC = 1 * MiB;
constexpr size_t WS_MODTAB = WS_MISC;
constexpr size_t WS_CS8 = WS_MISC + 1 * MiB;
constexpr size_t WS_CS16 = WS_CS8 + 64 * 8 * 2 * 4;
constexpr size_t WS_CS32 = WS_CS16 + 64 * 16 * 2 * 4;
constexpr size_t WS_LRUSUM = WS_MISC + 1 * MiB + 512 * 1024;
constexpr size_t WS_WM = 5 * MiB;
constexpr size_t WM_INP = WS_WM, WM_G = WS_WM + 9 * MiB, WM_BR = WS_WM + 17 * MiB, WM_OUT = WS_WM + 21 * MiB, WM_UQ = WS_WM + 23 * MiB  , WM_UKV = WS_WM + 24 * MiB + 512 * 1024  , WM_LRU = WS_MISC + 1 * MiB + 64 * 1024;
constexpr size_t WS_XC = 30 * MiB;
constexpr size_t WS_H = 38 * MiB;
constexpr size_t WS_QF = 74 * MiB;
constexpr size_t WS_KF = 101 * MiB;
constexpr size_t WS_VTM = 128 * MiB;
constexpr size_t WS_MG = WS_KF;
constexpr size_t WS_RET = 146 * MiB;
constexpr size_t WS_BIG = 182 * MiB;
constexpr size_t P_AX = WS_BIG, P_DQ = WS_BIG + 18 * MiB, P_DK = WS_BIG + 36 * MiB, VT_RET = WS_BIG + 54 * MiB, KT_RET = WS_BIG + 72 * MiB, VT_GQA = WS_BIG + 90 * MiB;
constexpr size_t P_BK = WS_BIG + 94 * MiB + 512 * 1024;
constexpr size_t P_AB = WS_BIG + 99 * MiB;
constexpr size_t P_CD = WS_BIG + 135 * MiB;
constexpr size_t P_CKV = WS_BIG + 171 * MiB, P_CKR = P_CKV + (size_t)NT * 256 * 2;
constexpr size_t ST_CQ = P_CKR + (size_t)NT * 32 * 2  , ST_CKV = ST_CQ + (size_t)NT * 12 * 4  , WS_XCH = ST_CKV + (size_t)NT * 8 * 4  , WS_END = WS_XCH + 64 * 256 * 4 * 8;
constexpr size_t WS_U = WS_BIG;
constexpr size_t WS_WF = WS_BIG + 99 * MiB;
constexpr size_t WF_SLOT = (size_t)(5632 * 1024 + 1024 * 2816) * 2;
constexpr size_t WS_SLAB_FFN = WS_BIG + 136 * MiB;
constexpr size_t WS_SLAB_OUT = WS_BIG;
constexpr size_t WS_MGP = WS_QF;
constexpr size_t WS_SCR_SIG = WS_BIG, WS_SCR_M = WS_BIG + 32 * MiB;
static_assert(WS_WF + 2 * WF_SLOT <= WS_END && WS_U + (size_t)NT * FF * 2 <= WS_WF, "FFN overlay");
static_assert(WS_SCR_M + 64 * MiB <= P_AB, "merge scratch overlay");

typedef __bf16 bf16x2_t __attribute__((ext_vector_type(2)));
__device__ __forceinline__ unsigned cvt_pk_bf16(float lo, float hi) { bf16x2_t v; v.x = (__bf16)lo; v.y = (__bf16)hi; return __builtin_bit_cast(unsigned, v); }
__device__ __forceinline__ float bf_lo(unsigned w) { return __uint_as_float(w << 16); }
__device__ __forceinline__ float bf_hi(unsigned w) { return __uint_as_float(w & 0xffff0000u); }
__device__ __forceinline__ float bf2f(bf16_t b) { return __uint_as_float(((unsigned)b) << 16); }
__device__ __forceinline__ bf16_t f2bf(float f) { return (bf16_t)(cvt_pk_bf16(f, 0.f) & 0xffffu); }
__device__ __forceinline__ float fast_exp2(float x) { return __builtin_amdgcn_exp2f(x); }
__device__ __forceinline__ float fast_rcp(float x) { return __builtin_amdgcn_rcpf(x); }
__device__ __forceinline__ float sigmoidf_(float x) { return fast_rcp(1.0f + fast_exp2(-LOG2E * x)); }
__device__ __forceinline__ float siluf_(float x) { return x * sigmoidf_(x); }
__device__ __forceinline__ float geluf_(float v) { return v * sigmoidf_(1.5957691216057308f * (v + 0.044715f * v * v * v)); }
__device__ __forceinline__ float rows_max(float x) {
    auto r = __builtin_amdgcn_permlane16_swap(__float_as_uint(x), __float_as_uint(x), false, false); x = fmaxf(__uint_as_float(r[0]), __uint_as_float(r[1]));
    auto q = __builtin_amdgcn_permlane32_swap(__float_as_uint(x), __float_as_uint(x), false, false); return fmaxf(__uint_as_float(q[0]), __uint_as_float(q[1]));
}
__device__ __forceinline__ float rows_sum(float x) {
    auto r = __builtin_amdgcn_permlane16_swap(__float_as_uint(x), __float_as_uint(x), false, false); x = __uint_as_float(r[0]) + __uint_as_float(r[1]);
    auto q = __builtin_amdgcn_permlane32_swap(__float_as_uint(x), __float_as_uint(x), false, false); return __uint_as_float(q[0]) + __uint_as_float(q[1]);
}
__device__ __forceinline__ u32x4 widen16(u32x2 a, u32x2 b) {
    auto r0 = __builtin_amdgcn_permlane16_swap(a.x, b.x, false, false); auto r1 = __builtin_amdgcn_permlane16_swap(a.y, b.y, false, false);
    return (u32x4){r0[0], r1[0], r0[1], r1[1]};
}
__device__ __forceinline__ float wave_sum(float v) {
#pragma unroll
    for (int o = 1; o < 64; o <<= 1) v += __shfl_xor(v, o);
    return v;
}
__device__ __forceinline__ int row_mod(int row) { return row < NLAT ? (row >> 11) : 8; }
__device__ __forceinline__ int posperm(int key) { return 8 * ((key >> 2) & 3) + 4 * ((key >> 4) & 1) + (key & 3); }
#define XB_TMO      128
#define XB_XCNT(j)  (256  + 64 * (j))
#define XB_XSUB(j)  (1280 + 64 * (j))
#define XB_XGEN(j)  (2304 + 64 * (j))
#define XB_TOP      3328
#define XB_TOPGEN   3392
#define XCD_BAR_WORDS 3456
#define XB_SPIN_CAP (1u << 20)
__device__ __forceinline__ unsigned xb_ld(unsigned* p)              { return __hip_atomic_load(p, __ATOMIC_RELAXED, __HIP_MEMORY_SCOPE_AGENT); }
__device__ __forceinline__ unsigned xb_add(unsigned* p, unsigned v) { return __hip_atomic_fetch_add(p, v, __ATOMIC_RELAXED, __HIP_MEMORY_SCOPE_AGENT); }
__device__ __forceinline__ unsigned xb_xcc_id() { return (unsigned)__builtin_amdgcn_s_getreg((3 << 11) | 20) & 0xFu; }
#define XB_SPIN(cond, bar) do { unsigned _sp = 0; while (cond) { __builtin_amdgcn_s_sleep(1); \
    if ((++_sp & 255u) == 0u) { if (xb_ld(&(bar)[XB_TMO])) break; if (_sp > XB_SPIN_CAP) { atomicAdd(&(bar)[XB_TMO], 1u); break; } } } } while (0)
struct XcdBarrier { unsigned* bar; unsigned x; volatile LAS unsigned* st; };
__device__ __forceinline__ XcdBarrier xcd_barrier_post(unsigned* bar, volatile LAS unsigned* st) {
    XcdBarrier b; b.bar = bar; b.x = xb_xcc_id(); b.st = st;
    if (threadIdx.x == 0) (void)xb_add(&bar[XB_XCNT(b.x)], 1u);
    return b;
}
__device__ __forceinline__ void xcd_barrier_complete(unsigned* bar, unsigned x, unsigned& nloc, unsigned& nx) {
    const unsigned G = gridDim.x * gridDim.y * gridDim.z;
    unsigned sum, cnt, mine, sp = 0u;
    for (;;) {
        sum = 0u; cnt = 0u; mine = 0u;
#pragma unroll
        for (unsigned j = 0; j < 16; ++j) { const unsigned c = xb_ld(&bar[XB_XCNT(j)]); sum += c; cnt += (c > 0u) ? 1u : 0u; mine = (j == x) ? c : mine; }
        if (sum == G) break;
        __builtin_amdgcn_s_sleep(1);
        if ((++sp & 255u) == 0u) { if (xb_ld(&bar[XB_TMO])) break; if (sp > XB_SPIN_CAP) { atomicAdd(&bar[XB_TMO], 1u); break; } }
    }
    nloc = mine > 0u ? mine : 1u; nx = cnt > 0u ? cnt : 1u;
}
__device__ __forceinline__ void xcd_barrier(const XcdBarrier& b) {
    asm volatile("s_waitcnt vmcnt(0)" ::: "memory");
    __syncthreads();
    if (threadIdx.x == 0) {
        unsigned* bar = b.bar; asm volatile("" : "+s"(bar));
        bar = (unsigned*)(GAS unsigned*)bar;
        unsigned bx = b.x; asm volatile("" : "+s"(bx));
        __builtin_amdgcn_s_waitcnt(0);
        unsigned nloc = b.st[0], nx = b.st[1];
        if (nloc == 0u) { xcd_barrier_complete(bar, bx, nloc, nx); b.st[0] = nloc; b.st[1] = nx; }
        const unsigned old = xb_add(&bar[XB_XSUB(bx)], 1u);
        const unsigned gen = old / nloc;
        if (old + 1u == (gen + 1u) * nloc) {
            __builtin_amdgcn_fence(__ATOMIC_RELEASE, "agent");
            asm volatile("s_waitcnt vmcnt(0)" ::: "memory");
            const unsigned og = xb_add(&bar[XB_TOP], 1u);
            const unsigned tg = og / nx;
            if (og + 1u == (tg + 1u) * nx) xb_add(&bar[XB_TOPGEN], 1u);
            else XB_SPIN(xb_ld(&bar[XB_TOPGEN]) == tg, bar);
            __builtin_amdgcn_fence(__ATOMIC_ACQUIRE, "agent");
            xb_add(&bar[XB_XGEN(bx)], 1u);
            asm volatile("s_waitcnt vmcnt(0)" ::: "memory");
        } else {
            XB_SPIN(xb_ld(&bar[XB_XGEN(bx)]) == gen, bar);
            __builtin_amdgcn_fence(__ATOMIC_ACQUIRE, "agent");
            asm volatile("s_waitcnt vmcnt(0)" ::: "memory");
        }
    }
    __syncthreads();
}

namespace pg8 {
constexpr int BM = 256, BK = 64, HALF = 128, HTB = HALF * BK * 2, STAGE_BYTES = 8 * HTB, NXCD = 8, WGM = 8;
__host__ __device__ __forceinline__ int lds_byte(int r, int c) { const int st = (r >> 4) * 2 + (c >> 5), rr = r & 15, cc = c & 31, ob = rr * 64 + cc * 2; return st * 1024 + (ob ^ (((ob >> 9) & 1) << 5)); }
__host__ __device__ __forceinline__ void stage_rc(int b, int& R, int& C) { const int st = b / 1024, sb = b % 1024, swz = sb ^ (((sb >> 9) & 1) << 5); R = (st >> 1) * 16 + swz / 64; C = (st & 1) * 32 + (swz % 64) / 2; }
__host__ __device__ __forceinline__ int perm32(int rho) { const int n = rho >> 4, i = rho & 15; return 8 * (i >> 2) + 4 * n + (i & 3); }

struct Unit { const char* A; const char* B; int nt, kind, pm, pn, k; };

struct TileOrder {
    int nM, nN, nwg, G, c, wgm;
    __device__ void init(int nM_, int nN_, int G_, int c_, int wgm_ = WGM) { nM = nM_; nN = nN_; nwg = nM * nN; G = G_; c = c_; wgm = wgm_; }
    __device__ bool tile(int i, int& pm, int& pn) const {
        const long L = (long)i * G + c; if (L >= nwg) return false;
        int wgid = (int)L; { const int q = nwg / NXCD, r = nwg % NXCD, xcd = wgid % NXCD, off = wgid / NXCD; wgid = (xcd < r ? xcd * (q + 1) : r * (q + 1) + (xcd - r) * q) + off; }
        const int nig = wgm * nN, gid = wgid / nig, fm = gid * wgm, gsz = (nM - fm) < wgm ? (nM - fm) : wgm;
        pm = fm + ((wgid % nig) % gsz); pn = (wgid % nig) / gsz; return true;
    }
};

template <class Epi, class Sched>
__device__ __forceinline__ void gemm_stream(LAS unsigned char* lds, const int tid, const Sched& S, const Epi& E) {
    const int wid = __builtin_amdgcn_readfirstlane(tid >> 6), lane = tid & 63, wr = wid >> 2, wc = wid & 3, fr = lane & 15, fq = lane >> 4;
    unsigned voff[2];
#pragma unroll
    for (int i = 0; i < 2; ++i) { int R, C; stage_rc(tid * 16 + i * 8192, R, C); voff[i] = (unsigned)(R * S.ld + C) * 2u; }
    const size_t hstep = (size_t)HALF * S.ld * 2;
    const size_t kstep = (size_t)(BK * 2);
    const unsigned ldsw = (unsigned)wid * 1024u;
    const int aoff = lds_byte(wr * 64 + fr, fq * 8), boff = lds_byte(wc * 32 + fr, fq * 8);
#define PG8_SA(b, h) (((b) * 2 + (h)) * HTB)
#define PG8_SB(b, h) ((4 + (b) * 2 + (h)) * HTB)
#define PG8_STAGE(bufoff, gbase, voff) do { _Pragma("unroll") for (int _i = 0; _i < 2; ++_i) \
        __builtin_amdgcn_global_load_lds((const unsigned*)((const char*)(gbase) + (voff)[_i]), (LAS unsigned*)(lds + (bufoff) + ldsw + _i * 8192), 16, 0, 0); } while (0)
#define PG8_LDA(dst, b, h) do { _Pragma("unroll") for (int m = 0; m < 4; ++m) _Pragma("unroll") for (int k = 0; k < 2; ++k) dst[m][k] = *(const LAS bf16x8*)(lds + PG8_SA(b, h) + aoff + m * 2048 + k * 1024); } while (0)
#define PG8_LDB(dst, b, h) do { _Pragma("unroll") for (int n = 0; n < 2; ++n) _Pragma("unroll") for (int k = 0; k < 2; ++k) dst[n][k] = *(const LAS bf16x8*)(lds + PG8_SB(b, h) + boff + n * 2048 + k * 1024); } while (0)
#define PG8_MMA(ai, bj, At, Bt) do { __builtin_amdgcn_s_setprio(1); _Pragma("unroll") for (int m = 0; m < 4; ++m) _Pragma("unroll") for (int n = 0; n < 2; ++n) _Pragma("unroll") for (int k = 0; k < 2; ++k) \
        acc[ai][bj][m][n] = __builtin_amdgcn_mfma_f32_16x16x32_bf16(Bt[n][k], At[m][k], acc[ai][bj][m][n], 0, 0, 0); __builtin_amdgcn_s_setprio(0); } while (0)
#define PG8_WAIT_V(n) asm volatile("s_waitcnt vmcnt(" #n ")" ::: "memory")
#define PG8_WAIT_L(n) asm volatile("s_waitcnt lgkmcnt(" #n ")" ::: "memory")
#define PG8_BAR __builtin_amdgcn_s_barrier()
#define PG8_SCHED __builtin_amdgcn_sched_barrier(0)
    Unit cur, nxt; int ui = 0;
    if (!S.next(0, cur)) return;
    f32x4 acc[2][2][4][2];
#pragma unroll
    for (int a = 0; a < 2; ++a)
#pragma unroll
        for (int b = 0; b < 2; ++b)
#pragma unroll
            for (int m = 0; m < 4; ++m)
#pragma unroll
                for (int n = 0; n < 2; ++n) acc[a][b][m][n] = (f32x4){0.f, 0.f, 0.f, 0.f};
    bf16x8 At[4][2], B0[2][2], B1[2][2];
    const char* cA = cur.A; const char* cB = cur.B;
    PG8_STAGE(PG8_SB(0, 0), cB, voff); PG8_STAGE(PG8_SB(0, 1), cB + hstep, voff); PG8_STAGE(PG8_SA(0, 0), cA, voff); PG8_STAGE(PG8_SA(0, 1), cA + hstep, voff);
    if (wr == 1) PG8_BAR;
    PG8_WAIT_V(2); PG8_BAR;
    PG8_STAGE(PG8_SB(1, 0), cB + kstep, voff); PG8_STAGE(PG8_SA(1, 0), cA + kstep, voff); PG8_STAGE(PG8_SB(1, 1), cB + hstep + kstep, voff);
    PG8_WAIT_V(6); PG8_BAR;
    for (;;) {
        const bool has_next = S.next(ui + 1, nxt);
        const char* nA; const char* nB;
        if (has_next) { nA = nxt.A; nB = nxt.B; } else { nA = cA; nB = cB; }
        const int nt = cur.nt;
        for (int t = 0; t < nt; t += 2) {
            const bool last = (t == nt - 2);
            const char* a1 = cA + (size_t)(t + 1) * kstep;
            const char* a2 = last ? nA : cA + (size_t)(t + 2) * kstep; const char* b2 = last ? nB : cB + (size_t)(t + 2) * kstep;
            const char* a3 = a2 + kstep; const char* b3 = b2 + kstep;
            PG8_LDB(B0, 0, 0); PG8_LDB(B1, 0, 1); PG8_SCHED; PG8_LDA(At, 0, 0); PG8_STAGE(PG8_SA(1, 1), a1 + hstep, voff);
            PG8_WAIT_V(8); PG8_WAIT_L(0); PG8_BAR; PG8_MMA(0, 0, At, B0); PG8_MMA(0, 1, At, B1); PG8_BAR; PG8_SCHED;
            PG8_LDA(At, 0, 1); PG8_STAGE(PG8_SB(0, 0), b2, voff); PG8_STAGE(PG8_SB(0, 1), b2 + hstep, voff); PG8_STAGE(PG8_SA(0, 0), a2, voff);
            PG8_WAIT_V(8); PG8_WAIT_L(0); PG8_BAR; PG8_MMA(1, 0, At, B0); PG8_MMA(1, 1, At, B1); PG8_BAR; PG8_SCHED;
            PG8_LDB(B0, 1, 0); PG8_LDB(B1, 1, 1); PG8_SCHED; PG8_LDA(At, 1, 0); PG8_STAGE(PG8_SA(0, 1), a2 + hstep, voff);
            PG8_WAIT_V(8); PG8_WAIT_L(0); PG8_BAR; PG8_MMA(0, 0, At, B0); PG8_MMA(0, 1, At, B1); PG8_BAR; PG8_SCHED;
            PG8_LDA(At, 1, 1); PG8_STAGE(PG8_SB(1, 0), b3, voff); PG8_STAGE(PG8_SB(1, 1), b3 + hstep, voff); PG8_STAGE(PG8_SA(1, 0), a3, voff);
            PG8_WAIT_V(8); PG8_WAIT_L(0); PG8_BAR; PG8_MMA(1, 0, At, B0); PG8_MMA(1, 1, At, B1); PG8_BAR; PG8_SCHED;
        }
        if (wr == 0) PG8_BAR;
        if (!(Epi::FUSED && !has_next && E.fuse_last(cur))) E(acc, cur, wr, wc, fr, fq);
        if (!has_next) break;
#pragma unroll
        for (int a = 0; a < 2; ++a)
#pragma unroll
            for (int b = 0; b < 2; ++b)
#pragma unroll
                for (int m = 0; m < 4; ++m)
#pragma unroll
                    for (int n = 0; n < 2; ++n) acc[a][b][m][n] = (f32x4){0.f, 0.f, 0.f, 0.f};
        cur = nxt; cA = nA; cB = nB; ++ui;
        if (wr == 1) PG8_BAR;
    }
    PG8_WAIT_V(0);
    PG8_BAR;
    if constexpr (Epi::FUSED) { if (E.fuse_last(cur)) E.fused(acc, cur, wr, wc, fr, fq, lds, wid, lane); }
#undef PG8_SA
#undef PG8_SB
#undef PG8_STAGE
#undef PG8_LDA
#undef PG8_LDB
#undef PG8_MMA
#undef PG8_WAIT_V
#undef PG8_WAIT_L
#undef PG8_BAR
#undef PG8_SCHED
}
}
struct Ctx {
    const float* in[27]; float* out; unsigned char* ws;
    LAS unsigned char* lds; int tid, lane, wave, G, bid;
};
enum { I_X = 0, I_C, I_CTX, I_CCTX, I_WMOD, I_BMOD, I_LNG, I_LNB, I_FFNIN, I_FFNOUT, I_WIN, I_CONVW, I_CONVB, I_LWA, I_LBA, I_LWX, I_LBX, I_LLAM, I_SINK, I_QNORM, I_KVNORM, I_WUQ, I_WUKV, I_RDECAY, I_GNG, I_WBR, I_WOUT };
template <class T> __device__ __forceinline__ T* wsp(const Ctx& c, size_t off) { return (T*)(c.ws + off); }
__device__ __forceinline__ float* xrow_ptr(const Ctx& c, int row) { return row < NLAT ? c.out + (size_t)row * D : wsp<float>(c, WS_XC) + (size_t)(row - NLAT) * D; }
__device__ __forceinline__ const float* modp(const Ctx& c, int l, int r, int k) { return wsp<float>(c, WS_MODTAB) + ((size_t)(l * 9 + r) * 9 + k) * D; }

enum { MAP_NAT = 0, MAP_PERM32, MAP_SWIGLU, MAP_INP, MAP_GATE, MAP_UQ, MAP_UKV };
constexpr int IO_AX = 0, IO_AY = 512, IO_BQ = 1024, IO_BK = 1536, IO_BV = 1664, IO_CQ = 1792, IO_CKV = 2176, IO_CKR = 2432, IO_DQ = 2464, IO_DK = 2976, IO_DV = 3488, IO_DG = 4000, IO_GT = 4512;
enum { EK_PLAIN = 0, EK_GELU, EK_SILU, EK_ROPE16, EK_ROPE32, EK_ROPE32K, EK_VT, EK_CKR };
struct HalfTile { int kind, src, dstoff; };
__device__ __forceinline__ HalfTile inp_half(int pn, int bj) {
    const int h = pn * 2 + bj;
    switch (pn) {
        case 0: case 1:   return HalfTile{EK_PLAIN, IO_AX + 128 * h, 128 * h};
        case 2: case 3:   return HalfTile{EK_GELU, IO_AY + 128 * (h - 4), 128 * (h - 4)};
        case 4: case 5:   return HalfTile{EK_ROPE16, IO_BQ + 128 * (h - 8), 128 * (h - 8)};
        case 6:           return bj == 0 ? HalfTile{EK_ROPE16, IO_BK, 0} : HalfTile{EK_VT, IO_BV, 0};
        case 7:           return HalfTile{EK_PLAIN, IO_CQ + 128 * (h - 14), 128 * (h - 14)};
        case 8:           return bj == 0 ? HalfTile{EK_PLAIN, IO_CQ + 256, 256} : HalfTile{EK_CKR, IO_CKR, 0};
        case 9:           return HalfTile{EK_PLAIN, IO_CKV + 128 * (h - 18), 128 * (h - 18)};
        case 10: case 11: return HalfTile{EK_ROPE32, IO_DQ + 128 * (h - 20), 128 * (h - 20)};
        case 12: case 13: return HalfTile{EK_ROPE32K, IO_DK + 128 * (h - 24), 128 * (h - 24)};
        case 14: case 15: return HalfTile{EK_VT, IO_DV + 128 * (h - 28), 128 * (h - 28)};
        default:          return HalfTile{EK_SILU, IO_DG + 128 * (h - 32), 128 * (h - 32)};
    }
}
struct RowMap {
    int mode; const float* kscale; float cscale;
    __device__ __forceinline__ int col(int R, float& sc) const {
        sc = cscale;
        switch (mode) {
            case MAP_NAT: return R;
            case MAP_PERM32: return (R & ~31) + pg8::perm32(R & 31);
            case MAP_SWIGLU: { const int pn = R >> 8, cs = R & 255, bj = cs >> 7, wc = (cs >> 5) & 3, n = (cs >> 4) & 1, i = cs & 15;
                return (n ? FF : 0) + 128 * pn + 32 * wc + 8 * (i >> 2) + 4 * bj + (i & 3); }
            case MAP_GATE: return IO_GT + (R & ~31) + pg8::perm32(R & 31);
            case MAP_UQ: {
                const int g = R >> 5, h = g / 3, gi = g % 3, rho = R & 31, n = rho >> 4, i = rho & 15;
                if (gi < 2) return 96 * h + 32 * gi + pg8::perm32(rho);
                return 96 * h + 64 + 16 * (i >> 3) + 8 * n + (i & 7); }
            case MAP_UKV: {
                const int g = R >> 5, h = g >> 2, gi = g & 3, rho = R & 31;
                if (gi < 2) return 128 * h + 32 * gi + pg8::perm32(rho);
                return 128 * h + 32 * gi + rho; }
            default: {
                const int pn = R >> 8, cs = R & 255, bj = cs >> 7, c7 = cs & 127, wc = (cs >> 5) & 3, n = (cs >> 4) & 1, i = cs & 15;
                const HalfTile ht = inp_half(pn, bj);
                switch (ht.kind) {
                    case EK_PLAIN: case EK_GELU: case EK_SILU: return ht.src + 32 * wc + pg8::perm32(cs & 31);
                    case EK_ROPE16: if (ht.src != IO_BK) sc = 0.125f * LOG2E; return ht.src + c7;
                    case EK_VT: return ht.src + c7;
                    case EK_ROPE32: return ht.src + 64 * (wc >> 1) + 32 * n + 16 * (wc & 1) + i;
                    case EK_ROPE32K: sc = 0.08838834764831845f; return ht.src + 64 * (wc >> 1) + 32 * n + 16 * (wc & 1) + i;
                    default: return c7 < 32 ? ht.src + c7 : -1;
                }
            }
        }
    }
};
struct ConvPend { float vv[32]; bf16_t* WT; const float* kscale; int ldk, k0, n0, sc; float cs; bool valid; };
__device__ __forceinline__ void conv_pend_init(ConvPend& P) {
#pragma unroll
    for (int i = 0; i < 32; ++i) P.vv[i] = 0.f;
    P.WT = nullptr; P.kscale = nullptr; P.ldk = 0; P.k0 = 0; P.n0 = 0; P.sc = 0; P.cs = 0.f; P.valid = false;
}
__device__ __forceinline__ void conv_issue(ConvPend& N, const float* W, int ldw, bf16_t* WT, int ldk, int k0, int n0, const RowMap& mp, int lane) {
    float cs; const int sc = mp.col(n0 + (lane & 31), cs);
    const float* Wp = W + (size_t)(k0 + (lane >> 5)) * ldw + (sc >= 0 ? sc : 0);
#pragma unroll
    for (int i = 0; i < 32; ++i) N.vv[i] = Wp[(size_t)(2 * i) * ldw];
    N.WT = WT; N.kscale = mp.kscale; N.ldk = ldk; N.k0 = k0; N.n0 = n0; N.sc = sc; N.cs = cs; N.valid = true;
}
__device__ __forceinline__ void conv_finish(const ConvPend& P, LAS float* scr, int lane) {
#pragma unroll
    for (int i = 0; i < 32; ++i) { const int kk = 2 * i + (lane >> 5);
        float v = P.sc >= 0 ? P.vv[i] * P.cs : 0.f; if (P.kscale) v *= P.kscale[P.k0 + kk];
        scr[kk * 33 + (lane & 31)] = v; }
    asm volatile("s_waitcnt lgkmcnt(0)" ::: "memory");
    const int c = lane & 7;
#pragma unroll
    for (int j = 0; j < 4; ++j) { const int n = (lane >> 3) + 8 * j; const LAS float* s = scr + (8 * c) * 33 + n;
        u32x4 o; o.x = cvt_pk_bf16(s[0 * 33], s[1 * 33]); o.y = cvt_pk_bf16(s[2 * 33], s[3 * 33]); o.z = cvt_pk_bf16(s[4 * 33], s[5 * 33]); o.w = cvt_pk_bf16(s[6 * 33], s[7 * 33]);
        *(u32x4*)(P.WT + (size_t)(P.n0 + n) * P.ldk + P.k0 + 8 * c) = o; }
    asm volatile("s_waitcnt lgkmcnt(0)" ::: "memory");
}
struct ConvJob { const float* W; int ldw, K, N; bf16_t* WT; int ldk; RowMap mp; };
__device__ __forceinline__ void conv_job_run(const Ctx& c, const ConvJob& j, int& base, int gw, int NGW, LAS float* scr, ConvPend& P) {
    const int nkb = j.K / 64, nnb = j.N / 32, nblk = nkb * nnb;
    int first = gw - (base % NGW); if (first < 0) first += NGW;
    for (int b = first; b < nblk; b += NGW) { ConvPend N; conv_issue(N, j.W, j.ldw, j.WT, j.ldk, 64 * (b / nnb), 32 * (b % nnb), j.mp, c.lane); if (P.valid) conv_finish(P, scr, c.lane); P = N; }
    base += nblk;
}
__device__ __forceinline__ void conv_ffn(const Ctx& c, int l, int f, int slot, int& base, int gw, int NGW, LAS float* scr, ConvPend& P, int which = 3) {
    bf16_t* w1t = wsp<bf16_t>(c, WS_WF + slot * WF_SLOT); bf16_t* w2t = w1t + (size_t)5632 * 1024;
    if (which & 1) { ConvJob j1{c.in[I_FFNIN] + (size_t)(l * 2 + f) * 1024 * 5632, 5632, 1024, 5632, w1t, 1024, RowMap{MAP_SWIGLU, nullptr, 1.f}};
        conv_job_run(c, j1, base, gw, NGW, scr, P); }
    if (which & 2) { ConvJob j2{c.in[I_FFNOUT] + (size_t)(l * 2 + f) * FF * 1024, 1024, FF, 1024, w2t, FF, RowMap{MAP_NAT, nullptr, 1.f}};
        conv_job_run(c, j2, base, gw, NGW, scr, P); }
}
__device__ __forceinline__ void conv_mixer(const Ctx& c, int l, int& base, int gw, int NGW, LAS float* scr, ConvPend& P, int which = 3) {
    const float* win = c.in[I_WIN] + (size_t)l * 1024 * IN_COLS;
    if (which & 1) { ConvJob j{win, IN_COLS, 1024, NINP, wsp<bf16_t>(c, WM_INP), 1024, RowMap{MAP_INP, nullptr, 1.f}}; conv_job_run(c, j, base, gw, NGW, scr, P); }
    if (!(which & 2)) return;
    { ConvJob j{win, IN_COLS, 1024, 4096, wsp<bf16_t>(c, WM_G), 1024, RowMap{MAP_GATE, nullptr, 1.f}}; conv_job_run(c, j, base, gw, NGW, scr, P); }
    for (int k = 0; k < 4; ++k) {
        ConvJob j{c.in[I_WBR] + (size_t)(l * 4 + k) * 512 * 1024, 1024, 512, 1024, wsp<bf16_t>(c, WM_BR) + (size_t)(k >> 1) * 1024 * 1024 + 512 * (k & 1), 1024, RowMap{MAP_PERM32, nullptr, 1.f}}; conv_job_run(c, j, base, gw, NGW, scr, P); }
    { ConvJob j{c.in[I_WOUT] + (size_t)l * 1024 * 1024, 1024, 1024, 1024, wsp<bf16_t>(c, WM_OUT), 1024, RowMap{MAP_NAT, nullptr, 1.f}}; conv_job_run(c, j, base, gw, NGW, scr, P); }
    { ConvJob j{c.in[I_WUQ] + (size_t)l * 384 * 768, 768, 384, 768, wsp<bf16_t>(c, WM_UQ), 1024, RowMap{MAP_UQ, c.in[I_QNORM] + l * 384, 0.10206207261596577f * LOG2E}}; conv_job_run(c, j, base, gw, NGW, scr, P); }
    { ConvJob j{c.in[I_WUKV] + (size_t)l * 256 * 1024, 1024, 256, 1024, wsp<bf16_t>(c, WM_UKV), 256, RowMap{MAP_UKV, c.in[I_KVNORM] + l * 256, 1.f}}; conv_job_run(c, j, base, gw, NGW, scr, P); }
    for (int m = 0; m < 32; ++m) {
        const int dir = m >> 4, gate = (m >> 3) & 1, n = m & 7;
        const float* W = (gate ? c.in[I_LWX] : c.in[I_LWA]) + (size_t)(((l * 2 + dir) * 8 + n) * 64) * 64;
        ConvJob j{W, 64, 64, 64, wsp<bf16_t>(c, WM_LRU) + (size_t)m * 4096, 64, RowMap{MAP_NAT, nullptr, 1.f}}; conv_job_run(c, j, base, gw, NGW, scr, P);
    }
}

__device__ __forceinline__ void p0_modtab(const Ctx& c, int lsel) {
    LAS float* S = (LAS float*)c.lds;
    LAS float* R = (LAS float*)(c.lds + 9 * 1024 * 4);
    for (int i = c.tid; i < 9 * 1024; i += 512) { const int r = i >> 10, k = i & 1023; const float v = r < 8 ? c.in[I_C][r * 1024 + k] : c.in[I_CCTX][k]; S[i] = v / (1.0f + expf(-v)); }
    __syncthreads();
    for (int it = c.bid; it < 144; it += c.G) {
        const int l = lsel, cg_ = it, col = 64 * cg_ + c.lane;
        const float* W = c.in[I_WMOD] + (size_t)l * 1024 * 9216 + col;
        float acc[9];
#pragma unroll
        for (int r = 0; r < 9; ++r) acc[r] = 0.f;
        const int k0 = c.wave * 128;
        for (int kb = k0; kb < k0 + 128; kb += 16) {
            float w[16];
#pragma unroll
            for (int j = 0; j < 16; ++j) w[j] = W[(size_t)(kb + j) * 9216];
#pragma unroll
            for (int j = 0; j < 16; j += 4) {
                asm volatile("" ::: "memory");
#pragma unroll
                for (int r = 0; r < 9; ++r) { const f32x4 s = *(const LAS f32x4*)(S + r * 1024 + kb + j); acc[r] += s.x * w[j] + s.y * w[j + 1] + s.z * w[j + 2] + s.w * w[j + 3]; } }
        }
#pragma unroll
        for (int r = 0; r < 9; ++r) R[(c.wave * 9 + r) * 64 + c.lane] = acc[r];
        __syncthreads();
        for (int i = c.tid; i < 9 * 64; i += 512) { const int r = i >> 6, ln = i & 63; float s = 0.f;
#pragma unroll
            for (int w = 0; w < 8; ++w) s += R[(w * 9 + r) * 64 + ln];
            wsp<float>(c, WS_MODTAB)[(size_t)(l * 9 + r) * 9216 + 64 * cg_ + ln] = s + c.in[I_BMOD][l * 9216 + 64 * cg_ + ln]; }
        __syncthreads();
    }
}
__device__ __forceinline__ void p0_rope_tables(const Ctx& c) {
    if (c.bid != c.G - 1) return;
    for (int i = c.tid; i < 64 * 56; i += 512) {
        const int pos = i / 56, r = i % 56; int nf, f; float* tab;
        if (r < 8) { nf = 8; f = r; tab = wsp<float>(c, WS_CS8); } else if (r < 24) { nf = 16; f = r - 8; tab = wsp<float>(c, WS_CS16); } else { nf = 32; f = r - 24; tab = wsp<float>(c, WS_CS32); }
        const float inv = powf(10000.0f, -(float)f / (float)nf), ang = (float)pos * inv;
        tab[(pos * 2 + 0) * nf + f] = cosf(ang); tab[(pos * 2 + 1) * nf + f] = sinf(ang);
    }
}
__device__ __forceinline__ void p0_rows(const Ctx& c) {
    const int gw = c.bid * 8 + c.wave, NGW = c.G * 8;
    for (int row0 = gw; row0 < NT; row0 += 3 * NGW) {
        f32x4 v[3][4];
#pragma unroll
        for (int q = 0; q < 3; ++q) { const int row = row0 + q * NGW; if (row < NT) { const float* src = row < NLAT ? c.in[I_X] + (size_t)row * D : c.in[I_CTX] + (size_t)(row - NLAT) * D;
#pragma unroll
            for (int j = 0; j < 4; ++j) v[q][j] = *(const f32x4*)(src + 256 * j + 4 * c.lane); } }
#pragma unroll
        for (int q = 0; q < 3; ++q) { const int row = row0 + q * NGW; if (row < NT) { bf16_t* hr = wsp<bf16_t>(c, WS_H) + (size_t)row * D;
            const int r = row_mod(row); const float* sh = modp(c, 0, r, 0); const float* sc = modp(c, 0, r, 1);
#pragma unroll
            for (int j = 0; j < 4; ++j) { const int col = 256 * j + 4 * c.lane; const f32x4 s1 = *(const f32x4*)(sc + col), s0 = *(const f32x4*)(sh + col);
                const f32x4 h = v[q][j] * (s1 + 1.0f) + s0; u32x2 o; o.x = cvt_pk_bf16(h.x, h.y); o.y = cvt_pk_bf16(h.z, h.w); *(u32x2*)(hr + col) = o; } } }
    }
}
__device__ __forceinline__ void phase_normalize(const Ctx& c, int rbeg, int nrows, const float* g, const float* b, int ln, int ksh, int ksc, const float* slab = nullptr, int lg = 0, int kg = 0, float coef = 0.f, const float* xc0 = nullptr) {
    const int gw = c.bid * 8 + c.wave, NGW = c.G * 8;
    for (int row0 = rbeg + gw; row0 < nrows; row0 += 3 * NGW) {
        f32x4 v[3][4];
#pragma unroll
        for (int q = 0; q < 3; ++q) { const int row = row0 + q * NGW; if (row < nrows) { const float* xr = (xc0 && row >= NLAT) ? xc0 + (size_t)(row - NLAT) * D : xrow_ptr(c, row);
#pragma unroll
            for (int j = 0; j < 4; ++j) v[q][j] = *(const f32x4*)(xr + 256 * j + 4 * c.lane); } }
#pragma unroll
        for (int q = 0; q < 3; ++q) { const int row = row0 + q * NGW; if (row < nrows) {
            float* xr = xrow_ptr(c, row);
            if (slab && row >= NLAT) { const float* gp = modp(c, lg, 8, kg);
#pragma unroll
                for (int j = 0; j < 4; ++j) { const int col = 256 * j + 4 * c.lane; const float* sp = slab + (size_t)(row - NLAT) * D + col;
                    const f32x4 a = (*(const f32x4*)sp + *(const f32x4*)(sp + (size_t)NCTX * D)) + (*(const f32x4*)(sp + 2 * (size_t)NCTX * D) + *(const f32x4*)(sp + 3 * (size_t)NCTX * D));
                    v[q][j] = v[q][j] * DN_ALPHA + *(const f32x4*)(gp + col) * coef * a; } }
            float s = 0.f;
#pragma unroll
            for (int j = 0; j < 4; ++j) s += (v[q][j].x + v[q][j].y) + (v[q][j].z + v[q][j].w);
            const float mean = wave_sum(s) * (1.f / D); float s2 = 0.f;
#pragma unroll
            for (int j = 0; j < 4; ++j) { v[q][j] = v[q][j] - mean; s2 += (v[q][j].x * v[q][j].x + v[q][j].y * v[q][j].y) + (v[q][j].z * v[q][j].z + v[q][j].w * v[q][j].w); }
            const float rstd = 1.f / sqrtf(wave_sum(s2) * (1.f / D) + LN_EPS);
            const int r = row_mod(row);
#pragma unroll
            for (int j = 0; j < 4; ++j) { const int col = 256 * j + 4 * c.lane;
                const f32x4 y = v[q][j] * rstd * *(const f32x4*)(g + col) + *(const f32x4*)(b + col);
                *(f32x4*)(xr + col) = y;
                if (ln >= 0) { const f32x4 h = y * (*(const f32x4*)(modp(c, ln, r, ksc) + col) + 1.0f) + *(const f32x4*)(modp(c, ln, r, ksh) + col);
                    u32x2 o; o.x = cvt_pk_bf16(h.x, h.y); o.y = cvt_pk_bf16(h.z, h.w); *(u32x2*)(wsp<bf16_t>(c, WS_H) + (size_t)row * D + col) = o; } } } }
    }
}
typedef f32x4 Acc[2][2][4][2];
struct SchedTiles {
    pg8::TileOrder ord; const char* A; const char* B; int ld, nt;
    __device__ __forceinline__ bool next(int i, pg8::Unit& u) const {
        int pm, pn; if (!ord.tile(i, pm, pn)) return false;
        u.A = A + (size_t)pm * 256 * ld * 2; u.B = B + (size_t)pn * 256 * ld * 2; u.nt = nt; u.kind = 0; u.pm = pm; u.pn = pn; u.k = 0; return true;
    }
};
struct SchedUp {
    pg8::TileOrder ord; const char* A; const char* B; int ld, nt;
    __device__ __forceinline__ bool next(int i, pg8::Unit& u) const {
        int pm, pn;
        if (ord.G == 256 && ord.nM == 72) { const int x = ord.c & 7, t = i * 32 + (ord.c >> 3); if (t >= 198) return false;
            if (t < 176) { const int pmi = t & 7; pn = t >> 3; pm = pmi < 7 ? 8 * x + pmi : 64 + x; } else { pm = 8 * x + 7; pn = t - 176; } }
        else if (!ord.tile(i, pm, pn)) return false;
        u.A = A + (size_t)pm * 256 * ld * 2; u.B = B + (size_t)pn * 256 * ld * 2; u.nt = nt; u.kind = 0; u.pm = pm; u.pn = pn; u.k = 0; return true;
    }
};
struct SchedInpLast {
    pg8::TileOrder ord; const char* A; const char* B; int ld, nt;
    __device__ __forceinline__ bool next(int i, pg8::Unit& u) const {
        int pm, pn;
        if (!ord.tile(i, pm, pn)) { const long q = (long)i * ord.G + ord.c - ord.nwg; if (q < 0 || q >= 72) return false;
            const int j = (int)q % 9; pm = 64 + (int)q / 9; pn = j < 2 ? j : j == 2 ? 6 : j == 3 ? 8 : j == 4 ? 9 : 7 + j; }
        u.A = A + (size_t)pm * 256 * ld * 2; u.B = B + (size_t)pn * 256 * ld * 2; u.nt = nt; u.kind = 0; u.pm = pm; u.pn = pn; u.k = 0; return true;
    }
};
struct EpiKeep {
    static constexpr bool FUSED = false; __device__ __forceinline__ bool fuse_last(const pg8::Unit&) const { return false; }
    __device__ __forceinline__ void fused(Acc&, const pg8::Unit&, int, int, int, int, LAS unsigned char*, int, int) const {}
    __device__ __forceinline__ void operator()(const Acc& acc, const pg8::Unit& u, int wr, int wc, int fr, int fq) const {
#pragma unroll
        for (int ai = 0; ai < 2; ++ai)
#pragma unroll
            for (int bj = 0; bj < 2; ++bj)
#pragma unroll
                for (int m = 0; m < 4; ++m) { asm volatile("" :: "v"(acc[ai][bj][m][0]), "v"(acc[ai][bj][m][1])); }
    }
};
struct EpiSwiglu {
    static constexpr bool FUSED = false; __device__ __forceinline__ bool fuse_last(const pg8::Unit&) const { return false; }
    __device__ __forceinline__ void fused(Acc&, const pg8::Unit&, int, int, int, int, LAS unsigned char*, int, int) const {}
    bf16_t* U; unsigned* cnt;
    __device__ __forceinline__ void operator()(const Acc& acc, const pg8::Unit& u, int wr, int wc, int fr, int fq) const {
        const __amdgpu_buffer_rsrc_t rs = __builtin_amdgcn_make_buffer_rsrc(U, 0, NT * FF * 2, 0x00020000);
#pragma unroll
        for (int ai = 0; ai < 2; ++ai)
#pragma unroll
            for (int m = 0; m < 4; ++m) {
                const int row = u.pm * 256 + ai * 128 + wr * 64 + m * 16 + fr;
                float o[8];
#pragma unroll
                for (int bj = 0; bj < 2; ++bj)
#pragma unroll
                    for (int j = 0; j < 4; ++j) o[4 * bj + j] = siluf_(acc[ai][bj][m][0][j]) * acc[ai][bj][m][1][j];
                u32x4 w; w.x = cvt_pk_bf16(o[0], o[1]); w.y = cvt_pk_bf16(o[2], o[3]); w.z = cvt_pk_bf16(o[4], o[5]); w.w = cvt_pk_bf16(o[6], o[7]);
                if (cnt) __builtin_amdgcn_raw_buffer_store_b128(w, rs, (unsigned)((row * FF + 128 * u.pn + 32 * wc + 8 * fq) * 2), 0, 16);
                else *(u32x4*)(U + (size_t)row * FF + 128 * u.pn + 32 * wc + 8 * fq) = w;
            }
        if (cnt) { asm volatile("s_waitcnt vmcnt(0)" ::: "memory"); if ((fr | fq) == 0) __hip_atomic_fetch_add(cnt + u.pm * 16, 1u, __ATOMIC_RELAXED, __HIP_MEMORY_SCOPE_AGENT); }
    }
};
struct SchedResid {
    pg8::TileOrder ord; const char* A; const char* B; int ld, nt; bool ctx; const char* Actx; size_t partA; int kpart; bool late;
    __device__ __forceinline__ bool next(int i, pg8::Unit& u) const {
        int pm, pn;
        const int cq = (ord.c + (ord.G >> 1)) % ord.G;
        const int nq = (ctx && cq < 128) ? (128 - cq + ord.G - 1) / ord.G : 0;
        if (i >= nq) { if (!ord.tile(i - nq, pm, pn)) return false;
            if (late && ord.G == 256) { const int x = ord.c & 7, j = ord.c >> 3; if (j < 4) { pm = 8 * x + 7; pn = j; } else if ((j & 7) == 7) { pm = 8 * x + (j >> 3); pn = 0; } else { pm = 8 * x + (j & 7); pn = j >> 3; } }
            u.A = A + (size_t)pm * 256 * ld * 2; u.B = B + (size_t)pn * 256 * ld * 2; u.nt = nt; u.kind = 0; u.pm = pm; u.pn = pn; u.k = 0; return true; }
        const int q = i * ord.G + cq;
        const int unit = q >> 2, part = q & 3; pm = 64 + (unit >> 2); pn = unit & 3;
        u.pm = pm; u.pn = pn; u.kind = 1; u.k = part;
        if (kpart) { const int base = ((nt / 4) & ~1), rem = (nt - 4 * base) / 2, kt0 = part * base + 2 * (part < rem ? part : rem); u.nt = base + (part < rem ? 2 : 0);
            u.A = A + (size_t)pm * 256 * ld * 2 + (size_t)kt0 * 128; u.B = B + (size_t)pn * 256 * ld * 2 + (size_t)kt0 * 128; }
        else { u.nt = nt; u.A = Actx + (size_t)part * partA + (size_t)(pm - 64) * 256 * ld * 2; u.B = B + (size_t)pn * 256 * ld * 2; }
        return true;
    }
};
template <class Sched>
__device__ __forceinline__ void wait_panels(const Ctx& c, const Sched& S, const unsigned* cnt, unsigned target) {
    if (c.tid == 0) { pg8::Unit u;
        for (int i = 0; S.next(i, u); ++i) { unsigned spins = 0; while (__hip_atomic_load(cnt + u.pm * 16, __ATOMIC_RELAXED, __HIP_MEMORY_SCOPE_AGENT) < target) { __builtin_amdgcn_s_sleep(2); if (++spins > (1u << 22)) break; } }
        __builtin_amdgcn_fence(__ATOMIC_ACQUIRE, "agent"); asm volatile("s_waitcnt vmcnt(0)" ::: "memory"); }
    __syncthreads();
}
struct EpiResid {
    static constexpr bool FUSED = true;
    Ctx c; int l, kg; float coef; float* slab; const float* x0;
    bool fuse; const float* lng; const float* lnb; int ln, ksh, ksc; unsigned* cnt;
    __device__ __forceinline__ bool fuse_last(const pg8::Unit& u) const { return fuse && u.kind == 0; }
    __device__ __forceinline__ void operator()(const Acc& acc, const pg8::Unit& u, int wr, int wc, int fr, int fq) const {
        const int col0 = u.pn * 256 + wc * 32 + 4 * fq;
        if (u.kind == 1) {
#pragma unroll
            for (int ai = 0; ai < 2; ++ai)
#pragma unroll
                for (int m = 0; m < 4; ++m) { float* sr = slab + ((size_t)u.k * NCTX + (size_t)(u.pm - 64) * 256 + ai * 128 + wr * 64 + m * 16 + fr) * D + col0;
#pragma unroll
                    for (int bj = 0; bj < 2; ++bj)
#pragma unroll
                        for (int n = 0; n < 2; ++n) *(f32x4*)(sr + bj * 128 + n * 16) = acc[ai][bj][m][n]; }
            return;
        }
        const float* gate = modp(c, l, row_mod(u.pm * 256), kg);
        f32x4 gv[2][2];
#pragma unroll
        for (int bj = 0; bj < 2; ++bj)
#pragma unroll
            for (int n = 0; n < 2; ++n) gv[bj][n] = *(const f32x4*)(gate + col0 + bj * 128 + n * 16) * coef;
#pragma unroll
        for (int ai = 0; ai < 2; ++ai)
#pragma unroll
            for (int m = 0; m < 4; ++m) {
                const int row = u.pm * 256 + ai * 128 + wr * 64 + m * 16 + fr;
                float* xr = xrow_ptr(c, row) + col0; const float* xs = x0 ? x0 + (size_t)row * D + col0 : xr;
#pragma unroll
                for (int bj = 0; bj < 2; ++bj)
#pragma unroll
                    for (int n = 0; n < 2; ++n) { const f32x4 x = *(const f32x4*)(xs + bj * 128 + n * 16); *(f32x4*)(xr + bj * 128 + n * 16) = x * DN_ALPHA + gv[bj][n] * acc[ai][bj][m][n]; }
                if (m == 3) asm volatile("" ::: "memory");
            }
    }
    __device__ __forceinline__ void fused(Acc& acc, const pg8::Unit& u, int wr, int wc, int fr, int fq, LAS unsigned char* lds, int wid, int lane) const {
        const int col0 = u.pn * 256 + wc * 32 + 4 * fq;
        {   const float* gate = modp(c, l, row_mod(u.pm * 256), kg);
            f32x4 gv[2][2];
#pragma unroll
            for (int bj = 0; bj < 2; ++bj)
#pragma unroll
                for (int n = 0; n < 2; ++n) gv[bj][n] = *(const f32x4*)(gate + col0 + bj * 128 + n * 16) * coef;
#pragma unroll
            for (int ai = 0; ai < 2; ++ai)
#pragma unroll
                for (int m = 0; m < 4; ++m) {
                    const int row = u.pm * 256 + ai * 128 + wr * 64 + m * 16 + fr;
                    const float* xs = (x0 ? x0 : c.out) + (size_t)row * D + col0;
#pragma unroll
                    for (int bj = 0; bj < 2; ++bj)
#pragma unroll
                        for (int n = 0; n < 2; ++n) acc[ai][bj][m][n] = *(const f32x4*)(xs + bj * 128 + n * 16) * DN_ALPHA + gv[bj][n] * acc[ai][bj][m][n];
                    asm volatile("" : "+v"(acc[ai][0][m][0]), "+v"(acc[ai][0][m][1]), "+v"(acc[ai][1][m][0]), "+v"(acc[ai][1][m][1]));
                    if (m & 1) asm volatile("" ::: "memory");
                }
        }
        LAS f32x2* P = (LAS f32x2*)lds;
        LAS f32x2* S = (LAS f32x2*)(lds + 8192);
#pragma unroll
        for (int ai = 0; ai < 2; ++ai)
#pragma unroll
            for (int m = 0; m < 4; ++m) {
                float s = 0.f;
#pragma unroll
                for (int bj = 0; bj < 2; ++bj)
#pragma unroll
                    for (int n = 0; n < 2; ++n) { const f32x4 x = acc[ai][bj][m][n]; s += (x[0] + x[1]) + (x[2] + x[3]); }
                s = rows_sum(s);
                const float mw = s * (1.0f / 64.0f); float q = 0.f;
#pragma unroll
                for (int bj = 0; bj < 2; ++bj)
#pragma unroll
                    for (int n = 0; n < 2; ++n) { const f32x4 d = acc[ai][bj][m][n] - mw; q += (d[0] * d[0] + d[1] * d[1]) + (d[2] * d[2] + d[3] * d[3]); }
                q = rows_sum(q);
                if (fq == 0) P[(ai * 128 + wr * 64 + m * 16 + fr) * 4 + wc] = (f32x2){mw, q};
            }
        asm volatile("s_waitcnt lgkmcnt(0)" ::: "memory"); __builtin_amdgcn_s_barrier(); asm volatile("" ::: "memory");
        unsigned long long* xbuf = wsp<unsigned long long>(c, WS_XCH);
        const int prow = wid * 32 + (lane & 31);
        if (lane < 32) {
            const f32x2 a = P[prow * 4 + 0], b = P[prow * 4 + 1], cc = P[prow * 4 + 2], d = P[prow * 4 + 3];
            const float mt = (a.x + b.x + cc.x + d.x) * 0.25f;
            const float da = a.x - mt, db = b.x - mt, dc = cc.x - mt, dd = d.x - mt;
            const float m2 = (a.y + b.y) + (cc.y + d.y) + 64.0f * ((da * da + db * db) + (dc * dc + dd * dd));
            __hip_atomic_store(xbuf + ((size_t)(u.pm * 256 + prow) * 4 + u.pn), ((unsigned long long)__float_as_uint(m2) << 32) | __float_as_uint(mt), __ATOMIC_RELAXED, __HIP_MEMORY_SCOPE_AGENT);
        }
        asm volatile("s_waitcnt vmcnt(0)" ::: "memory");
        if (lane == 0) __hip_atomic_fetch_add(cnt + 64 * u.pm, 1u, __ATOMIC_RELAXED, __HIP_MEMORY_SCOPE_AGENT);
        if (wid == 0) {
            unsigned spins = 0;
            while ((unsigned)__builtin_amdgcn_readfirstlane(__hip_atomic_load(cnt + 64 * u.pm, __ATOMIC_RELAXED, __HIP_MEMORY_SCOPE_AGENT)) < 32u) { __builtin_amdgcn_s_sleep(2); if (++spins > (1u << 22)) break; }
        }
        asm volatile("s_waitcnt vmcnt(0) lgkmcnt(0)" ::: "memory"); __builtin_amdgcn_s_barrier(); asm volatile("" ::: "memory");
        if (lane < 32) {
            const unsigned long long* slot = xbuf + (size_t)(u.pm * 256 + prow) * 4; float mt[4], m2[4]; float ms = 0.f;
#pragma unroll
            for (int t = 0; t < 4; ++t) { const unsigned long long w = __hip_atomic_load(slot + t, __ATOMIC_RELAXED, __HIP_MEMORY_SCOPE_AGENT); mt[t] = __uint_as_float((unsigned)w); m2[t] = __uint_as_float((unsigned)(w >> 32)); ms += mt[t]; }
            const float mean = ms * 0.25f; float q = 0.f;
#pragma unroll
            for (int t = 0; t < 4; ++t) { const float dm = mt[t] - mean; q += m2[t] + 256.0f * dm * dm; }
            S[prow] = (f32x2){mean, 1.0f / sqrtf(q * (1.0f / 1024.0f) + LN_EPS)};
        }
        asm volatile("s_waitcnt lgkmcnt(0)" ::: "memory"); __builtin_amdgcn_s_barrier(); asm volatile("" ::: "memory");
        const int rm = row_mod(u.pm * 256);
#pragma unroll
        for (int bj = 0; bj < 2; ++bj) {
            const int colA = col0 + bj * 128, colB = colA + 16, hcol = u.pn * 256 + bj * 128 + wc * 32 + ((fq & 1) ? 16 : 0) + 8 * (fq >> 1);
            const f32x4 gg0 = *(const f32x4*)(lng + colA), bb0 = *(const f32x4*)(lnb + colA), gg1 = *(const f32x4*)(lng + colB), bb1 = *(const f32x4*)(lnb + colB);
            f32x4 sc0 = {1.f, 1.f, 1.f, 1.f}, sh0 = {0.f, 0.f, 0.f, 0.f}, sc1 = sc0, sh1 = sh0;
            if (ln >= 0) { sc0 = *(const f32x4*)(modp(c, ln, rm, ksc) + colA) + 1.0f; sh0 = *(const f32x4*)(modp(c, ln, rm, ksh) + colA); sc1 = *(const f32x4*)(modp(c, ln, rm, ksc) + colB) + 1.0f; sh1 = *(const f32x4*)(modp(c, ln, rm, ksh) + colB); }
#pragma unroll
            for (int ai = 0; ai < 2; ++ai)
#pragma unroll
                for (int m = 0; m < 4; ++m) { const int r = ai * 128 + wr * 64 + m * 16 + fr, row = u.pm * 256 + r; const f32x2 sr = S[r];
                    const f32x4 y0 = (acc[ai][bj][m][0] - sr.x) * sr.y * gg0 + bb0, y1 = (acc[ai][bj][m][1] - sr.x) * sr.y * gg1 + bb1;
                    *(f32x4*)(c.out + (size_t)row * D + colA) = y0; *(f32x4*)(c.out + (size_t)row * D + colB) = y1;
                    if (ln >= 0) { const f32x4 h0 = y0 * sc0 + sh0, h1 = y1 * sc1 + sh1; u32x2 oa, ob; oa.x = cvt_pk_bf16(h0.x, h0.y); oa.y = cvt_pk_bf16(h0.z, h0.w); ob.x = cvt_pk_bf16(h1.x, h1.y); ob.y = cvt_pk_bf16(h1.z, h1.w);
                        *(u32x4*)(wsp<bf16_t>(c, WS_H) + (size_t)row * D + hcol) = widen16(oa, ob); } }
        }
    }
};
struct RowInfo { int row, b, s, prow, pcol; bool lat; };
__device__ __forceinline__ RowInfo row_info(int row) {
    RowInfo r; r.row = row; r.lat = row < NLAT;
    if (r.lat) { const int t = row & 2047; r.b = row >> 11; r.s = CTX + t; r.prow = t >> 6; r.pcol = t & 63; }
    else { const int q = row - NLAT; r.b = q >> 8; r.s = q & 255; r.prow = 0; r.pcol = 0; }
    return r;
}
template <int CTRL> __device__ __forceinline__ float dpp_quad(float v) { return __int_as_float(__builtin_amdgcn_mov_dpp(__float_as_int(v), CTRL, 0xf, 0xf, true)); }
__device__ __forceinline__ void quad_transpose(f32x4& v, int q) {
    const bool b0 = (q & 1) != 0, b1 = (q & 2) != 0;
    { const float s = b0 ? v.x : v.y, r = dpp_quad<0xB1>(s); if (b0) v.x = r; else v.y = r; }
    { const float s = b0 ? v.z : v.w, r = dpp_quad<0xB1>(s); if (b0) v.z = r; else v.w = r; }
    { const float s = b1 ? v.x : v.z, r = dpp_quad<0x4E>(s); if (b1) v.x = r; else v.z = r; }
    { const float s = b1 ? v.y : v.w, r = dpp_quad<0x4E>(s); if (b1) v.y = r; else v.w = r; }
}
struct EpiInp {
    static constexpr bool FUSED = false; __device__ __forceinline__ bool fuse_last(const pg8::Unit&) const { return false; }
    __device__ __forceinline__ void fused(Acc&, const pg8::Unit&, int, int, int, int, LAS unsigned char*, int, int) const {}
    Ctx c;
    __device__ __forceinline__ void dst_of(int src, bf16_t*& dst, int& ld) const {
        if (src < IO_AY) { dst = wsp<bf16_t>(c, P_AX); ld = 512; }
        else if (src < IO_BQ) { dst = wsp<bf16_t>(c, P_AB); ld = 1024; }
        else if (src < IO_BK) { dst = wsp<bf16_t>(c, P_AB) + 512; ld = 1024; }
        else if (src < IO_BV) { dst = wsp<bf16_t>(c, P_BK); ld = 128; }
        else if (src < IO_CKV) { dst = wsp<bf16_t>(c, P_CD) + 512; ld = 1024; }
        else if (src < IO_CKR) { dst = wsp<bf16_t>(c, P_CKV); ld = 256; }
        else if (src < IO_DQ) { dst = wsp<bf16_t>(c, P_CKR); ld = 32; }
        else if (src < IO_DK) { dst = wsp<bf16_t>(c, P_DQ); ld = 512; }
        else if (src < IO_DV) { dst = wsp<bf16_t>(c, P_DK); ld = 512; }
        else { dst = wsp<bf16_t>(c, P_CD); ld = 1024; }
    }
    __device__ __forceinline__ void operator()(const Acc& acc, const pg8::Unit& u, int wr, int wc, int fr, int fq) const {
#pragma unroll
        for (int bj = 0; bj < 2; ++bj) {
            const HalfTile ht = inp_half(u.pn, bj);
            bf16_t* dst; int ld; dst_of(ht.src, dst, ld);
            const int dcol = ht.dstoff + 32 * wc + 8 * fq;
            if (ht.kind == EK_PLAIN || ht.kind == EK_GELU || ht.kind == EK_SILU) {
#pragma unroll
                for (int ai = 0; ai < 2; ++ai)
#pragma unroll
                    for (int m = 0; m < 4; ++m) {
                        const int row = u.pm * 256 + ai * 128 + wr * 64 + m * 16 + fr;
                        float o[8];
#pragma unroll
                        for (int j = 0; j < 4; ++j) { o[j] = acc[ai][bj][m][0][j]; o[4 + j] = acc[ai][bj][m][1][j]; }
                        if (ht.kind == EK_GELU) {
#pragma unroll
                            for (int j = 0; j < 8; ++j) o[j] = geluf_(o[j]); }
                        if (ht.kind == EK_SILU) {
#pragma unroll
                            for (int j = 0; j < 8; ++j) o[j] = siluf_(o[j]); }
                        u32x4 w; w.x = cvt_pk_bf16(o[0], o[1]); w.y = cvt_pk_bf16(o[2], o[3]); w.z = cvt_pk_bf16(o[4], o[5]); w.w = cvt_pk_bf16(o[6], o[7]);
                        *(u32x4*)(dst + (size_t)row * ld + dcol) = w;
                        if (ht.src >= IO_CQ && ht.src < IO_CKR) {
                            float ss = (bf_lo(w.x) * bf_lo(w.x) + bf_hi(w.x) * bf_hi(w.x)) + (bf_lo(w.y) * bf_lo(w.y) + bf_hi(w.y) * bf_hi(w.y)) + (bf_lo(w.z) * bf_lo(w.z) + bf_hi(w.z) * bf_hi(w.z)) + (bf_lo(w.w) * bf_lo(w.w) + bf_hi(w.w) * bf_hi(w.w));
                            ss = rows_sum(ss);
                            if (fq == 0) { if (ht.src < IO_CKV) wsp<float>(c, ST_CQ)[(size_t)row * 12 + ((ht.dstoff + 32 * wc) >> 5)] = ss; else wsp<float>(c, ST_CKV)[(size_t)row * 8 + ((ht.dstoff + 32 * wc) >> 5)] = ss; }
                        }
                    }
            } else if (ht.kind == EK_ROPE16 || ht.kind == EK_ROPE32 || ht.kind == EK_ROPE32K) {
                const bool r16 = ht.kind == EK_ROPE16;
                const int seg = r16 ? (wc & 1) : (wc >> 1), nf = r16 ? 16 : 32, f0 = r16 ? 4 * fq : 16 * (wc & 1) + 4 * fq;
                const float* tab = wsp<float>(c, r16 ? WS_CS16 : WS_CS32);
                const int head = (ht.dstoff >> 7);
#pragma unroll
                for (int ai = 0; ai < 2; ++ai)
#pragma unroll
                    for (int mp = 0; mp < 2; ++mp) {
                        f32x4 oa[2], ob[2]; int sblk = 0, bb = 0;
#pragma unroll
                        for (int mm = 0; mm < 2; ++mm) { const int m = 2 * mp + mm;
                            const RowInfo ri = row_info(u.pm * 256 + ai * 128 + wr * 64 + m * 16 + fr);
                            f32x4 x1 = acc[ai][bj][m][0], x2 = acc[ai][bj][m][1], o1 = x1, o2 = x2;
                            if (ri.lat) { const int pos = seg ? ri.pcol : ri.prow;
                                const f32x4 cs = *(const f32x4*)(tab + (pos * 2 + 0) * nf + f0), sn = *(const f32x4*)(tab + (pos * 2 + 1) * nf + f0);
                                o1 = x1 * cs - x2 * sn; o2 = x2 * cs + x1 * sn; }
                            u32x4 w; w.x = cvt_pk_bf16(o1.x, o1.y); w.y = cvt_pk_bf16(o1.z, o1.w); w.z = cvt_pk_bf16(o2.x, o2.y); w.w = cvt_pk_bf16(o2.z, o2.w);
                            *(u32x4*)(dst + (size_t)ri.row * ld + dcol) = w;
                            oa[mm] = o1; ob[mm] = o2; if (mm == 0) { sblk = ri.s & ~31; bb = ri.b; } }
                        if (ht.kind == EK_ROPE32K) {
                            const int q4 = fr & 3;
                            quad_transpose(oa[0], q4); quad_transpose(oa[1], q4); quad_transpose(ob[0], q4); quad_transpose(ob[1], q4);
                            bf16_t* kt = wsp<bf16_t>(c, KT_RET) + ((size_t)(bb * 4 + head) * 128 + 32 * wc + 8 * fq + q4) * SALL + sblk + 8 * (fr >> 2);
                            u32x4 wa; wa.x = cvt_pk_bf16(oa[0].x, oa[0].y); wa.y = cvt_pk_bf16(oa[0].z, oa[0].w); wa.z = cvt_pk_bf16(oa[1].x, oa[1].y); wa.w = cvt_pk_bf16(oa[1].z, oa[1].w);
                            u32x4 wb; wb.x = cvt_pk_bf16(ob[0].x, ob[0].y); wb.y = cvt_pk_bf16(ob[0].z, ob[0].w); wb.z = cvt_pk_bf16(ob[1].x, ob[1].y); wb.w = cvt_pk_bf16(ob[1].z, ob[1].w);
                            *(u32x4*)kt = wa; *(u32x4*)(kt + 4 * SALL) = wb;
                        }
                    }
            } else if (ht.kind == EK_VT) {
                const bool gq = ht.src == IO_BV; const int q4 = fr & 3;
#pragma unroll
                for (int ai = 0; ai < 2; ++ai)
#pragma unroll
                    for (int mp = 0; mp < 2; ++mp) {
                        const RowInfo ri = row_info(u.pm * 256 + ai * 128 + wr * 64 + mp * 32 + fr);
                        const int sp = (ri.s & ~31) + 8 * (fr >> 2);
#pragma unroll
                        for (int n = 0; n < 2; ++n) {
                            const int c7 = 32 * wc + 16 * n + 4 * fq + q4;
                            f32x4 t0 = acc[ai][bj][2 * mp][n], t1 = acc[ai][bj][2 * mp + 1][n]; quad_transpose(t0, q4); quad_transpose(t1, q4);
                            bf16_t* vt = gq ? wsp<bf16_t>(c, VT_GQA) + ((size_t)(ri.b * 2 + (c7 >> 6)) * 64 + (c7 & 63)) * SALL + sp
                                            : wsp<bf16_t>(c, VT_RET) + ((size_t)(ri.b * 4 + (ht.dstoff >> 7)) * 128 + c7) * SALL + sp;
                            u32x4 w; w.x = cvt_pk_bf16(t0.x, t0.y); w.y = cvt_pk_bf16(t0.z, t0.w); w.z = cvt_pk_bf16(t1.x, t1.y); w.w = cvt_pk_bf16(t1.z, t1.w);
                            *(u32x4*)vt = w;
                        }
                    }
            } else {
                if (wc == 0) {
#pragma unroll
                    for (int ai = 0; ai < 2; ++ai)
#pragma unroll
                        for (int m = 0; m < 4; ++m) {
                            const int row = u.pm * 256 + ai * 128 + wr * 64 + m * 16 + fr;
#pragma unroll
                            for (int n = 0; n < 2; ++n) { u32x2 w; w.x = cvt_pk_bf16(acc[ai][bj][m][n][0], acc[ai][bj][m][n][1]); w.y = cvt_pk_bf16(acc[ai][bj][m][n][2], acc[ai][bj][m][n][3]);
                                *(u32x2*)(dst + (size_t)row * 32 + 16 * n + 4 * fq) = w; }
                        }
                }
            }
        }
    }
};
struct SchedMerge {
    pg8::TileOrder ord; const char* H; const char* Wg; const char* Wb; const char* AB; const char* CD; int ld; bool ctx;
    __device__ __forceinline__ bool next(int i, pg8::Unit& u) const {
        int pm, pn, k, isP;
        if (ord.tile(i >> 3, pm, pn)) { k = (i >> 1) & 3; isP = i & 1; u.kind = isP; }
        else { if (!ctx) return false;
            const int R = (ord.nwg + ord.G - 1) / ord.G; const int j = i - 8 * R; if (j < 0) return false;
            const long q = (long)(j >> 1) * ord.G + ord.c; if (q >= 128) return false;
            const int unit = (int)q >> 2; k = (int)q & 3; pm = 64 + (unit >> 2); pn = unit & 3; isP = j & 1; u.kind = isP ? 2 : 0; }
        u.pm = pm; u.pn = pn; u.k = k;
        if (!isP) { u.A = H + (size_t)pm * 256 * 1024 * 2; u.B = Wg + (size_t)(k * 1024 + pn * 256) * 1024 * 2; u.nt = 16; }
        else { const char* bp = k == 0 ? AB : k == 1 ? AB + 1024 : k == 2 ? CD + 1024 : CD;
            u.A = bp + (size_t)pm * 256 * 1024 * 2; u.B = Wb + ((size_t)((k >> 1) * 1024 + pn * 256) * 1024 + 512 * (k & 1)) * 2; u.nt = 8; }
        return true;
    }
};
struct EpiMerge {
    static constexpr bool FUSED = false; __device__ __forceinline__ bool fuse_last(const pg8::Unit&) const { return false; }
    __device__ __forceinline__ void fused(Acc&, const pg8::Unit&, int, int, int, int, LAS unsigned char*, int, int) const {}
    GAS unsigned char* sig; GAS unsigned char* msum; GAS bf16_t* MG; GAS bf16_t* MGP;
    __device__ __forceinline__ void operator()(const Acc& acc, const pg8::Unit& u, int wr, int wc, int fr, int fq) const {
        const unsigned toff = (unsigned)((wr * 4 + wc) * 64 + fq * 16 + fr) * 16u;
        if (u.kind == 0) {
#pragma unroll
            for (int ai = 0; ai < 2; ++ai)
#pragma unroll
                for (int bj = 0; bj < 2; ++bj)
#pragma unroll
                    for (int m = 0; m < 4; ++m) {
                        const int q = (ai * 2 + bj) * 4 + m; const f32x4 a = acc[ai][bj][m][0], b = acc[ai][bj][m][1];
                        unsigned t2 = toff; asm volatile("" : "+v"(t2));
                        u32x4 w; w.x = cvt_pk_bf16(sigmoidf_(a.x), sigmoidf_(a.y)); w.y = cvt_pk_bf16(sigmoidf_(a.z), sigmoidf_(a.w)); w.z = cvt_pk_bf16(sigmoidf_(b.x), sigmoidf_(b.y)); w.w = cvt_pk_bf16(sigmoidf_(b.z), sigmoidf_(b.w));
                        *(GAS u32x4*)(sig + q * 8192 + t2) = w;
                    }
            return;
        }
#pragma unroll
        for (int g2 = 0; g2 < 8; ++g2) {
            const int g = g2 >> 1, ai = g >> 1, bj = g & 1, m0 = (g2 & 1) * 2;
            unsigned t2 = toff; asm volatile("" : "+v"(t2));
            u32x4 sw[2], mw[2];
#pragma unroll
            for (int mm = 0; mm < 2; ++mm) { const int q = g * 4 + m0 + mm; sw[mm] = *(const GAS u32x4*)(sig + q * 8192 + t2); if (u.kind == 1 && u.k > 0) mw[mm] = *(const GAS u32x4*)(msum + q * 8192 + t2); }
#pragma unroll
            for (int mm = 0; mm < 2; ++mm) { const int m = m0 + mm, q = g * 4 + m;
                f32x4 a = acc[ai][bj][m][0], b = acc[ai][bj][m][1];
                if (!((DBG >> (8 + u.k)) & 1)) { a = (f32x4){0.f, 0.f, 0.f, 0.f}; b = a; }
                a.x *= bf_lo(sw[mm].x); a.y *= bf_hi(sw[mm].x); a.z *= bf_lo(sw[mm].y); a.w *= bf_hi(sw[mm].y); b.x *= bf_lo(sw[mm].z); b.y *= bf_hi(sw[mm].z); b.z *= bf_lo(sw[mm].w); b.w *= bf_hi(sw[mm].w);
                const int row = (u.pm < 64 ? u.pm * 256 : (u.pm - 64) * 256) + ai * 128 + wr * 64 + m * 16 + fr, col = u.pn * 256 + bj * 128 + wc * 32 + 8 * fq;
                if (u.kind == 2) {
                    u32x4 o; o.x = cvt_pk_bf16(a.x, a.y); o.y = cvt_pk_bf16(a.z, a.w); o.z = cvt_pk_bf16(b.x, b.y); o.w = cvt_pk_bf16(b.z, b.w);
                    *(GAS u32x4*)(MGP + ((size_t)u.k * NCTX + row) * D + col) = o; continue; }
                if (u.k > 0) { a.x += bf_lo(mw[mm].x); a.y += bf_hi(mw[mm].x); a.z += bf_lo(mw[mm].y); a.w += bf_hi(mw[mm].y); b.x += bf_lo(mw[mm].z); b.y += bf_hi(mw[mm].z); b.z += bf_lo(mw[mm].w); b.w += bf_hi(mw[mm].w); }
                u32x4 o; o.x = cvt_pk_bf16(a.x, a.y); o.y = cvt_pk_bf16(a.z, a.w); o.z = cvt_pk_bf16(b.x, b.y); o.w = cvt_pk_bf16(b.z, b.w);
                if (u.k < 3) *(GAS u32x4*)(msum + q * 8192 + t2) = o;
                else *(GAS u32x4*)(MG + (size_t)row * D + col) = o;
            }
            asm volatile("" ::: "memory");
        }
    }
};
struct EpiMlaQ {
    static constexpr bool FUSED = false; __device__ __forceinline__ bool fuse_last(const pg8::Unit&) const { return false; }
    __device__ __forceinline__ void fused(Acc&, const pg8::Unit&, int, int, int, int, LAS unsigned char*, int, int) const {}
    Ctx c;
    __device__ __forceinline__ void operator()(const Acc& acc, const pg8::Unit& u, int wr, int wc, int fr, int fq) const {
        const float* tab = wsp<float>(c, WS_CS8);
#pragma unroll
        for (int ai = 0; ai < 2; ++ai)
#pragma unroll
            for (int m = 0; m < 4; ++m) {
                const RowInfo ri = row_info(u.pm * 256 + ai * 128 + wr * 64 + m * 16 + fr);
                const float* st = wsp<float>(c, ST_CQ) + (size_t)ri.row * 12;
                const f32x4 s0 = *(const f32x4*)st, s1 = *(const f32x4*)(st + 4), s2 = *(const f32x4*)(st + 8);
                const float rstd = 1.0f / sqrtf((((s0.x + s0.y) + (s0.z + s0.w)) + ((s1.x + s1.y) + (s1.z + s1.w)) + ((s2.x + s2.y) + (s2.z + s2.w))) * (1.0f / 384.0f) + LN_EPS);
                bf16_t* Q = wsp<bf16_t>(c, WS_QF) + (size_t)ri.row * 768;
#pragma unroll
                for (int bj = 0; bj < 2; ++bj) {
                    const int g = u.pn * 8 + bj * 4 + wc, h = g / 3, gi = g % 3;
                    const f32x4 a = acc[ai][bj][m][0] * rstd, b = acc[ai][bj][m][1] * rstd;
                    if (gi < 2) { u32x4 w; w.x = cvt_pk_bf16(a.x, a.y); w.y = cvt_pk_bf16(a.z, a.w); w.z = cvt_pk_bf16(b.x, b.y); w.w = cvt_pk_bf16(b.z, b.w);
                        *(u32x4*)(Q + 96 * h + 32 * gi + 8 * fq) = w; }
                    else { f32x4 o1 = a, o2 = b;
                        if (ri.lat) { const int pos = (fq >> 1) ? ri.pcol : ri.prow, e0 = 4 * (fq & 1);
                            const f32x4 cs = *(const f32x4*)(tab + (pos * 2 + 0) * 8 + e0), sn = *(const f32x4*)(tab + (pos * 2 + 1) * 8 + e0);
                            o1 = a * cs - b * sn; o2 = b * cs + a * sn; }
                        u32x2 w1, w2; w1.x = cvt_pk_bf16(o1.x, o1.y); w1.y = cvt_pk_bf16(o1.z, o1.w); w2.x = cvt_pk_bf16(o2.x, o2.y); w2.y = cvt_pk_bf16(o2.z, o2.w);
                        *(u32x4*)(Q + 96 * h + 64 + 16 * (fq & 1) + 8 * (fq >> 1)) = widen16(w1, w2); }
                }
            }
    }
};
struct EpiMlaKV {
    static constexpr bool FUSED = false; __device__ __forceinline__ bool fuse_last(const pg8::Unit&) const { return false; }
    __device__ __forceinline__ void fused(Acc&, const pg8::Unit&, int, int, int, int, LAS unsigned char*, int, int) const {}
    Ctx c;
    __device__ __forceinline__ void operator()(const Acc& acc, const pg8::Unit& u, int wr, int wc, int fr, int fq) const {
#pragma unroll
        for (int ai = 0; ai < 2; ++ai)
#pragma unroll
            for (int m = 0; m < 4; ++m) {
                const RowInfo ri = row_info(u.pm * 256 + ai * 128 + wr * 64 + m * 16 + fr);
                const float* st = wsp<float>(c, ST_CKV) + (size_t)ri.row * 8;
                const f32x4 s0 = *(const f32x4*)st, s1 = *(const f32x4*)(st + 4);
                const float rstd = 1.0f / sqrtf((((s0.x + s0.y) + (s0.z + s0.w)) + ((s1.x + s1.y) + (s1.z + s1.w))) * (1.0f / 256.0f) + LN_EPS);
                const int sp = (ri.s & ~31) + posperm(ri.s & 31);
#pragma unroll
                for (int bj = 0; bj < 2; ++bj) {
                    const int g = u.pn * 8 + bj * 4 + wc, h = g >> 2, gi = g & 3;
                    const f32x4 a = acc[ai][bj][m][0] * rstd, b = acc[ai][bj][m][1] * rstd;
                    if (gi < 2) { u32x4 w; w.x = cvt_pk_bf16(a.x, a.y); w.y = cvt_pk_bf16(a.z, a.w); w.z = cvt_pk_bf16(b.x, b.y); w.w = cvt_pk_bf16(b.z, b.w);
                        *(u32x4*)(wsp<bf16_t>(c, WS_KF) + ((size_t)(ri.b * 8 + h) * SALL + ri.s) * 96 + 32 * gi + 8 * fq) = w; }
                    else { bf16_t* vt = wsp<bf16_t>(c, WS_VTM) + ((size_t)(ri.b * 8 + h) * 64 + 32 * (gi - 2) + 4 * fq) * SALL + sp;
                        const unsigned w0 = cvt_pk_bf16(a.x, a.y), w1 = cvt_pk_bf16(a.z, a.w), w2 = cvt_pk_bf16(b.x, b.y), w3 = cvt_pk_bf16(b.z, b.w);
                        vt[0 * SALL] = (bf16_t)(w0 & 0xffff); vt[1 * SALL] = (bf16_t)(w0 >> 16); vt[2 * SALL] = (bf16_t)(w1 & 0xffff); vt[3 * SALL] = (bf16_t)(w1 >> 16);
                        vt[16 * SALL] = (bf16_t)(w2 & 0xffff); vt[17 * SALL] = (bf16_t)(w2 >> 16); vt[18 * SALL] = (bf16_t)(w3 & 0xffff); vt[19 * SALL] = (bf16_t)(w3 >> 16); }
                }
            }
    }
};
__device__ __forceinline__ f32x4 mfma16(bf16x8 a, bf16x8 b, f32x4 c) { return __builtin_amdgcn_mfma_f32_16x16x32_bf16(a, b, c, 0, 0, 0); }
__device__ __forceinline__ bf16x8 ldfrag(const bf16_t* p) { return *(const bf16x8*)p; }
__device__ __forceinline__ bf16x8 ldfrag_dev(const bf16_t* p) {
    const unsigned long long a = __hip_atomic_load((const unsigned long long*)p, __ATOMIC_RELAXED, __HIP_MEMORY_SCOPE_AGENT), b = __hip_atomic_load((const unsigned long long*)p + 1, __ATOMIC_RELAXED, __HIP_MEMORY_SCOPE_AGENT);
    u32x4 w; w.x = (unsigned)a; w.y = (unsigned)(a >> 32); w.z = (unsigned)b; w.w = (unsigned)(b >> 32); return __builtin_bit_cast(bf16x8, w);
}
__device__ __forceinline__ bf16x8 pack8(const f32x4 a, const f32x4 b) {
    u32x4 w; w.x = cvt_pk_bf16(a.x, a.y); w.y = cvt_pk_bf16(a.z, a.w); w.z = cvt_pk_bf16(b.x, b.y); w.w = cvt_pk_bf16(b.z, b.w); return __builtin_bit_cast(bf16x8, w);
}
__device__ __forceinline__ float sumsq8(bf16x8 v) { const u32x4 w = __builtin_bit_cast(u32x4, v); float s = 0.f;
    s += bf_lo(w.x) * bf_lo(w.x) + bf_hi(w.x) * bf_hi(w.x); s += bf_lo(w.y) * bf_lo(w.y) + bf_hi(w.y) * bf_hi(w.y);
    s += bf_lo(w.z) * bf_lo(w.z) + bf_hi(w.z) * bf_hi(w.z); s += bf_lo(w.w) * bf_lo(w.w) + bf_hi(w.w) * bf_hi(w.w); return s; }
__device__ __forceinline__ void st4bf(bf16_t* p, const f32x4 v) { u32x2 w; w.x = cvt_pk_bf16(v.x, v.y); w.y = cvt_pk_bf16(v.z, v.w); *(u32x2*)p = w; }

__device__ __forceinline__ void mla_kr_item(const Ctx& c, int it) {
    const int fr = c.lane & 15, fq = c.lane >> 4, row0 = 16 * it;
    const RowInfo ri = row_info(row0 + fr);
    const int seg = fq & 1, half = fq >> 1, pos = seg ? ri.pcol : ri.prow;
    const bf16_t* kr = wsp<bf16_t>(c, P_CKR) + (size_t)(row0 + fr) * 32 + 16 * seg;
    const u32x4 w1 = *(const u32x4*)kr, w2 = *(const u32x4*)(kr + 8);
    const float x1[8] = {bf_lo(w1.x), bf_hi(w1.x), bf_lo(w1.y), bf_hi(w1.y), bf_lo(w1.z), bf_hi(w1.z), bf_lo(w1.w), bf_hi(w1.w)};
    const float x2[8] = {bf_lo(w2.x), bf_hi(w2.x), bf_lo(w2.y), bf_hi(w2.y), bf_lo(w2.z), bf_hi(w2.z), bf_lo(w2.w), bf_hi(w2.w)};
    float o[8];
    const float* cp = wsp<float>(c, WS_CS8) + (pos * 2 + 0) * 8; const float* sp = cp + 8;
#pragma unroll
    for (int e = 0; e < 8; ++e) { const float cc = ri.lat ? cp[e] : 1.0f, sv = ri.lat ? sp[e] : 0.0f; o[e] = half == 0 ? x1[e] * cc - x2[e] * sv : x2[e] * cc + x1[e] * sv; }
    u32x4 krw; krw.x = cvt_pk_bf16(o[0], o[1]); krw.y = cvt_pk_bf16(o[2], o[3]); krw.z = cvt_pk_bf16(o[4], o[5]); krw.w = cvt_pk_bf16(o[6], o[7]);
#pragma unroll
    for (int h = 0; h < 8; ++h) *(u32x4*)(wsp<bf16_t>(c, WS_KF) + ((size_t)(ri.b * 8 + h) * SALL + ri.s) * 96 + 64 + 8 * fq) = krw;
}

template <int DQK, int NQT> struct AttnSt { f32x4 o[4][NQT]; float m[NQT], l[NQT]; bf16x8 q[NQT][DQK / 32]; };
template <int DQK, int NQT>
__device__ __forceinline__ void attn_init(AttnSt<DQK, NQT>& st, const bf16_t* Q, int ldq, float m0, float l0, int fr, int fq) {
#pragma unroll
    for (int qt = 0; qt < NQT; ++qt) { st.m[qt] = m0; st.l[qt] = l0;
#pragma unroll
        for (int ks = 0; ks < DQK / 32; ++ks) st.q[qt][ks] = ldfrag(Q + (size_t)(16 * qt + fr) * ldq + 32 * ks + 8 * fq);
#pragma unroll
        for (int d = 0; d < 4; ++d) st.o[d][qt] = (f32x4){0.f, 0.f, 0.f, 0.f}; }
}
template <int DQK, int NQT, bool MASK>
__device__ __forceinline__ void attn_steps(AttnSt<DQK, NQT>& st, const bf16_t* Kp, int ldk, const bf16_t* VTp, int nsteps, int qpos0, int kpos0, int fr, int fq) {
    for (int stp = 0; stp < nsteps; ++stp) {
        f32x4 s[2][NQT];
#pragma unroll
        for (int kt = 0; kt < 2; ++kt) {
            bf16x8 kf[DQK / 32];
#pragma unroll
            for (int ks = 0; ks < DQK / 32; ++ks) kf[ks] = ldfrag(Kp + (size_t)(32 * stp + 16 * kt + fr) * ldk + 32 * ks + 8 * fq);
#pragma unroll
            for (int qt = 0; qt < NQT; ++qt) { s[kt][qt] = (f32x4){0.f, 0.f, 0.f, 0.f};
#pragma unroll
                for (int ks = 0; ks < DQK / 32; ++ks) s[kt][qt] = mfma16(kf[ks], st.q[qt][ks], s[kt][qt]); }
        }
        bf16x8 vf[4];
#pragma unroll
        for (int d = 0; d < 4; ++d) vf[d] = ldfrag(VTp + (size_t)(16 * d + fr) * SALL + 32 * stp + 8 * fq);
#pragma unroll
        for (int qt = 0; qt < NQT; ++qt) {
            if (MASK) { const int qp = qpos0 + 16 * qt + fr;
#pragma unroll
                for (int kt = 0; kt < 2; ++kt)
#pragma unroll
                    for (int r = 0; r < 4; ++r) { const int dd = qp - (kpos0 + 32 * stp + 16 * kt + 4 * fq + r); if (dd > 128 || dd < -128) s[kt][qt][r] = -1e30f; } }
            float mx = fmaxf(fmaxf(fmaxf(s[0][qt].x, s[0][qt].y), fmaxf(s[0][qt].z, s[0][qt].w)), fmaxf(fmaxf(s[1][qt].x, s[1][qt].y), fmaxf(s[1][qt].z, s[1][qt].w)));
            mx = rows_max(mx);
            const float mn = fmaxf(st.m[qt], mx), alpha = fast_exp2(st.m[qt] - mn); st.m[qt] = mn;
            float ps = 0.f;
#pragma unroll
            for (int kt = 0; kt < 2; ++kt)
#pragma unroll
                for (int r = 0; r < 4; ++r) { float p = fast_exp2(s[kt][qt][r] - mn); if (MASK) p = s[kt][qt][r] < -1e29f ? 0.f : p; s[kt][qt][r] = p; ps += p; }
            st.l[qt] = st.l[qt] * alpha + ps;
            const bf16x8 pk = pack8(s[0][qt], s[1][qt]);
#pragma unroll
            for (int d = 0; d < 4; ++d) st.o[d][qt] = mfma16(vf[d], pk, st.o[d][qt] * alpha);
        }
    }
}
template <int DQK, int NQT>
__device__ __forceinline__ void attn_store(AttnSt<DQK, NQT>& st, bf16_t* O, int ldo, int fr, int fq, bool dry = false) {
#pragma unroll
    for (int qt = 0; qt < NQT; ++qt) { const float l = rows_sum(st.l[qt]); const float inv = 1.0f / l;
#pragma unroll
        for (int d = 0; d < 4; d += 2) {
            const f32x4 va = st.o[d][qt] * inv, vb = st.o[d + 1][qt] * inv; u32x2 a, b; a.x = cvt_pk_bf16(va.x, va.y); a.y = cvt_pk_bf16(va.z, va.w); b.x = cvt_pk_bf16(vb.x, vb.y); b.y = cvt_pk_bf16(vb.z, vb.w);
            const u32x4 w = widen16(a, b);
            if (!dry) *(u32x4*)(O + (size_t)(16 * qt + fr) * ldo + 16 * (d + (fq & 1)) + 8 * (fq >> 1)) = w; } }
}
__device__ __forceinline__ void gqa_item(const Ctx& c, int l, int it, bool dry = false) {
    const int fr = c.lane & 15, fq = c.lane >> 4;
    const bool lat = it < 2048; int b, hq, tg;
    if (lat) { b = it >> 8; hq = (it >> 5) & 7; tg = it & 31; } else { const int j = it - 2048; b = j >> 5; hq = (j >> 2) & 7; tg = j & 3; }
    const int kvh = hq >> 2, row0 = lat ? b * SEQ + 64 * tg : NLAT + b * CTX + 64 * tg;
    bf16_t* Q = wsp<bf16_t>(c, P_AB) + 512 + (size_t)row0 * 1024 + hq * 64;
    const bf16_t* Kall = wsp<bf16_t>(c, P_BK) + kvh * 64;
    const bf16_t* VT = wsp<bf16_t>(c, VT_GQA) + (size_t)((b * 2 + kvh) * 64) * SALL;
    AttnSt<64, 4> st;
    attn_init<64, 4>(st, Q, 1024, c.in[I_SINK][l * 8 + hq] * LOG2E, fq == 0 ? 1.0f : 0.0f, fr, fq);
    if (lat) { const int tlo = 64 * tg - 128 < 0 ? 0 : 64 * tg - 128, thi = 64 * tg + 192 > SEQ ? SEQ : 64 * tg + 192;
        attn_steps<64, 4, true>(st, Kall + (size_t)(b * SEQ + tlo) * 128, 128, VT + CTX + tlo, (thi - tlo) >> 5, 64 * tg, tlo, fr, fq); }
    attn_steps<64, 4, false>(st, Kall + (size_t)(NLAT + b * CTX) * 128, 128, VT, 8, 0, 0, fr, fq);
    attn_store<64, 4>(st, Q, 1024, fr, fq, dry);
}
__device__ __forceinline__ void mla_item(const Ctx& c, int it) {
    const int fr = c.lane & 15, fq = c.lane >> 4;
    const bool lat = it < 2048; int b, h, tg;
    if (lat) { b = it >> 8; h = (it >> 5) & 7; tg = it & 31; } else { const int j = it - 2048; b = j >> 5; h = (j >> 2) & 7; tg = j & 3; }
    const int row0 = lat ? b * SEQ + 64 * tg : NLAT + b * CTX + 64 * tg;
    AttnSt<96, 4> st;
    attn_init<96, 4>(st, wsp<bf16_t>(c, WS_QF) + (size_t)row0 * 768 + h * 96, 768, -1e30f, 0.0f, fr, fq);
    attn_steps<96, 4, false>(st, wsp<bf16_t>(c, WS_KF) + (size_t)((b * 8 + h) * SALL) * 96, 96, wsp<bf16_t>(c, WS_VTM) + (size_t)((b * 8 + h) * 64) * SALL, lat ? SALL / 32 : CTX / 32, 0, 0, fr, fq);
    attn_store<96, 4>(st, wsp<bf16_t>(c, P_CD) + 512 + (size_t)row0 * 1024 + h * 64, 1024, fr, fq);
}

template <int DQK> struct AttnLds { static constexpr int KROW = DQK * 2 + 16, VROW = 64 * 2 + 16, KBYTES = 64 * KROW, BUF = KBYTES + 64 * VROW, KCH = DQK / 8; };
template <int DQK> struct TileRegs { u32x4 k0, k1, v; };
template <int DQK>
__device__ __forceinline__ void tile_gload(TileRegs<DQK>& r, const bf16_t* Kp, int ldk, const bf16_t* VTp, int tid) {
    constexpr int KCH = AttnLds<DQK>::KCH;
    { const int key = tid / KCH, part = tid % KCH; r.k0 = *(const u32x4*)(Kp + (size_t)key * ldk + part * 8); }
    if (DQK == 96) { const int cidx = tid + 512; if (cidx < 64 * KCH) { const int key = cidx / KCH, part = cidx % KCH; r.k1 = *(const u32x4*)(Kp + (size_t)key * ldk + part * 8); } }
    { const int dv = tid >> 3, part = tid & 7; r.v = *(const u32x4*)(VTp + (size_t)dv * SALL + part * 8); }
}
template <int DQK>
__device__ __forceinline__ void tile_swrite(const TileRegs<DQK>& r, LAS unsigned char* buf, int tid) {
    constexpr int KCH = AttnLds<DQK>::KCH, KROW = AttnLds<DQK>::KROW, VROW = AttnLds<DQK>::VROW;
    { const int key = tid / KCH, part = tid % KCH; *(LAS u32x4*)(buf + key * KROW + part * 16) = r.k0; }
    if (DQK == 96) { const int cidx = tid + 512; if (cidx < 64 * KCH) { const int key = cidx / KCH, part = cidx % KCH; *(LAS u32x4*)(buf + key * KROW + part * 16) = r.k1; } }
    { const int dv = tid >> 3, part = tid & 7; *(LAS u32x4*)(buf + AttnLds<DQK>::KBYTES + dv * VROW + part * 16) = r.v; }
}
template <int DQK, int NQT, bool MASK, int VAR = 0>
__device__ __forceinline__ void attn_tile(AttnSt<DQK, NQT>& st, const LAS unsigned char* buf, int qpos0, int kpos0, int fr, int fq) {
    constexpr int KROW = AttnLds<DQK>::KROW, VROW = AttnLds<DQK>::VROW;
#pragma unroll
    for (int stp = 0; stp < 2; ++stp) {
        f32x4 s[2][NQT];
#pragma unroll
        for (int kt = 0; kt < 2; ++kt) {
            bf16x8 kf[DQK / 32];
#pragma unroll
            for (int ks = 0; ks < DQK / 32; ++ks) kf[ks] = *(const LAS bf16x8*)(buf + (32 * stp + 16 * kt + fr) * KROW + ks * 64 + fq * 16);
#pragma unroll
            for (int qt = 0; qt < NQT; ++qt) { s[kt][qt] = (f32x4){0.f, 0.f, 0.f, 0.f};
#pragma unroll
                for (int ks = 0; ks < DQK / 32; ++ks) s[kt][qt] = mfma16(kf[ks], st.q[qt][ks], s[kt][qt]); }
        }
        bf16x8 vf[4];
#pragma unroll
        for (int d = 0; d < 4; ++d) vf[d] = *(const LAS bf16x8*)(buf + AttnLds<DQK>::KBYTES + (16 * d + fr) * VROW + stp * 64 + fq * 16);
#pragma unroll
        for (int qt = 0; qt < NQT; ++qt) {
            if (MASK) { const int qp = qpos0 + 16 * qt + fr;
#pragma unroll
                for (int kt = 0; kt < 2; ++kt)
#pragma unroll
                    for (int r = 0; r < 4; ++r) { const int dd = qp - (kpos0 + 32 * stp + 16 * kt + 4 * fq + r); if (dd > 128 || dd < -128) s[kt][qt][r] = -1e30f; } }
            float mx = fmaxf(fmaxf(fmaxf(s[0][qt].x, s[0][qt].y), fmaxf(s[0][qt].z, s[0][qt].w)), fmaxf(fmaxf(s[1][qt].x, s[1][qt].y), fmaxf(s[1][qt].z, s[1][qt].w)));
            if (VAR != 1) { mx = rows_max(mx); }
            const float mn = fmaxf(st.m[qt], mx), alpha = fast_exp2(st.m[qt] - mn); st.m[qt] = mn;
            float ps = 0.f;
#pragma unroll
            for (int kt = 0; kt < 2; ++kt)
#pragma unroll
                for (int r = 0; r < 4; ++r) { float p = VAR == 2 ? s[kt][qt][r] - mn : fast_exp2(s[kt][qt][r] - mn); if (MASK) p = s[kt][qt][r] < -1e29f ? 0.f : p; s[kt][qt][r] = p; ps += p; }
            st.l[qt] = st.l[qt] * alpha + ps;
            const bf16x8 pk = pack8(s[0][qt], s[1][qt]);
#pragma unroll
            for (int d = 0; d < 4; ++d) st.o[d][qt] = mfma16(vf[d], pk, VAR == 3 ? st.o[d][qt] : st.o[d][qt] * alpha);
        }
    }
}
template <int DQK, int NQT, bool MASK>
__device__ __forceinline__ void attn_tile64(AttnSt<DQK, NQT>& st, const LAS unsigned char* buf, int qpos0, int kpos0, int fr, int fq) {
    constexpr int KROW = AttnLds<DQK>::KROW, VROW = AttnLds<DQK>::VROW;
    f32x4 s[4][NQT];
#pragma unroll
    for (int kt = 0; kt < 4; ++kt) {
        bf16x8 kf[DQK / 32];
#pragma unroll
        for (int ks = 0; ks < DQK / 32; ++ks) kf[ks] = *(const LAS bf16x8*)(buf + (16 * kt + fr) * KROW + ks * 64 + fq * 16);
#pragma unroll
        for (int qt = 0; qt < NQT; ++qt) { s[kt][qt] = (f32x4){0.f, 0.f, 0.f, 0.f};
#pragma unroll
            for (int ks = 0; ks < DQK / 32; ++ks) s[kt][qt] = mfma16(kf[ks], st.q[qt][ks], s[kt][qt]); }
    }
    bf16x8 pk[2][NQT];
#pragma unroll
    for (int qt = 0; qt < NQT; ++qt) {
        if (MASK) { const int qp = qpos0 + 16 * qt + fr;
#pragma unroll
            for (int kt = 0; kt < 4; ++kt)
#pragma unroll
                for (int r = 0; r < 4; ++r) { const int dd = qp - (kpos0 + 16 * kt + 4 * fq + r); if (dd > 128 || dd < -128) s[kt][qt][r] = -1e30f; } }
        float mx = fmaxf(fmaxf(fmaxf(s[0][qt].x, s[0][qt].y), fmaxf(s[0][qt].z, s[0][qt].w)), fmaxf(fmaxf(s[1][qt].x, s[1][qt].y), fmaxf(s[1][qt].z, s[1][qt].w)));
        mx = fmaxf(mx, fmaxf(fmaxf(fmaxf(s[2][qt].x, s[2][qt].y), fmaxf(s[2][qt].z, s[2][qt].w)), fmaxf(fmaxf(s[3][qt].x, s[3][qt].y), fmaxf(s[3][qt].z, s[3][qt].w))));
        mx = rows_max(mx);
        const float mn = fmaxf(st.m[qt], mx), alpha = fast_exp2(st.m[qt] - mn); st.m[qt] = mn;
        float ps = 0.f;
#pragma unroll
        for (int kt = 0; kt < 4; ++kt)
#pragma unroll
            for (int r = 0; r < 4; ++r) { float p = fast_exp2(s[kt][qt][r] - mn); if (MASK) p = s[kt][qt][r] < -1e29f ? 0.f : p; s[kt][qt][r] = p; ps += p; }
        st.l[qt] = st.l[qt] * alpha + ps;
        pk[0][qt] = pack8(s[0][qt], s[1][qt]); pk[1][qt] = pack8(s[2][qt], s[3][qt]);
#pragma unroll
        for (int d = 0; d < 4; ++d) st.o[d][qt] = st.o[d][qt] * alpha;
    }
#pragma unroll
    for (int stp = 0; stp < 2; ++stp) {
        bf16x8 vf[4];
#pragma unroll
        for (int d = 0; d < 4; ++d) vf[d] = *(const LAS bf16x8*)(buf + AttnLds<DQK>::KBYTES + (16 * d + fr) * VROW + stp * 64 + fq * 16);
#pragma unroll
        for (int qt = 0; qt < NQT; ++qt)
#pragma unroll
            for (int d = 0; d < 4; ++d) st.o[d][qt] = mfma16(vf[d], pk[stp][qt], st.o[d][qt]);
    }
}
#define ATT_STEP(DQK, t, R, COMPUTE, KP, LDK, VP) do { \
        COMPUTE; \
        if ((t) + 1 < ntile) tile_swrite<DQK>(R, c.lds + (((t) + 1) & 1) * L::BUF, c.tid); \
        __syncthreads(); \
        if ((t) + 3 < ntile) tile_gload<DQK>(R, KP((t) + 3), LDK, VP((t) + 3), c.tid); } while (0)
template <int VAR = 0> __device__ __forceinline__ void mla_block_item(const Ctx& c, int it, bool dry = false) {
    const int fr = c.lane & 15, fq = c.lane >> 4, b = it >> 6, h = (it >> 3) & 7, qg = it & 7, row0 = b * SEQ + 256 * qg + 32 * c.wave;
    typedef AttnLds<96> L;
    const bf16_t* Kp = wsp<bf16_t>(c, WS_KF) + (size_t)((b * 8 + h) * SALL) * 96; const bf16_t* VTp = wsp<bf16_t>(c, WS_VTM) + (size_t)((b * 8 + h) * 64) * SALL;
    AttnSt<96, 2> st;
    attn_init<96, 2>(st, wsp<bf16_t>(c, WS_QF) + (size_t)row0 * 768 + h * 96, 768, -1e30f, 0.0f, fr, fq);
    constexpr int ntile = SALL / 64;
    TileRegs<96> r0;
    tile_gload<96>(r0, Kp, 96, VTp, c.tid); tile_swrite<96>(r0, c.lds, c.tid);
    __syncthreads();
    for (int t = 0; t < ntile; ++t) {
        if (t + 1 < ntile) tile_gload<96>(r0, Kp + (size_t)(64 * (t + 1)) * 96, 96, VTp + 64 * (t + 1), c.tid);
        attn_tile64<96, 2, false>(st, c.lds + (t & 1) * L::BUF, 0, 0, fr, fq);
        if (t + 1 < ntile) tile_swrite<96>(r0, c.lds + ((t + 1) & 1) * L::BUF, c.tid);
        __syncthreads();
    }
    attn_store<96, 2>(st, wsp<bf16_t>(c, P_CD) + 512 + (size_t)row0 * 1024 + h * 64, 1024, fr, fq, dry);
}
constexpr int MD_KAREA = 16384, MD_BUF = MD_KAREA + 8192;
__device__ __forceinline__ void mla_dma_issue(LAS unsigned char* buf, const bf16_t* Kt, const bf16_t* VTt, unsigned oK0, unsigned oK1, unsigned oV, int wave) {
    __builtin_amdgcn_global_load_lds((const unsigned*)((const char*)Kt + oK0), (LAS unsigned*)(buf + wave * 1024), 16, 0, 0);
    __builtin_amdgcn_global_load_lds((const unsigned*)((const char*)Kt + oK1), (LAS unsigned*)(buf + (wave + 8) * 1024), 16, 0, 0);
    __builtin_amdgcn_global_load_lds((const unsigned*)((const char*)VTt + oV), (LAS unsigned*)(buf + MD_KAREA + wave * 1024), 16, 0, 0);
}
constexpr float LAZY_TAU = 8.0f;
__device__ __forceinline__ int imax3(int a, int b, int c) { return max(max(a, b), c); }
__device__ __forceinline__ int imax9(int c, const f32x4& a, const f32x4& b) {
    return imax3(imax3(c, __float_as_int(a.x), __float_as_int(a.y)), imax3(__float_as_int(a.z), __float_as_int(a.w), __float_as_int(b.x)), imax3(__float_as_int(b.y), __float_as_int(b.z), __float_as_int(b.w)));
}
__device__ __forceinline__ void mla_dma_tile(AttnSt<96, 4>& st, f32x4 (&nm)[4], const LAS unsigned char* buf, int fr, int fq, bool first) {
    const int kx = (fr >> 2) & 3, vx = (fr >> 1) & 7;
#pragma unroll 1
    for (int stp = 0; stp < 2; ++stp) {
        f32x4 s[2][4];
#pragma unroll
        for (int kt = 0; kt < 2; ++kt) {
            bf16x8 kf[3];
#pragma unroll
            for (int ks = 0; ks < 3; ++ks) kf[ks] = *(const LAS bf16x8*)(buf + (32 * stp + 16 * kt + fr) * 192 + (4 * ks + (fq ^ kx)) * 16);
#pragma unroll
            for (int qt = 0; qt < 4; ++qt) { s[kt][qt] = mfma16(kf[0], st.q[qt][0], nm[qt]); s[kt][qt] = mfma16(kf[1], st.q[qt][1], s[kt][qt]); s[kt][qt] = mfma16(kf[2], st.q[qt][2], s[kt][qt]); }
        }
        int chk = 0;
#pragma unroll
        for (int qt = 0; qt < 4; ++qt) chk = imax9(chk, s[0][qt], s[1][qt]);
        const bool f0 = first && stp == 0;
        if (f0 || __builtin_amdgcn_ballot_w64(chk > __float_as_int(LAZY_TAU)) != 0ull) {
#pragma unroll
            for (int qt = 0; qt < 4; ++qt) {
                float mx = fmaxf(fmaxf(fmaxf(s[0][qt].x, s[0][qt].y), fmaxf(s[0][qt].z, s[0][qt].w)), fmaxf(fmaxf(s[1][qt].x, s[1][qt].y), fmaxf(s[1][qt].z, s[1][qt].w)));
                mx = rows_max(mx);
                const float dlt = f0 ? mx : fmaxf(mx, 0.f), alpha = f0 ? 1.0f : fast_exp2(-dlt);
                nm[qt] -= dlt; s[0][qt] -= dlt; s[1][qt] -= dlt; st.l[qt] *= alpha;
#pragma unroll
                for (int d = 0; d < 4; ++d) st.o[d][qt] *= alpha;
            }
        }
        bf16x8 vf[4];
#pragma unroll
        for (int d = 0; d < 4; ++d) vf[d] = *(const LAS bf16x8*)(buf + MD_KAREA + (16 * d + fr) * 128 + ((4 * stp + fq) ^ vx) * 16);
#pragma unroll
        for (int qt = 0; qt < 4; ++qt) {
            float ps = 0.f;
#pragma unroll
            for (int kt = 0; kt < 2; ++kt)
#pragma unroll
                for (int r = 0; r < 4; ++r) { const float p = fast_exp2(s[kt][qt][r]); s[kt][qt][r] = p; ps += p; }
            st.l[qt] += ps;
            const bf16x8 pk = pack8(s[0][qt], s[1][qt]);
#pragma unroll
            for (int d = 0; d < 4; ++d) st.o[d][qt] = mfma16(vf[d], pk, st.o[d][qt]);
        }
    }
}
__device__ __forceinline__ void mla_dma_item(const Ctx& c, int it) {
    const int fr = c.lane & 15, fq = c.lane >> 4, b = it >> 5, h = (it >> 2) & 7, qg = it & 3, row0 = b * SEQ + 512 * qg + 64 * c.wave;
    const bf16_t* Kp = wsp<bf16_t>(c, WS_KF) + (size_t)((b * 8 + h) * SALL) * 96; const bf16_t* VTp = wsp<bf16_t>(c, WS_VTM) + (size_t)((b * 8 + h) * 64) * SALL;
    AttnSt<96, 4> st;
    attn_init<96, 4>(st, wsp<bf16_t>(c, WS_QF) + (size_t)row0 * 768 + h * 96, 768, -1e30f, 0.0f, fr, fq);
    f32x4 nm[4];
#pragma unroll
    for (int qt = 0; qt < 4; ++qt) nm[qt] = (f32x4){0.f, 0.f, 0.f, 0.f};
    unsigned oK0, oK1, oV;
    { const int q0 = c.wave * 1024 + c.lane * 16, r0 = q0 / 192, c0 = (q0 % 192) / 16; oK0 = r0 * 192 + ((c0 ^ ((r0 >> 2) & 3)) * 16);
      const int q1 = (c.wave + 8) * 1024 + c.lane * 16, r1 = q1 / 192, c1 = (q1 % 192) / 16; oK1 = (c.wave + 8) < 12 ? r1 * 192 + ((c1 ^ ((r1 >> 2) & 3)) * 16) : c.lane * 16;
      const int rv = 8 * c.wave + (c.lane >> 3), cv = c.lane & 7; oV = rv * (SALL * 2) + ((cv ^ ((rv >> 1) & 7)) * 16); }
    constexpr int ntile = SALL / 64;
    mla_dma_issue(c.lds, Kp, VTp, oK0, oK1, oV, c.wave);
    mla_dma_issue(c.lds + MD_BUF, Kp + 64 * 96, VTp + 64, oK0, oK1, oV, c.wave);
    for (int t = 0; t < ntile; ++t) {
        if (t + 1 < ntile) asm volatile("s_waitcnt vmcnt(3)" ::: "memory"); else asm volatile("s_waitcnt vmcnt(0)" ::: "memory");
        __builtin_amdgcn_s_barrier(); asm volatile("" ::: "memory");
        if (t + 2 < ntile) mla_dma_issue(c.lds + ((t + 2) % 3) * MD_BUF, Kp + (size_t)(64 * (t + 2)) * 96, VTp + 64 * (t + 2), oK0, oK1, oV, c.wave);
        mla_dma_tile(st, nm, c.lds + (t % 3) * MD_BUF, fr, fq, t == 0);
        asm volatile("s_waitcnt lgkmcnt(0)" ::: "memory");
    }
    __syncthreads();
    attn_store<96, 4>(st, wsp<bf16_t>(c, P_CD) + 512 + (size_t)row0 * 1024 + h * 64, 1024, fr, fq);
}
template <int DQK, int NQT, bool MASK>
__device__ __forceinline__ void attn_tile_lazy(AttnSt<DQK, NQT>& st, f32x4 (&nm)[NQT], const LAS unsigned char* buf, int qpos0, int kpos0, int fr, int fq) {
    constexpr int KROW = AttnLds<DQK>::KROW, VROW = AttnLds<DQK>::VROW;
#pragma unroll
    for (int stp = 0; stp < 2; ++stp) {
        f32x4 s[2][NQT];
#pragma unroll
        for (int kt = 0; kt < 2; ++kt) {
            bf16x8 kf[DQK / 32];
#pragma unroll
            for (int ks = 0; ks < DQK / 32; ++ks) kf[ks] = *(const LAS bf16x8*)(buf + (32 * stp + 16 * kt + fr) * KROW + ks * 64 + fq * 16);
#pragma unroll
            for (int qt = 0; qt < NQT; ++qt) { s[kt][qt] = mfma16(kf[0], st.q[qt][0], nm[qt]);
#pragma unroll
                for (int ks = 1; ks < DQK / 32; ++ks) s[kt][qt] = mfma16(kf[ks], st.q[qt][ks], s[kt][qt]); }
        }
        int chk = 0;
#pragma unroll
        for (int qt = 0; qt < NQT; ++qt) {
            if (MASK) { const int qp = qpos0 + 16 * qt + fr;
#pragma unroll
                for (int kt = 0; kt < 2; ++kt)
#pragma unroll
                    for (int r = 0; r < 4; ++r) { const int dd = qp - (kpos0 + 32 * stp + 16 * kt + 4 * fq + r); if (dd > 128 || dd < -128) s[kt][qt][r] = -1e30f; } }
            chk = imax9(chk, s[0][qt], s[1][qt]);
        }
        if (__builtin_amdgcn_ballot_w64(chk > __float_as_int(LAZY_TAU)) != 0ull) {
#pragma unroll
            for (int qt = 0; qt < NQT; ++qt) {
                float mx = fmaxf(fmaxf(fmaxf(s[0][qt].x, s[0][qt].y), fmaxf(s[0][qt].z, s[0][qt].w)), fmaxf(fmaxf(s[1][qt].x, s[1][qt].y), fmaxf(s[1][qt].z, s[1][qt].w)));
                mx = rows_max(mx);
                const float dlt = fmaxf(mx, 0.f), alpha = fast_exp2(-dlt);
                nm[qt] -= dlt; s[0][qt] -= dlt; s[1][qt] -= dlt; st.l[qt] *= alpha;
#pragma unroll
                for (int d = 0; d < 4; ++d) st.o[d][qt] *= alpha;
            }
        }
        bf16x8 vf[4];
#pragma unroll
        for (int d = 0; d < 4; ++d) vf[d] = *(const LAS bf16x8*)(buf + AttnLds<DQK>::KBYTES + (16 * d + fr) * VROW + stp * 64 + fq * 16);
#pragma unroll
        for (int qt = 0; qt < NQT; ++qt) {
            float ps = 0.f;
#pragma unroll
            for (int kt = 0; kt < 2; ++kt)
#pragma unroll
                for (int r = 0; r < 4; ++r) { const float p = fast_exp2(s[kt][qt][r]); s[kt][qt][r] = p; ps += p; }
            st.l[qt] += ps;
            const bf16x8 pk = pack8(s[0][qt], s[1][qt]);
#pragma unroll
            for (int d = 0; d < 4; ++d) st.o[d][qt] = mfma16(vf[d], pk, st.o[d][qt]);
        }
    }
}
__device__ __forceinline__ void gqa_block_item(const Ctx& c, int l, int it, bool dry = false) {
    const int fr = c.lane & 15, fq = c.lane >> 4, b = it >> 6, kvh = (it >> 5) & 1, tq = it & 31, hq = kvh * 4 + (c.wave >> 1), q0 = 64 * tq + 32 * (c.wave & 1);
    typedef AttnLds<64> L;
    bf16_t* Q = wsp<bf16_t>(c, P_AB) + 512 + (size_t)(b * SEQ + q0) * 1024 + hq * 64;
    const bf16_t* Kall = wsp<bf16_t>(c, P_BK) + kvh * 64; const bf16_t* VT = wsp<bf16_t>(c, VT_GQA) + (size_t)((b * 2 + kvh) * 64) * SALL;
    AttnSt<64, 2> st;
    attn_init<64, 2>(st, Q, 1024, c.in[I_SINK][l * 8 + hq] * LOG2E, fq == 0 ? 1.0f : 0.0f, fr, fq);
    f32x4 nm[2];
#pragma unroll
    for (int qt = 0; qt < 2; ++qt) { const float v = -st.m[qt]; nm[qt] = (f32x4){v, v, v, v}; }
    const int wlo = 64 * tq - 128 < 0 ? 0 : 64 * tq - 128, whi = 64 * tq + 192 > SEQ ? SEQ : 64 * tq + 192, ntile = 4 + ((whi - wlo) >> 6);
#define GQA_KP(t) ((t) < 4 ? Kall + (size_t)(NLAT + b * CTX + 64 * (t)) * 128 : Kall + (size_t)(b * SEQ + wlo + 64 * ((t) - 4)) * 128)
#define GQA_VP(t) ((t) < 4 ? VT + 64 * (t) : VT + CTX + wlo + 64 * ((t) - 4))
#define GQA_COMPUTE(t) do { if ((t) < 4) attn_tile_lazy<64, 2, false>(st, nm, c.lds + ((t) & 1) * L::BUF, 0, 0, fr, fq); \
        else { const int k0 = wlo + 64 * ((t) - 4); if (k0 >= q0 + 31 - 128 && k0 + 63 <= q0 + 128) attn_tile_lazy<64, 2, false>(st, nm, c.lds + ((t) & 1) * L::BUF, 0, 0, fr, fq); \
               else if (k0 + 63 >= q0 - 128 && k0 <= q0 + 31 + 128) attn_tile_lazy<64, 2, true>(st, nm, c.lds + ((t) & 1) * L::BUF, q0, k0, fr, fq); } } while (0)
    TileRegs<64> r0;
    tile_gload<64>(r0, GQA_KP(0), 128, GQA_VP(0), c.tid); tile_swrite<64>(r0, c.lds, c.tid);
    __syncthreads();
    for (int t = 0; t < ntile; ++t) {
        if (t + 1 < ntile) tile_gload<64>(r0, GQA_KP(t + 1), 128, GQA_VP(t + 1), c.tid);
        GQA_COMPUTE(t);
        if (t + 1 < ntile) tile_swrite<64>(r0, c.lds + ((t + 1) & 1) * L::BUF, c.tid);
        __syncthreads();
    }
#undef GQA_KP
#undef GQA_VP
#undef GQA_COMPUTE
    attn_store<64, 2>(st, Q, 1024, fr, fq, dry);
}
#undef ATT_STEP

__device__ __forceinline__ int ret_row0(int b, int p) { return p < 2 ? NLAT + b * CTX + 128 * p : b * SEQ + 128 * (p - 2); }
__device__ __forceinline__ int ret_s0(int p) { return p < 2 ? 128 * p : CTX + 128 * (p - 2); }
__device__ __forceinline__ int ret_posb(int p) { return p < 2 ? 1 - p : 2 + (17 - p); }
__device__ __forceinline__ float ret_lg2(const Ctx& c, int l, int dir, int h) { const float x = c.in[I_RDECAY][(l * 2 + dir) * 4 + h]; return -log2f(1.0f + expf(-x)); }
__device__ __forceinline__ bf16_t* ret_state(const Ctx& c, int b, int h, int dir, int pos) { return wsp<bf16_t>(c, WS_RET) + ((size_t)(((b * 4 + h) * 2 + dir) * 18 + pos)) * 16384; }
__device__ __forceinline__ void ret_kv_item(const Ctx& c, int l, int it) {
    const int fr = c.lane & 15, fq = c.lane >> 4;
    const int w = it & 7, p = (it >> 3) % 18, bh = (it >> 3) / 18, b = bh >> 2, h = bh & 3, s0 = ret_s0(p);
    const float lgf = ret_lg2(c, l, 0, h), lgb = ret_lg2(c, l, 1, h);
    const bf16_t* KT = wsp<bf16_t>(c, KT_RET) + ((size_t)(b * 4 + h) * 128 + 16 * w + fr) * SALL + s0 + 8 * fq;
    const bf16_t* VT = wsp<bf16_t>(c, VT_RET) + ((size_t)(b * 4 + h) * 128 + fr) * SALL + s0 + 8 * fq;
    bf16x8 kf[4], kb[4];
#pragma unroll
    for (int u = 0; u < 4; ++u) { const u32x4 kw = *(const u32x4*)(KT + 32 * u); float v[8] = {bf_lo(kw.x), bf_hi(kw.x), bf_lo(kw.y), bf_hi(kw.y), bf_lo(kw.z), bf_hi(kw.z), bf_lo(kw.w), bf_hi(kw.w)};
        float vf[8], vb[8];
#pragma unroll
        for (int jj = 0; jj < 8; ++jj) { const int jl = 32 * u + 16 * (jj >> 2) + 4 * fq + (jj & 3);
            if (RDBG & 64) v[jj] = bf2f(wsp<bf16_t>(c, P_DK)[(size_t)(ret_row0(b, p) + jl) * 512 + h * 128 + 16 * w + fr]); vf[jj] = v[jj] * exp2f((float)(127 - jl) * lgf); vb[jj] = v[jj] * exp2f((float)jl * lgb); }
        u32x4 o; o.x = cvt_pk_bf16(vf[0], vf[1]); o.y = cvt_pk_bf16(vf[2], vf[3]); o.z = cvt_pk_bf16(vf[4], vf[5]); o.w = cvt_pk_bf16(vf[6], vf[7]); kf[u] = __builtin_bit_cast(bf16x8, o);
        o.x = cvt_pk_bf16(vb[0], vb[1]); o.y = cvt_pk_bf16(vb[2], vb[3]); o.z = cvt_pk_bf16(vb[4], vb[5]); o.w = cvt_pk_bf16(vb[6], vb[7]); kb[u] = __builtin_bit_cast(bf16x8, o);
        if (RDBG & 32) { const u32x4 cw = {0x3c233c23u, 0x3c233c23u, 0x3c233c23u, 0x3c233c23u}; kf[u] = __builtin_bit_cast(bf16x8, cw); kb[u] = kf[u]; } }
    bf16_t* Sf = ret_state(c, b, h, 0, p) + (size_t)fr * 128 + 16 * w + 4 * fq;
    bf16_t* Sb = ret_state(c, b, h, 1, ret_posb(p)) + (size_t)fr * 128 + 16 * w + 4 * fq;
#pragma unroll 2
    for (int d = 0; d < 8; ++d) {
        f32x4 af = (f32x4){0.f, 0.f, 0.f, 0.f}, ab = af;
#pragma unroll
        for (int u = 0; u < 4; ++u) { const bf16x8 vf = ldfrag(VT + (size_t)(16 * d) * SALL + 32 * u); af = mfma16(kf[u], vf, af); ab = mfma16(kb[u], vf, ab); }
        st4bf(Sf + (size_t)(16 * d) * 128, af); st4bf(Sb + (size_t)(16 * d) * 128, ab);
    }
}
__device__ __forceinline__ void ret_prefix(const Ctx& c, int l, int e) {
    const int chain = e >> 11, off = (e & 2047) * 8, dir = chain & 1, h = (chain >> 1) & 3;
    const float dec = exp2f(128.0f * ret_lg2(c, l, dir, h));
    bf16_t* S = wsp<bf16_t>(c, WS_RET) + (size_t)chain * 18 * 16384 + off;
    u32x4 kv[18];
#pragma unroll
    for (int p = 0; p < 18; ++p) kv[p] = *(const u32x4*)(S + (size_t)p * 16384);
    float R[8];
#pragma unroll
    for (int j = 0; j < 8; ++j) R[j] = 0.f;
#pragma unroll
    for (int p = 0; p < 18; ++p) {
        u32x4 o; o.x = cvt_pk_bf16(R[0], R[1]); o.y = cvt_pk_bf16(R[2], R[3]); o.z = cvt_pk_bf16(R[4], R[5]); o.w = cvt_pk_bf16(R[6], R[7]);
        *(u32x4*)(S + (size_t)p * 16384) = o;
        R[0] = R[0] * dec + bf_lo(kv[p].x); R[1] = R[1] * dec + bf_hi(kv[p].x); R[2] = R[2] * dec + bf_lo(kv[p].y); R[3] = R[3] * dec + bf_hi(kv[p].y);
        R[4] = R[4] * dec + bf_lo(kv[p].z); R[5] = R[5] * dec + bf_hi(kv[p].z); R[6] = R[6] * dec + bf_lo(kv[p].w); R[7] = R[7] * dec + bf_hi(kv[p].w);
    }
}
__device__ __forceinline__ void ret_out_item(const Ctx& c, int l, int it, bool dry = false) {
    const int fr = c.lane & 15, fq = c.lane >> 4;
    const int w = it & 7, p = (it >> 3) % 18, bh = (it >> 3) / 18, b = bh >> 2, h = bh & 3, s0 = ret_s0(p), row0 = ret_row0(b, p);
    const float lgf = ret_lg2(c, l, 0, h), lgb = ret_lg2(c, l, 1, h);
    const int il = 16 * w + fr;
    bf16x8 qf[4];
#pragma unroll
    for (int ks = 0; ks < 4; ++ks) qf[ks] = ldfrag(wsp<bf16_t>(c, P_DQ) + (size_t)(row0 + il) * 512 + h * 128 + 32 * ks + 8 * fq);
    f32x4 y[8];
    {
        f32x4 st[8];
        const bf16_t* K = wsp<bf16_t>(c, P_DK) + (size_t)(row0 + fr) * 512 + h * 128 + 8 * fq;
#pragma unroll
        for (int jt = 0; jt < 8; ++jt) { st[jt] = (f32x4){0.f, 0.f, 0.f, 0.f};
#pragma unroll
            for (int ks = 0; ks < 4; ++ks) st[jt] = mfma16(ldfrag(K + (size_t)(16 * jt) * 512 + 32 * ks), qf[ks], st[jt]);
#pragma unroll
            for (int r = 0; r < 4; ++r) { const int d = il - (16 * jt + 4 * fq + r); st[jt][r] *= d >= 0 ? exp2f((float)d * lgf) : exp2f((float)(-d) * lgb); } }
        const bf16_t* VT = wsp<bf16_t>(c, VT_RET) + ((size_t)(b * 4 + h) * 128 + fr) * SALL + s0 + 8 * fq;
        bf16x8 pk[4];
#pragma unroll
        for (int u = 0; u < 4; ++u) pk[u] = pack8(st[2 * u], st[2 * u + 1]);
#pragma unroll
        for (int d = 0; d < 8; ++d) { y[d] = (f32x4){0.f, 0.f, 0.f, 0.f};
#pragma unroll
            for (int u = 0; u < 4; ++u) y[d] = mfma16(ldfrag(VT + (size_t)(16 * d) * SALL + 32 * u), pk[u], y[d]);
            if (!(RDBG & 1)) y[d] = (f32x4){0.f, 0.f, 0.f, 0.f}; }
    }
    {
        const float xif = exp2f((float)(il + 1) * lgf), xib = exp2f((float)(128 - il) * lgb);
        const bf16_t* Rf = ret_state(c, b, h, 0, p) + (size_t)fr * 128 + 8 * fq;
        const bf16_t* Rb = ret_state(c, b, h, 1, ret_posb(p)) + (size_t)fr * 128 + 8 * fq;
#pragma unroll 2
        for (int d = 0; d < 8; ++d) { f32x4 cf = (f32x4){0.f, 0.f, 0.f, 0.f}, cb = cf;
#pragma unroll
            for (int ks = 0; ks < 4; ++ks) { bf16x8 rf_ = ldfrag(Rf + (size_t)(16 * d) * 128 + 32 * ks), rb_ = ldfrag(Rb + (size_t)(16 * d) * 128 + 32 * ks);
                if (RDBG & 16) { const u32x4 cw = {0x3c233c23u, 0x3c233c23u, 0x3c233c23u, 0x3c233c23u}; rf_ = __builtin_bit_cast(bf16x8, cw); rb_ = rf_; }
                cf = mfma16(rf_, qf[ks], cf); cb = mfma16(rb_, qf[ks], cb); }
            if (RDBG & 2) y[d] += cf * xif; if (RDBG & 4) y[d] += cb * xib; }
    }
    float s = 0.f;
#pragma unroll
    for (int d = 0; d < 8; ++d) s += (y[d].x + y[d].y) + (y[d].z + y[d].w);
    s = rows_sum(s);
    const float mu = s * (1.0f / 128.0f); float q = 0.f;
#pragma unroll
    for (int d = 0; d < 8; ++d) { y[d] = y[d] - mu; q += (y[d].x * y[d].x + y[d].y * y[d].y) + (y[d].z * y[d].z + y[d].w * y[d].w); }
    q = rows_sum(q);
    const float rstd = 1.0f / sqrtf(q * (1.0f / 128.0f) + LN_EPS);
    bf16_t* G = wsp<bf16_t>(c, P_CD) + (size_t)(row0 + il) * 1024 + h * 128 + 4 * fq;
    const float* gn = c.in[I_GNG] + l * 512 + h * 128 + 4 * fq;
#pragma unroll
    for (int d = 0; d < 8; ++d) { const u32x2 gw = *(const u32x2*)(G + 16 * d); const f32x4 gg = *(const f32x4*)(gn + 16 * d);
        f32x4 o = y[d] * rstd * gg; o.x *= bf_lo(gw.x); o.y *= bf_hi(gw.x); o.z *= bf_lo(gw.y); o.w *= bf_hi(gw.y); if (!dry) st4bf(G + 16 * d, o); }
}

__device__ __forceinline__ void tile128_load(u32x4 (&r)[4], const bf16_t* src, int ld, int tid) {
#pragma unroll
    for (int j = 0; j < 4; ++j) { const int i = tid + 512 * j; r[j] = *(const u32x4*)(src + (size_t)(i >> 4) * ld + (i & 15) * 8); }
}
__device__ __forceinline__ void tile128_store(const u32x4 (&r)[4], LAS unsigned char* t, int tid) {
#pragma unroll
    for (int j = 0; j < 4; ++j) { const int i = tid + 512 * j, row = i >> 4, cch = i & 15; *(LAS u32x4*)(t + row * 256 + ((cch ^ (row & 15)) << 4)) = r[j]; }
}
__device__ __forceinline__ bf16x8 tile128_frag(const LAS unsigned char* t, int rb, int kc, int fr, int fq) { return *(const LAS bf16x8*)(t + (rb + fr) * 256 + (((kc + fq) ^ fr) << 4)); }
__device__ __forceinline__ void ret_kv_block(const Ctx& c, int l, int it) {
    const int fr = c.lane & 15, fq = c.lane >> 4, w = c.wave;
    const int p = it % 18, bh = it / 18, b = bh >> 2, h = bh & 3, s0 = ret_s0(p);
    const float lgf = ret_lg2(c, l, 0, h), lgb = ret_lg2(c, l, 1, h);
    LAS unsigned char* tK = c.lds; LAS unsigned char* tV = c.lds + 32768;
    { u32x4 r0[4], r1[4];
      tile128_load(r0, wsp<bf16_t>(c, KT_RET) + (size_t)((b * 4 + h) * 128) * SALL + s0, SALL, c.tid);
      tile128_load(r1, wsp<bf16_t>(c, VT_RET) + (size_t)((b * 4 + h) * 128) * SALL + s0, SALL, c.tid);
      tile128_store(r0, tK, c.tid); tile128_store(r1, tV, c.tid); }
    __syncthreads();
    bf16x8 kf[4], kb[4];
#pragma unroll
    for (int u = 0; u < 4; ++u) { const u32x4 kw = __builtin_bit_cast(u32x4, tile128_frag(tK, 16 * w, 4 * u, fr, fq)); const float v[8] = {bf_lo(kw.x), bf_hi(kw.x), bf_lo(kw.y), bf_hi(kw.y), bf_lo(kw.z), bf_hi(kw.z), bf_lo(kw.w), bf_hi(kw.w)};
        float vf[8], vb[8];
#pragma unroll
        for (int jj = 0; jj < 8; ++jj) { const int jl = 32 * u + 16 * (jj >> 2) + 4 * fq + (jj & 3); vf[jj] = v[jj] * fast_exp2((float)(127 - jl) * lgf); vb[jj] = v[jj] * fast_exp2((float)jl * lgb); }
        u32x4 o; o.x = cvt_pk_bf16(vf[0], vf[1]); o.y = cvt_pk_bf16(vf[2], vf[3]); o.z = cvt_pk_bf16(vf[4], vf[5]); o.w = cvt_pk_bf16(vf[6], vf[7]); kf[u] = __builtin_bit_cast(bf16x8, o);
        o.x = cvt_pk_bf16(vb[0], vb[1]); o.y = cvt_pk_bf16(vb[2], vb[3]); o.z = cvt_pk_bf16(vb[4], vb[5]); o.w = cvt_pk_bf16(vb[6], vb[7]); kb[u] = __builtin_bit_cast(bf16x8, o); }
    bf16_t* Sf = ret_state(c, b, h, 0, p) + (size_t)(fr + 16 * (fq & 1)) * 128 + 16 * w + 8 * (fq >> 1);
    bf16_t* Sb = ret_state(c, b, h, 1, ret_posb(p)) + (size_t)(fr + 16 * (fq & 1)) * 128 + 16 * w + 8 * (fq >> 1);
#pragma unroll 1
    for (int d = 0; d < 8; d += 2) {
        u32x2 pf[2], pb[2];
#pragma unroll
        for (int e = 0; e < 2; ++e) { f32x4 af = (f32x4){0.f, 0.f, 0.f, 0.f}, ab = af;
#pragma unroll
            for (int u = 0; u < 4; ++u) { const bf16x8 vf = tile128_frag(tV, 16 * (d + e), 4 * u, fr, fq); af = mfma16(kf[u], vf, af); ab = mfma16(kb[u], vf, ab); }
            pf[e].x = cvt_pk_bf16(af.x, af.y); pf[e].y = cvt_pk_bf16(af.z, af.w); pb[e].x = cvt_pk_bf16(ab.x, ab.y); pb[e].y = cvt_pk_bf16(ab.z, ab.w); }
        *(u32x4*)(Sf + (size_t)(16 * d) * 128) = widen16(pf[0], pf[1]); *(u32x4*)(Sb + (size_t)(16 * d) * 128) = widen16(pb[0], pb[1]);
    }
    __syncthreads();
}
__device__ __forceinline__ void ret_out_block(const Ctx& c, int l, int it, bool dry = false) {
    const int fr = c.lane & 15, fq = c.lane >> 4, w = c.wave;
    const int p = it % 18, bh = it / 18, b = bh >> 2, h = bh & 3, s0 = ret_s0(p), row0 = ret_row0(b, p);
    const float lgf = ret_lg2(c, l, 0, h), lgb = ret_lg2(c, l, 1, h);
    LAS unsigned char* tK = c.lds; LAS unsigned char* tV = c.lds + 32768; LAS unsigned char* tF = c.lds + 65536; LAS unsigned char* tB = c.lds + 98304;
    const int il = 16 * w + fr;
    bf16x8 qf[4];
    { u32x4 r0[4], r1[4], r2[4], r3[4];
      tile128_load(r0, wsp<bf16_t>(c, P_DK) + (size_t)row0 * 512 + h * 128, 512, c.tid);
      tile128_load(r1, wsp<bf16_t>(c, VT_RET) + (size_t)((b * 4 + h) * 128) * SALL + s0, SALL, c.tid);
      tile128_load(r2, ret_state(c, b, h, 0, p), 128, c.tid);
      tile128_load(r3, ret_state(c, b, h, 1, ret_posb(p)), 128, c.tid);
#pragma unroll
      for (int ks = 0; ks < 4; ++ks) qf[ks] = ldfrag(wsp<bf16_t>(c, P_DQ) + (size_t)(row0 + il) * 512 + h * 128 + 32 * ks + 8 * fq);
      tile128_store(r0, tK, c.tid); tile128_store(r1, tV, c.tid); tile128_store(r2, tF, c.tid); tile128_store(r3, tB, c.tid); }
    __syncthreads();
    f32x4 y[8];
    {
        f32x4 st[8];
#pragma unroll
        for (int jt = 0; jt < 8; ++jt) { st[jt] = (f32x4){0.f, 0.f, 0.f, 0.f};
#pragma unroll
            for (int ks = 0; ks < 4; ++ks) st[jt] = mfma16(tile128_frag(tK, 16 * jt, 4 * ks, fr, fq), qf[ks], st[jt]);
#pragma unroll
            for (int r = 0; r < 4; ++r) { const int d = il - (16 * jt + 4 * fq + r); st[jt][r] *= d >= 0 ? fast_exp2((float)d * lgf) : fast_exp2((float)(-d) * lgb); } }
        bf16x8 pk[4];
#pragma unroll
        for (int u = 0; u < 4; ++u) pk[u] = pack8(st[2 * u], st[2 * u + 1]);
#pragma unroll
        for (int d = 0; d < 8; ++d) { y[d] = (f32x4){0.f, 0.f, 0.f, 0.f};
#pragma unroll
            for (int u = 0; u < 4; ++u) y[d] = mfma16(tile128_frag(tV, 16 * d, 4 * u, fr, fq), pk[u], y[d]); }
    }
    {
        const float xif = fast_exp2((float)(il + 1) * lgf), xib = fast_exp2((float)(128 - il) * lgb);
#pragma unroll 2
        for (int d = 0; d < 8; ++d) { f32x4 cf = (f32x4){0.f, 0.f, 0.f, 0.f}, cb = cf;
#pragma unroll
            for (int ks = 0; ks < 4; ++ks) { cf = mfma16(tile128_frag(tF, 16 * d, 4 * ks, fr, fq), qf[ks], cf); cb = mfma16(tile128_frag(tB, 16 * d, 4 * ks, fr, fq), qf[ks], cb); }
            y[d] += cf * xif + cb * xib; }
    }
    float s = 0.f;
#pragma unroll
    for (int d = 0; d < 8; ++d) s += (y[d].x + y[d].y) + (y[d].z + y[d].w);
    s = rows_sum(s);
    const float mu = s * (1.0f / 128.0f); float q = 0.f;
#pragma unroll
    for (int d = 0; d < 8; ++d) { y[d] = y[d] - mu; q += (y[d].x * y[d].x + y[d].y * y[d].y) + (y[d].z * y[d].z + y[d].w * y[d].w); }
    q = rows_sum(q);
    const float rstd = 1.0f / sqrtf(q * (1.0f / 128.0f) + LN_EPS);
    bf16_t* G = wsp<bf16_t>(c, P_CD) + (size_t)(row0 + il) * 1024 + h * 128 + 4 * fq;
    const float* gn = c.in[I_GNG] + l * 512 + h * 128 + 4 * fq;
#pragma unroll
    for (int d = 0; d < 8; d += 2) { u32x2 pk2[2];
#pragma unroll
        for (int e = 0; e < 2; ++e) { const u32x2 gw = *(const u32x2*)(G + 16 * (d + e)); const f32x4 gg = *(const f32x4*)(gn + 16 * (d + e));
            f32x4 o = y[d + e] * rstd * gg; o.x *= bf_lo(gw.x); o.y *= bf_hi(gw.x); o.z *= bf_lo(gw.y); o.w *= bf_hi(gw.y); pk2[e].x = cvt_pk_bf16(o.x, o.y); pk2[e].y = cvt_pk_bf16(o.z, o.w); }
        const u32x4 w = widen16(pk2[0], pk2[1]);
        if (!dry) *(u32x4*)(G - 4 * fq + 16 * (d + (fq & 1)) + 8 * (fq >> 1)) = w; }
    __syncthreads();
}

__device__ __forceinline__ void lru_item(const Ctx& c, int l, int b, int ch, int n, int mode, unsigned* cntp = nullptr, bool skip_out = false, int nb = -1, int nn = 0) {
    const bool final = mode == 1, dry = false;
    const bool isctx = ch < 4; const int T = isctx ? CTX : SEQ, t0 = isctx ? 64 * ch : 64 * (ch - 4), rowbase = isctx ? NLAT + b * CTX : b * SEQ;
    LAS float* xa = (LAS float*)c.lds;
    LAS bf16_t* xab = (LAS bf16_t*)(c.lds + 16384);
    LAS float* ga = (LAS float*)(c.lds + 16384 + 9216);
    LAS float* gb = ga + 2 * 4096;
    LAS float* pa = gb + 2 * 4096;
    LAS float* h0 = pa + 1024;
    const bf16_t* AX = wsp<bf16_t>(c, P_AX);
    const int gfr = c.lane & 15, gfq = c.lane >> 4, gdir = c.wave >> 2, ge = 16 * (c.wave & 3) + gfr, gcc = n * 64 + ge;
    bf16x8 gwa[2], gwx[2];
#pragma unroll
    for (int ks = 0; ks < 2; ++ks) { gwa[ks] = ldfrag(wsp<bf16_t>(c, WM_LRU) + (size_t)((gdir * 2 + 0) * 8 + n) * 4096 + ge * 64 + 8 * gfq + 32 * ks); gwx[ks] = ldfrag(wsp<bf16_t>(c, WM_LRU) + (size_t)((gdir * 2 + 1) * 8 + n) * 4096 + ge * 64 + 8 * gfq + 32 * ks); }
    const float gba = c.in[I_LBA][(l * 2 + gdir) * 512 + gcc], gbx = c.in[I_LBX][(l * 2 + gdir) * 512 + gcc], glam = c.in[I_LLAM][(l * 2 + gdir) * 512 + gcc];
    u32x4 gpre = (u32x4){0u, 0u, 0u, 0u};
    {
        const int t = c.tid >> 3, e8 = (c.tid & 7) * 8, cc = n * 64 + e8;
        const float* cw = c.in[I_CONVW] + l * 4 * 512 + cc; const float* cb = c.in[I_CONVB] + l * 512 + cc;
        if (mode != 0) gpre = *(const u32x4*)(wsp<bf16_t>(c, P_AB) + (size_t)(rowbase + t0 + t) * 1024 + n * 64 + e8);
        float v[8]; { const f32x4 b0 = *(const f32x4*)cb, b1 = *(const f32x4*)(cb + 4); v[0] = b0.x; v[1] = b0.y; v[2] = b0.z; v[3] = b0.w; v[4] = b1.x; v[5] = b1.y; v[6] = b1.z; v[7] = b1.w; }
#pragma unroll
        for (int j = 0; j < 4; ++j) { const int tt = t0 + t + j - 2;
            if (tt >= 0 && tt < T) { const u32x4 xw = *(const u32x4*)(AX + (size_t)(rowbase + tt) * 512 + cc); const f32x4 w0 = *(const f32x4*)(cw + j * 512), w1 = *(const f32x4*)(cw + j * 512 + 4);
                v[0] += w0.x * bf_lo(xw.x); v[1] += w0.y * bf_hi(xw.x); v[2] += w0.z * bf_lo(xw.y); v[3] += w0.w * bf_hi(xw.y); v[4] += w1.x * bf_lo(xw.z); v[5] += w1.y * bf_hi(xw.z); v[6] += w1.z * bf_lo(xw.w); v[7] += w1.w * bf_hi(xw.w); } }
        *(LAS f32x4*)(xa + t * 64 + e8) = (f32x4){v[0], v[1], v[2], v[3]}; *(LAS f32x4*)(xa + t * 64 + e8 + 4) = (f32x4){v[4], v[5], v[6], v[7]};
        u32x4 o; o.x = cvt_pk_bf16(v[0], v[1]); o.y = cvt_pk_bf16(v[2], v[3]); o.z = cvt_pk_bf16(v[4], v[5]); o.w = cvt_pk_bf16(v[6], v[7]); *(LAS u32x4*)(xab + t * 72 + e8) = o;
    }
    if (final && c.tid < 128) {
        const int dir = c.tid >> 6, e = c.tid & 63, pos = dir == 0 ? ch : (isctx ? 3 - ch : 4 + (35 - ch));
        const float* sum = wsp<float>(c, WS_LRUSUM) + ((size_t)(b * 2 + dir) * 36) * 1024 + (n * 64 + e) * 2;
        float hst = 0.f;
#pragma unroll
        for (int hf = 0; hf < 2; ++hf) {
            f32x2 sq[18];
#pragma unroll
            for (int q = 0; q < 18; ++q) sq[q] = *(const f32x2*)(sum + (size_t)(18 * hf + q) * 1024);
#pragma unroll
            for (int q = 0; q < 18; ++q) hst = 18 * hf + q < pos ? sq[q].x * hst + sq[q].y : hst;
        }
        h0[dir * 64 + e] = hst;
    }
    __syncthreads();
    {
        f32x4 ar[4], ai[4];
#pragma unroll
        for (int tt = 0; tt < 4; ++tt) { ar[tt] = (f32x4){0.f, 0.f, 0.f, 0.f}; ai[tt] = ar[tt]; }
#pragma unroll
        for (int ks = 0; ks < 2; ++ks) {
#pragma unroll
            for (int tt = 0; tt < 4; ++tt) { const bf16x8 xf = *(const LAS bf16x8*)(xab + (16 * tt + gfr) * 72 + 32 * ks + 8 * gfq); ar[tt] = mfma16(xf, gwa[ks], ar[tt]); ai[tt] = mfma16(xf, gwx[ks], ai[tt]); } }
        const int fr = gfr, fq = gfq, dir = gdir, e = ge;
        const float ba = gba, bx = gbx, lam = glam;
        const float sp8 = -8.0f * LOG2E * log1pf(expf(-lam));
#pragma unroll
        for (int tt = 0; tt < 4; ++tt)
#pragma unroll
            for (int r = 0; r < 4; ++r) { const int t = 16 * tt + 4 * fq + r;
                const float rg = sigmoidf_(ar[tt][r] + ba), ig = sigmoidf_(ai[tt][r] + bx);
                const float a = fast_exp2(rg * sp8), bt = __builtin_sqrtf(fmaxf(1.0f - a * a, 0.f)) * (ig * xa[t * 64 + e]);
                ga[(dir * 64 + t) * 64 + e] = a; gb[(dir * 64 + t) * 64 + e] = bt; }
    }
    __syncthreads();
    const int sdir = c.tid >> 8, part = (c.tid >> 6) & 3, se = c.tid & 63;
    float av[16], bv[16];
#pragma unroll
    for (int k = 0; k < 16; ++k) { const int i = 16 * part + k, t = sdir == 0 ? i : 63 - i; av[k] = ga[(sdir * 64 + t) * 64 + se]; bv[k] = gb[(sdir * 64 + t) * 64 + se]; }
    { float hh = 0.f, ap = 1.f;
#pragma unroll
      for (int k = 0; k < 16; ++k) { hh = av[k] * hh + bv[k]; ap *= av[k]; }
      *(LAS f32x2*)(pa + ((sdir * 4 + part) * 64 + se) * 2) = (f32x2){ap, hh}; }
    __syncthreads();
    if (mode == 2) {
        if (part == 0) { float hh = 0.f, ap = 1.f;
#pragma unroll
            for (int q = 0; q < 4; ++q) { const f32x2 s = *(const LAS f32x2*)(pa + ((sdir * 4 + q) * 64 + se) * 2); hh = s.x * hh + s.y; ap *= s.x; }
            const int pos = sdir == 0 ? ch : (isctx ? 3 - ch : 4 + (35 - ch));
            __hip_atomic_store((unsigned long long*)(wsp<float>(c, WS_LRUSUM) + ((size_t)(b * 2 + sdir) * 36 + pos) * 1024 + (n * 64 + se) * 2), ((unsigned long long)__float_as_uint(hh) << 32) | __float_as_uint(ap), __ATOMIC_RELAXED, __HIP_MEMORY_SCOPE_AGENT); }
        asm volatile("s_waitcnt vmcnt(0)" ::: "memory");
        __syncthreads();
        if (c.tid == 0) __hip_atomic_fetch_add(cntp, 1u, __ATOMIC_RELAXED, __HIP_MEMORY_SCOPE_AGENT);
        if (skip_out) return;
        u32x4 pf0 = (u32x4){0u, 0u, 0u, 0u}, pf1 = pf0, pf2 = pf0;
        if (nb >= 0) { const int t = c.tid >> 3, e8 = (c.tid & 7) * 8, rb2 = isctx ? NLAT + nb * CTX : nb * SEQ; int ta = t0 + t - 2, tb = t0 + t + 1; ta = ta < 0 ? 0 : ta; tb = tb >= T ? T - 1 : tb;
            pf0 = *(const u32x4*)(AX + (size_t)(rb2 + ta) * 512 + nn * 64 + e8); pf1 = *(const u32x4*)(AX + (size_t)(rb2 + tb) * 512 + nn * 64 + e8);
            pf2 = *(const u32x4*)(wsp<bf16_t>(c, P_AB) + (size_t)(rb2 + t0 + t) * 1024 + nn * 64 + e8); }
        if (c.tid == 0) { unsigned spins = 0; while (__hip_atomic_load(cntp, __ATOMIC_RELAXED, __HIP_MEMORY_SCOPE_AGENT) < 36u) { __builtin_amdgcn_s_sleep(2); if (++spins > (1u << 22)) break; } }
        __syncthreads();
        asm volatile("" :: "v"(pf0), "v"(pf1), "v"(pf2));
        if (c.tid < 128) {
            const int dir = c.tid >> 6, e = c.tid & 63, pos = dir == 0 ? ch : (isctx ? 3 - ch : 4 + (35 - ch));
            const unsigned long long* sum = (const unsigned long long*)(wsp<float>(c, WS_LRUSUM) + ((size_t)(b * 2 + dir) * 36) * 1024 + (n * 64 + e) * 2);
            unsigned long long sq[36]; float hst = 0.f;
#pragma unroll
            for (int q = 0; q < 36; ++q) sq[q] = __hip_atomic_load(sum + (size_t)q * 512, __ATOMIC_RELAXED, __HIP_MEMORY_SCOPE_AGENT);
#pragma unroll
            for (int q = 0; q < 36; ++q) hst = q < pos ? __uint_as_float((unsigned)sq[q]) * hst + __uint_as_float((unsigned)(sq[q] >> 32)) : hst;
            h0[dir * 64 + e] = hst; }
        __syncthreads();
    }
    if (mode == 0) {
        if (part == 0) { float hh = 0.f, ap = 1.f;
#pragma unroll
            for (int q = 0; q < 4; ++q) { const f32x2 s = *(const LAS f32x2*)(pa + ((sdir * 4 + q) * 64 + se) * 2); hh = s.x * hh + s.y; ap *= s.x; }
            const int pos = sdir == 0 ? ch : (isctx ? 3 - ch : 4 + (35 - ch));
            *(f32x2*)(wsp<float>(c, WS_LRUSUM) + ((size_t)(b * 2 + sdir) * 36 + pos) * 1024 + (n * 64 + se) * 2) = (f32x2){ap, hh}; }
        return;
    }
    { float hh = h0[sdir * 64 + se];
      for (int q = 0; q < part; ++q) { const f32x2 s = *(const LAS f32x2*)(pa + ((sdir * 4 + q) * 64 + se) * 2); hh = s.x * hh + s.y; }
#pragma unroll
      for (int k = 0; k < 16; ++k) { const int i = 16 * part + k, t = sdir == 0 ? i : 63 - i; hh = av[k] * hh + bv[k]; gb[(sdir * 64 + t) * 64 + se] = hh; } }
    __syncthreads();
    {
        const int t = c.tid >> 3, e8 = (c.tid & 7) * 8;
        bf16_t* p = wsp<bf16_t>(c, P_AB) + (size_t)(rowbase + t0 + t) * 1024 + n * 64 + e8;
        const u32x4 g = gpre;
        const f32x4 f0 = *(const LAS f32x4*)(gb + t * 64 + e8), f1 = *(const LAS f32x4*)(gb + t * 64 + e8 + 4), r0 = *(const LAS f32x4*)(gb + (64 + t) * 64 + e8), r1 = *(const LAS f32x4*)(gb + (64 + t) * 64 + e8 + 4);
        u32x4 o; o.x = cvt_pk_bf16((f0.x + r0.x) * bf_lo(g.x), (f0.y + r0.y) * bf_hi(g.x)); o.y = cvt_pk_bf16((f0.z + r0.z) * bf_lo(g.y), (f0.w + r0.w) * bf_hi(g.y));
        o.z = cvt_pk_bf16((f1.x + r1.x) * bf_lo(g.z), (f1.y + r1.y) * bf_hi(g.z)); o.w = cvt_pk_bf16((f1.z + r1.z) * bf_lo(g.w), (f1.w + r1.w) * bf_hi(g.w));
        if (!dry) *(u32x4*)p = o;
    }
    __syncthreads();
}
#ifndef DBG
#define DBG 0xFFF
#endif
constexpr int LDS_BYTES = 147456, MISC_OFF = 131072 + 320;
constexpr int CW_BAR = 4096, CW_PANEL = 16384, CW_LRU = 40960, CW_UP = 65536;
struct Args { const float* in[27]; float* out; unsigned char* ws; };
__device__ __forceinline__ void make_ctx(Ctx& c, const Args& args, unsigned char* lds_raw) {
    int t = threadIdx.x; asm volatile("" : "+v"(t));
    const __attribute__((address_space(4))) char* kp = (const __attribute__((address_space(4))) char*)__builtin_amdgcn_kernarg_segment_ptr(); asm volatile("" : "+s"(kp));
    typedef const float* fptr_t;
#pragma unroll
    for (int i = 0; i < 27; ++i) c.in[i] = (const float*)(GAS const float*)*(const __attribute__((address_space(4))) fptr_t*)(kp + 8 * i);
    float* o = *(float* const __attribute__((address_space(4)))*)(kp + 8 * 27); unsigned char* w = *(unsigned char* const __attribute__((address_space(4)))*)(kp + 8 * 28);
    c.out = (float*)(GAS float*)o; c.ws = (unsigned char*)(GAS unsigned char*)w; c.lds = (LAS unsigned char*)lds_raw;
    c.tid = t; c.lane = t & 63; c.wave = __builtin_amdgcn_readfirstlane(t >> 6); c.G = gridDim.x; c.bid = blockIdx.x;
}
#define CTX() Ctx c; make_ctx(c, args, lds_raw)
#ifndef PROBE
#define PROBE -1
#endif
#define PBASE 0.0f
#define PSCALE 16.0f
#ifndef WGM_UP
#define WGM_UP 8
#endif
__global__ void __launch_bounds__(512, 2) fwd_kernel(Args args) {
    extern __shared__ __attribute__((aligned(16))) unsigned char lds_raw[];
    XcdBarrier bar;
    { CTX();
      for (int u = c.tid; u < (LDS_BYTES - 131072) / 4; u += 512) ((LAS unsigned*)(c.lds + 131072))[u] = 0u;
      __syncthreads();
      bar = xcd_barrier_post(wsp<unsigned>(c, WS_CTL) + CW_BAR, (volatile LAS unsigned*)(c.lds + MISC_OFF) + 8);
      if (PROBE >= 0 && c.tid == 0) ((volatile LAS unsigned long long*)(c.lds + MISC_OFF + 64))[0] = __builtin_amdgcn_s_memrealtime(); }
#define GRID_BAR() do { xcd_barrier(bar); if (PROBE >= 0 && threadIdx.x == 0) { volatile LAS unsigned long long* P_ = (volatile LAS unsigned long long*)((LAS unsigned char*)lds_raw + MISC_OFF + 64); \
        const unsigned long long now_ = __builtin_amdgcn_s_memrealtime(); if (P_[2] == (unsigned long long)PROBE) P_[1] = now_ - P_[0]; P_[0] = now_; P_[2] = P_[2] + 1; } } while (0)
#define SCR(c) ((LAS float*)((c).lds + 57344 + (c).wave * 8704))
    { CTX(); p0_modtab(c, 0); }
    { CTX(); p0_rope_tables(c); }
    cg::this_grid().sync();
    { CTX(); p0_rows(c); }
    { CTX(); int base = 0; ConvPend P; conv_pend_init(P); conv_ffn(c, 0, 0, 0, base, c.bid * 8 + c.wave, c.G * 8, SCR(c), P); conv_mixer(c, 0, base, c.bid * 8 + c.wave, c.G * 8, SCR(c), P); if (P.valid) conv_finish(P, SCR(c), c.lane); }
    { CTX(); __syncthreads(); p0_modtab(c, 1); }
    GRID_BAR();
    const int c0G = gridDim.x;
#pragma unroll 1
    for (int l = 0; l < DEPTH; ++l) {
        const bool last = l == DEPTH - 1;
        const int nM = last ? 64 : 72;
        const int dbg = (DBG >> (3 * l)) & 7;
        if (dbg & 1) {
        if (TW & 0x2000) { CTX(); SchedTiles S; S.ord.init(72, 22, c.G, c.bid, WGM_UP); S.A = (const char*)wsp<bf16_t>(c, WS_H); S.B = (const char*)wsp<bf16_t>(c, WS_WF); S.ld = 1024; S.nt = 16;
          EpiKeep E{}; pg8::gemm_stream(c.lds, c.tid, S, E); }
        if (TW & 0x80000) GRID_BAR();
        if (TW & 0x4000) { CTX(); SchedTiles S; S.ord.init(72, 22, c.G, c.bid, WGM_UP); S.A = (const char*)wsp<bf16_t>(c, WS_H); S.B = (const char*)wsp<bf16_t>(c, WS_WF); S.ld = 1024; S.nt = 16;
          EpiSwiglu E{wsp<bf16_t>(c, WS_U), nullptr}; pg8::gemm_stream(c.lds, c.tid, S, E); }
        { CTX(); SchedUp S; S.ord.init(72, 22, c.G, c.bid, WGM_UP); S.A = (const char*)wsp<bf16_t>(c, WS_H); S.B = (const char*)wsp<bf16_t>(c, WS_WF); S.ld = 1024; S.nt = 16;
          EpiSwiglu E{wsp<bf16_t>(c, WS_U), wsp<unsigned>(c, WS_CTL) + CW_UP + (l * 2 + 0) * 2048}; pg8::gemm_stream(c.lds, c.tid, S, E); }
        if (TW & 0x8000000) GRID_BAR();
        if (TW & 0x10000) { CTX(); SchedResid S; S.ord.init(64, 4, c.G, c.bid); S.A = (const char*)wsp<bf16_t>(c, WS_U); S.B = (const char*)(wsp<bf16_t>(c, WS_WF) + (size_t)5632 * 1024); S.ld = FF; S.nt = 44; S.ctx = true; S.Actx = nullptr; S.partA = 0; S.kpart = 1; S.late = true;
          EpiKeep E{}; pg8::gemm_stream(c.lds, c.tid, S, E); }
        { CTX(); SchedResid S; S.ord.init(64, 4, c.G, c.bid); S.A = (const char*)wsp<bf16_t>(c, WS_U); S.B = (const char*)(wsp<bf16_t>(c, WS_WF) + (size_t)5632 * 1024); S.ld = FF; S.nt = 44; S.ctx = true; S.Actx = nullptr; S.partA = 0; S.kpart = 1; S.late = true;
          const bool fz = c.G == 256; wait_panels(c, S, wsp<unsigned>(c, WS_CTL) + CW_UP + (l * 2 + 0) * 2048, 22 * 8);
          EpiResid E{c, l, 2, 0.5f, wsp<float>(c, WS_SLAB_FFN), l == 0 ? c.in[I_X] : nullptr, fz, c.in[I_LNG] + l * 3 * D, c.in[I_LNB] + l * 3 * D, l, 3, 4, wsp<unsigned>(c, WS_CTL) + CW_PANEL + (l * 3 + 0) * 4096}; pg8::gemm_stream(c.lds, c.tid, S, E); }
        GRID_BAR();
        }
        { CTX(); phase_normalize(c, c.G == 256 ? NLAT : 0, NT, c.in[I_LNG] + l * 3 * D, c.in[I_LNB] + l * 3 * D, l, 3, 4, wsp<float>(c, WS_SLAB_FFN), l, 2, 0.5f, l == 0 ? c.in[I_CTX] : nullptr); }
        GRID_BAR();
        if (dbg & 2) {
        if (TW & 0x40000) { CTX(); SchedTiles S; S.ord.init(72, 18, c.G, c.bid); S.A = (const char*)wsp<bf16_t>(c, WS_H); S.B = (const char*)wsp<bf16_t>(c, WM_INP); S.ld = 1024; S.nt = 16;
          EpiKeep E{}; pg8::gemm_stream(c.lds, c.tid, S, E); }
        if (!last) { CTX(); SchedTiles S; S.ord.init(72, 18, c.G, c.bid); S.A = (const char*)wsp<bf16_t>(c, WS_H); S.B = (const char*)wsp<bf16_t>(c, WM_INP); S.ld = 1024; S.nt = 16;
          EpiInp E{c}; pg8::gemm_stream(c.lds, c.tid, S, E); }
        else { CTX(); SchedInpLast S; S.ord.init(64, 18, c.G, c.bid); S.A = (const char*)wsp<bf16_t>(c, WS_H); S.B = (const char*)wsp<bf16_t>(c, WM_INP); S.ld = 1024; S.nt = 16;
          EpiInp E{c}; pg8::gemm_stream(c.lds, c.tid, S, E); }
        GRID_BAR();
        for (int rep = 0; rep < ((TW & 0x800000) ? 2 : 1); ++rep) {
        { CTX(); SchedTiles S; S.ord.init(last ? 64 : 72, 3, c.G, c.bid); S.A = (const char*)(wsp<bf16_t>(c, P_CD) + 512); S.B = (const char*)wsp<bf16_t>(c, WM_UQ); S.ld = 1024; S.nt = 6;
          EpiMlaQ E{c}; pg8::gemm_stream(c.lds, c.tid, S, E); }
        { CTX(); SchedTiles S; S.ord.init(72, 4, c.G, c.G == 256 ? (c.bid + 40) & 255 : c.bid); S.A = (const char*)wsp<bf16_t>(c, P_CKV);     S.B = (const char*)wsp<bf16_t>(c, WM_UKV); S.ld = 256; S.nt = 4;
          EpiMlaKV E{c}; pg8::gemm_stream(c.lds, c.tid, S, E); __syncthreads(); }
        }
        if (c0G < 252) { CTX(); for (int it = c.bid; it < 8 * 36 * 8; it += c.G) lru_item(c, l, (it >> 3) / 36, (it >> 3) % 36, it & 7, 0); }
        else { CTX(); if (c.bid >= 216 && c.bid < 252) lru_item(c, l, 7, c.bid - 216, 7, 0); }
        for (int rep = 0; rep < ((TW & 0x1000000) ? 2 : 1); ++rep) { CTX(); for (int it = c.bid * 8 + c.wave; it < NT / 16; it += c.G * 8) mla_kr_item(c, it); }
        for (int rep = 0; rep < ((TW & 4) ? 2 : 1); ++rep) { CTX(); __syncthreads(); for (int it = c.G == 256 ? (c.bid + 104) & 255 : c.bid; it < 8 * 4 * 18; it += c.G) ret_kv_block(c, l, it); }
        GRID_BAR();
        if (!(RDBG & 8)) { CTX(); for (int e = c.bid * 512 + c.tid; e < 64 * 2048; e += c.G * 512) ret_prefix(c, l, e); }
        GRID_BAR();
        { CTX();
          const int it0 = c0G < 252 ? c.bid : (c.bid >= 252 ? (((252 + c.bid - 252) << 3) | 7) : 8 * 36 * 8), its = c0G < 252 ? c.G : 32;
          for (int it = it0; it < 8 * 36 * 8; it += its) { if (last && ((it >> 3) % 36) < 4) continue; lru_item(c, l, (it >> 3) / 36, (it >> 3) % 36, it & 7, 1); } }
        if (c0G >= 252) { CTX();
            for (int r = 0; r < 9; ++r) { const int g = 7 * r + c.bid / 36; if (c.bid < 252) { const int ch = c.bid % 36; const int g2 = g + 7 < 63 ? g + 7 : -1; lru_item(c, l, g >> 3, ch, g & 7, 2, wsp<unsigned>(c, WS_CTL) + CW_LRU + (l * 64 + g) * 64, last && ch < 4, g2 < 0 ? -1 : g2 >> 3, g2 & 7); } } __syncthreads(); }
        if (TW & 0x4000000) GRID_BAR();
        if (TW & 0xF00) { CTX(); const bool dryv = c.G != 123457; for (int it = c.bid; it < 512; it += c.G) mla_block_item<((TW >> 8) & 15) - 1>(c, it, dryv); }
        { CTX(); for (int it = c.bid; it < 256; it += c.G) mla_dma_item(c, it); }
        if (TW & 0x4000000) GRID_BAR();
        if (TW & 128) { CTX(); for (int it = c.bid; it < 512; it += c.G) gqa_block_item(c, l, it, c.G != 123457); }
        { CTX(); for (int it = c.bid; it < 512; it += c.G) gqa_block_item(c, l, it); }
        if (TW & 0x4000000) GRID_BAR();
        if (!last && (TW & 0x2000000)) { CTX(); const int gw = c.bid * 8 + c.wave, NGW = c.G * 8; for (int it = 2048 + gw; it < 2304; it += NGW) mla_item(c, it); for (int it = 2048 + gw; it < 2304; it += NGW) gqa_item(c, l, it, c.G != 123457); }
        if (!last && c0G != 256) { CTX(); if (c.wave == 0) { for (int it = 2048 + c.bid; it < 2304; it += c.G) mla_item(c, it); } else if (c.wave == 1) { for (int it = 2048 + c.bid; it < 2304; it += c.G) gqa_item(c, l, it); } }
        if (!last && c0G == 256) { CTX();
            const int q = c.bid - 64, it = 2048 + q + (c.wave >> 1) * 192;
            if (q >= 0 && c.wave < 4 && it < 2304) { if ((c.wave & 1) == 0) mla_item(c, it); else gqa_item(c, l, it); } }
        if (TW & 0x4000000) GRID_BAR();
        if (TW & 32) { CTX(); __syncthreads(); for (int it = c.bid; it < 8 * 4 * 18; it += c.G) { if (last && (it % 18) < 2) continue; ret_out_block(c, l, it, c.G != 123457); } }
        { CTX(); __syncthreads(); for (int it = c.bid; it < 8 * 4 * 18; it += c.G) { if (last && (it % 18) < 2) continue; ret_out_block(c, l, it); } }
        GRID_BAR();
        if (TW & 0x20000) { CTX(); SchedMerge S; S.ord.init(64, 4, c.G, c.bid); S.ctx = !last; S.H = (const char*)wsp<bf16_t>(c, WS_H); S.Wg = (const char*)wsp<bf16_t>(c, WM_G); S.Wb = (const char*)wsp<bf16_t>(c, WM_BR);
          S.AB = (const char*)wsp<bf16_t>(c, P_AB); S.CD = (const char*)wsp<bf16_t>(c, P_CD); S.ld = 1024;
          EpiKeep E{}; pg8::gemm_stream(c.lds, c.tid, S, E); }
        { CTX(); SchedMerge S; S.ord.init(64, 4, c.G, c.bid); S.ctx = !last; S.H = (const char*)wsp<bf16_t>(c, WS_H); S.Wg = (const char*)wsp<bf16_t>(c, WM_G); S.Wb = (const char*)wsp<bf16_t>(c, WM_BR);
          S.AB = (const char*)wsp<bf16_t>(c, P_AB); S.CD = (const char*)wsp<bf16_t>(c, P_CD); S.ld = 1024;
          EpiMerge E{(GAS unsigned char*)(c.ws + WS_SCR_SIG + (size_t)c.bid * 131072), (GAS unsigned char*)(c.ws + WS_SCR_M + (size_t)c.bid * 262144), (GAS bf16_t*)wsp<bf16_t>(c, WS_MG), (GAS bf16_t*)wsp<bf16_t>(c, WS_MGP)}; pg8::gemm_stream(c.lds, c.tid, S, E); }
        if (!last && c0G == 256) { CTX();
            __syncthreads();
            if (c.bid >= 128) { int base = 0; ConvPend P; conv_pend_init(P); conv_mixer(c, l + 1, base, (c.bid - 128) * 8 + c.wave, 128 * 8, SCR(c), P, 1); if (P.valid) conv_finish(P, SCR(c), c.lane); } }
        GRID_BAR();
        if (!last && c0G == 256) { CTX();
            if (c.bid < 128) { int base = 0; ConvPend P; conv_pend_init(P); conv_ffn(c, l, 1, 1, base, c.bid * 8 + c.wave, 128 * 8, SCR(c), P, 1); if (P.valid) conv_finish(P, SCR(c), c.lane); }
            __syncthreads(); }
        { CTX(); SchedResid S; S.ord.init(64, 4, c.G, c.bid); S.A = (const char*)wsp<bf16_t>(c, WS_MG); S.B = (const char*)wsp<bf16_t>(c, WM_OUT); S.ld = 1024; S.nt = 16; S.ctx = !last; S.Actx = (const char*)wsp<bf16_t>(c, WS_MGP); S.partA = (size_t)NCTX * D * 2; S.kpart = 0; S.late = false;
          const bool fz = c.G == 256;
          EpiResid E{c, l, 5, 1.0f, wsp<float>(c, WS_SLAB_OUT), nullptr, fz, c.in[I_LNG] + (l * 3 + 1) * D, c.in[I_LNB] + (l * 3 + 1) * D, l, 6, 7, wsp<unsigned>(c, WS_CTL) + CW_PANEL + (l * 3 + 1) * 4096}; pg8::gemm_stream(c.lds, c.tid, S, E); }
        GRID_BAR();
        }
        { CTX(); phase_normalize(c, c.G == 256 ? NLAT : 0, nM * 256, c.in[I_LNG] + (l * 3 + 1) * D, c.in[I_LNB] + (l * 3 + 1) * D, l, 6, 7, wsp<float>(c, WS_SLAB_OUT), l, 5, 1.0f); }
        for (int rep = 0; rep < ((TW & 64) ? 2 : 1); ++rep)
        { CTX(); int base = 0; const int gw = c.bid * 8 + c.wave, NGW = c.G * 8; ConvPend P; conv_pend_init(P); conv_ffn(c, l, 1, 1, base, gw, NGW, SCR(c), P, (!last && c.G == 256) ? 2 : 3); if (!last) { conv_ffn(c, l + 1, 0, 0, base, gw, NGW, SCR(c), P); conv_mixer(c, l + 1, base, gw, NGW, SCR(c), P, c.G == 256 ? 2 : 3); } if (P.valid) conv_finish(P, SCR(c), c.lane); }
        GRID_BAR();
        if (dbg & 4) {
        { CTX(); SchedUp S; S.ord.init(nM, 22, c.G, c.bid, WGM_UP); S.A = (const char*)wsp<bf16_t>(c, WS_H); S.B = (const char*)wsp<bf16_t>(c, WS_WF + WF_SLOT); S.ld = 1024; S.nt = 16;
          EpiSwiglu E{wsp<bf16_t>(c, WS_U), wsp<unsigned>(c, WS_CTL) + CW_UP + (l * 2 + 1) * 2048}; pg8::gemm_stream(c.lds, c.tid, S, E); }
        if (TW & 0x8000000) GRID_BAR();
        { CTX(); SchedResid S; S.ord.init(64, 4, c.G, c.bid); S.A = (const char*)wsp<bf16_t>(c, WS_U); S.B = (const char*)(wsp<bf16_t>(c, WS_WF + WF_SLOT) + (size_t)5632 * 1024); S.ld = FF; S.nt = 44; S.ctx = !last; S.Actx = nullptr; S.partA = 0; S.kpart = 1; S.late = true;
          const bool fz = c.G == 256; wait_panels(c, S, wsp<unsigned>(c, WS_CTL) + CW_UP + (l * 2 + 1) * 2048, 22 * 8);
          EpiResid E{c, l, 8, 0.5f, wsp<float>(c, WS_SLAB_FFN), nullptr, fz, c.in[I_LNG] + (l * 3 + 2) * D, c.in[I_LNB] + (l * 3 + 2) * D, last ? -1 : l + 1, 0, 1, wsp<unsigned>(c, WS_CTL) + CW_PANEL + (l * 3 + 2) * 4096}; pg8::gemm_stream(c.lds, c.tid, S, E); }
        GRID_BAR();
        }
        { CTX(); phase_normalize(c, c.G == 256 ? NLAT : 0, nM * 256, c.in[I_LNG] + (l * 3 + 2) * D, c.in[I_LNB] + (l * 3 + 2) * D, last ? -1 : l + 1, 0, 1, wsp<float>(c, WS_SLAB_FFN), l, 8, 0.5f); }
        if (!last) GRID_BAR();
    }
    if (PROBE >= 0) { GRID_BAR(); if (blockIdx.x == 0 && threadIdx.x == 0) args.out[0] += 10.0f + (float)((volatile LAS unsigned long long*)((LAS unsigned char*)lds_raw + MISC_OFF + 64))[1] * (0.01f / PSCALE) - (PBASE / PSCALE); }
}

extern "C" void kernel_launch(void* const* d_in, const int* in_sizes, int n_in, void* d_out, int out_size, void* d_ws, size_t ws_size, hipStream_t stream) {
    static int grid = 0;
    if (grid == 0) {
        if (n_in != 27 || out_size != NLAT * D || ws_size < WS_END) { fprintf(stderr, "kernel_launch: unexpected problem (n_in %d, out %d, ws %zu < %zu)\n", n_in, out_size, ws_size, (size_t)WS_END); grid = -1; return; }
        int dev = 0, cus = 0, per_cu = 0;
        hipGetDevice(&dev); hipDeviceGetAttribute(&cus, hipDeviceAttributeMultiprocessorCount, dev);
        hipFuncSetAttribute((const void*)fwd_kernel, hipFuncAttributeMaxDynamicSharedMemorySize, LDS_BYTES);
        hipOccupancyMaxActiveBlocksPerMultiprocessor(&per_cu, (const void*)fwd_kernel, 512, LDS_BYTES);
        if (per_cu < 1) { fprintf(stderr, "kernel_launch: occupancy query says %d workgroups per CU\n", per_cu); per_cu = 1; }
        (void)hipGetLastError();
        grid = cus;
    }
    if (grid < 0) return;
    hipMemsetAsync((char*)d_ws + WS_CTL, 0, CTL_BYTES, stream);
    Args a{};
    for (int i = 0; i < 27; ++i) a.in[i] = (const float*)d_in[i];
    a.out = (float*)d_out; a.ws = (unsigned char*)d_ws;
    void* kargs[] = {&a};
    hipError_t e = hipLaunchCooperativeKernel((const void*)fwd_kernel, dim3(grid), dim3(512), kargs, LDS_BYTES, stream);
    if (e != hipSuccess) fprintf(stderr, "cooperative launch failed: %s (grid %d)\n", hipGetErrorString(e), grid);
}
```
